# Optimizing an MI355X kernel written in HIP

```python
import jax, jax.numpy as jnp
from jax import lax
import numpy as np

D_MODEL = 2048
BATCH = 16
SEQ = 256
DEPTH = 2
DEC_BATCH = 2
DEC_SEQ = 1024
PAST_LEN = 512

GRID_W = 64
N_MOD = 9
D_FF = 256 * ((8 * D_MODEL // 3 + 255) // 256)
HG_DK = 128
HG_DV = 128
HG_WIDTH = D_MODEL // 4
HG_HEADS = HG_WIDTH // HG_DK
HG_CHUNK = 16
NA_HEAD_DIM = 128
NA_WIDTH = D_MODEL // 2
NA_HEADS = NA_WIDTH // NA_HEAD_DIM
NA_KH = 8
NA_KW = 16
NA_QBW = 8
NA_BAND = NA_QBW + NA_KW
NA_QBLOCK = 128
NA_SCALE = NA_HEAD_DIM ** -0.5
LRU_WIDTH = D_MODEL // 4
LRU_BLOCKS = 8
LRU_BW = LRU_WIDTH // LRU_BLOCKS
LRU_CONV = 4
LRU_C = 8.0
IN_SPLITS = (HG_WIDTH,) * 5 + (NA_WIDTH,) * 3 + (LRU_WIDTH,) * 2 + (3 * D_MODEL,)
D_IN = sum(IN_SPLITS)
EPS = 1e-6
NEG = -1e30

kernel_name = 'hybrid_flow_prefix_trunk'


def rmsnorm(x, g):
    xf = x.astype(jnp.float32)
    y = xf * lax.rsqrt(jnp.mean(xf * xf, axis=-1, keepdims=True) + EPS)
    return (y * g.astype(jnp.float32)).astype(x.dtype)


def adaln_params(cvec, w, b):
    m = jax.nn.silu(cvec) @ w + b
    return m.reshape(cvec.shape[0], N_MOD, D_MODEL)


def modulated_norm(x, mods, slot, g):
    shift = mods[:, None, 3 * slot]
    scale = mods[:, None, 3 * slot + 1]
    return rmsnorm(x, g) * (1 + scale) + shift


def gate_of(mods, slot):
    return mods[:, None, 3 * slot + 2]


def swiglu(h, w_up, w_down):
    a, u = jnp.split(h @ w_up, 2, axis=-1)
    return (jax.nn.silu(a) * u) @ w_down


def ffn_sublayer(x, mods, slot, g, w_up, w_down):
    h = modulated_norm(x, mods, slot, g)
    return x + 0.5 * gate_of(mods, slot) * swiglu(h, w_up, w_down)


def split_projection(z):
    parts, start = [], 0
    for width in IN_SPLITS:
        parts.append(z[..., start:start + width])
        start += width
    return parts


def hgrn_lower_bounds(logits):
    p = jax.nn.softmax(logits.astype(jnp.float32), axis=0)
    cum = jnp.cumsum(p, axis=0)
    return cum - cum[0:1]


def hgrn2_chunk_scan(q, log_f, k, v, s0):
    B, N, H, DK = q.shape
    DV = v.shape[-1]
    nC = N // HG_CHUNK
    q, log_f, k = [t.reshape(B, nC, HG_CHUNK, H, DK) for t in (q, log_f, k)]
    v = v.reshape(B, nC, HG_CHUNK, H, DV)
    b = jnp.cumsum(log_f, axis=2)
    causal = jnp.tril(jnp.ones((HG_CHUNK, HG_CHUNK), dtype=bool))[:, :, None, None]
    decay = jnp.exp(jnp.where(causal, b[:, :, :, None] - b[:, :, None, :], -jnp.inf))
    scores = jnp.einsum('bntshd,bnshd->bnhts', q[:, :, :, None] * decay, k)
    o_intra = jnp.einsum('bnhts,bnshe->bnthe', scores, v)
    b_last = b[:, :, -1]
    kv = jnp.einsum('bnshd,bnshe->bnhde', k * jnp.exp(b_last[:, :, None] - b), v)

    def step(S, inp):
        dec, kv_c = inp
        return dec[..., None] * S + kv_c, S

    s_final, s_start = lax.scan(step, s0, (jnp.moveaxis(jnp.exp(b_last), 1, 0), jnp.moveaxis(kv, 1, 0)))
    o_inter = jnp.einsum('bnthd,nbhde->bnthe', q * jnp.exp(b), s_start)
    return (o_intra + o_inter).reshape(B, N, H, DV), s_final


def hgrn2_mixer(zq, zf_fwd, zf_bwd, zi, zo, lb, norm_g, s0):
    B, N, _ = zq.shape
    f32 = jnp.float32
    heads = lambda t: t.reshape(B, N, HG_HEADS, -1)
    q = heads(jax.nn.silu(zq.astype(f32)))
    v = heads(zi.astype(f32))

    def forget(zf, lb_d):
        log_f = jnp.logaddexp(jnp.log(lb_d), jnp.log1p(-lb_d) + jax.nn.log_sigmoid(zf.astype(f32)))
        return heads(log_f), heads(-jnp.expm1(log_f))

    lf_f, k_f = forget(zf_fwd, lb[0])
    lf_b, k_b = forget(zf_bwd, lb[1])
    s0 = s0.astype(f32)
    rev = lambda t: jnp.flip(t, axis=1)
    o_f, s_f = hgrn2_chunk_scan(q, lf_f, k_f, v, s0[:, 0])
    o_b, s_b = hgrn2_chunk_scan(rev(q), rev(lf_b), rev(k_b), rev(v), s0[:, 1])
    o = o_f + rev(o_b)
    o = o * lax.rsqrt(jnp.mean(o * o, axis=-1, keepdims=True) + EPS) * norm_g.astype(f32)
    o = o.reshape(B, N, HG_WIDTH) * jax.nn.silu(zo.astype(f32))
    return o.astype(zq.dtype), jnp.stack([s_f, s_b], axis=1)


def context_attention(q, k, v):
    B, N, H, Dh = q.shape
    nb = N // NA_QBLOCK
    qb = jnp.moveaxis(q.reshape(B, nb, NA_QBLOCK, H, Dh), 1, 0)

    def block(qi):
        s = jnp.einsum('bqhd,bkhd->bhqk', qi, k).astype(jnp.float32) * NA_SCALE
        p = jax.nn.softmax(s, axis=-1).astype(v.dtype)
        return jnp.einsum('bhqk,bkhd->bqhd', p, v)

    o = lax.map(block, qb)
    return jnp.moveaxis(o, 0, 1).reshape(B, N, H * Dh)


def neighbourhood_attention(q, k, v, k_ctx, v_ctx, rpb):
    B, N, H, Dh = q.shape
    f32 = jnp.float32
    rows = N // GRID_W
    kh = min(NA_KH, rows)
    nqb = GRID_W // NA_QBW
    r = jnp.arange(rows)
    key_rows = jnp.clip(r - kh // 2, 0, rows - kh)[:, None] + jnp.arange(kh)[None]
    qcol = jnp.arange(GRID_W).reshape(nqb, NA_QBW)
    win_start = jnp.clip(qcol - NA_KW // 2, 0, GRID_W - NA_KW)
    band_start = jnp.clip(jnp.arange(nqb) * NA_QBW - NA_KW // 2, 0, GRID_W - NA_BAND)
    key_cols = band_start[:, None] + jnp.arange(NA_BAND)[None]
    in_win = (key_cols[:, None] >= win_start[..., None]) & (key_cols[:, None] < win_start[..., None] + NA_KW)
    idx = key_rows[:, None, :, None] * GRID_W + key_cols[None, :, None, :]
    dy = key_rows - r[:, None] + NA_KH - 1
    dx = jnp.clip(key_cols[:, None] - qcol[..., None] + NA_KW - 1, 0, 2 * NA_KW - 2)
    bias = rpb.astype(f32)[:, dy[:, None, None, :, None], dx[None, :, :, None, :]]
    bias = jnp.where(in_win[None, None, :, :, None, :], bias, NEG)
    bias = jnp.moveaxis(bias, 1, 0)
    q_rows = jnp.moveaxis(q.reshape(B, rows, nqb, NA_QBW, H, Dh), 1, 0)
    n_loc = kh * NA_BAND

    def row(args):
        q_r, idx_r, bias_r = args
        k_loc = k[:, idx_r]
        v_loc = v[:, idx_r]
        s_loc = jnp.einsum('bjqhd,bjkwhd->bhjqkw', q_r, k_loc).astype(f32) * NA_SCALE + bias_r
        s_ctx = jnp.einsum('bjqhd,bmhd->bhjqm', q_r, k_ctx).astype(f32) * NA_SCALE
        s = jnp.concatenate([s_loc.reshape(B, H, nqb, NA_QBW, n_loc), s_ctx], axis=-1)
        p = jax.nn.softmax(s, axis=-1).astype(v.dtype)
        p_loc = p[..., :n_loc].reshape(B, H, nqb, NA_QBW, kh, NA_BAND)
        o = (jnp.einsum('bhjqkw,bjkwhd->bjqhd', p_loc, v_loc)
             + jnp.einsum('bhjqm,bmhd->bjqhd', p[..., n_loc:], v_ctx))
        return o.reshape(B, GRID_W, H * Dh)

    o = lax.map(row, (q_rows, idx, bias))
    return jnp.moveaxis(o, 0, 1).reshape(B, N, H * Dh)


def centred_dwconv(x, w, b):
    N = x.shape[1]
    left = LRU_CONV // 2
    xp = jnp.pad(x, ((0, 0), (left, LRU_CONV - 1 - left), (0, 0)))
    out = b + w[0] * xp[:, 0:N]
    for j in range(1, LRU_CONV):
        out = out + w[j] * xp[:, j:j + N]
    return out


def rglru_mixer(zx, zg, conv_w, conv_b, w_a, b_a, w_x, b_x, lam, h0):
    B, N, _ = zx.shape
    f32 = jnp.float32
    x = centred_dwconv(zx, conv_w, conv_b).astype(f32)
    xb = x.reshape(B, N, LRU_BLOCKS, LRU_BW)

    def block_linear(w, bias):
        return jnp.einsum('bnki,kij->bnkj', xb, w.astype(f32)).reshape(B, N, LRU_WIDTH) + bias.astype(f32)

    def direction(d, reverse):
        r_gate = jax.nn.sigmoid(block_linear(w_a[d], b_a[d]))
        i_gate = jax.nn.sigmoid(block_linear(w_x[d], b_x[d]))
        log_a = -LRU_C * r_gate * jax.nn.softplus(-lam[d].astype(f32))
        a = jnp.exp(log_a)
        u = jnp.sqrt(-jnp.expm1(2.0 * log_a)) * (i_gate * x)

        def step(h, inp):
            a_t, u_t = inp
            h = a_t * h + u_t
            return h, h

        h_last, hs = lax.scan(step, h0[:, d].astype(f32), (jnp.moveaxis(a, 1, 0), jnp.moveaxis(u, 1, 0)),
                              reverse=reverse)
        return jnp.moveaxis(hs, 0, 1), h_last

    y_f, h_f = direction(0, False)
    y_b, h_b = direction(1, True)
    y = (y_f + y_b) * jax.nn.gelu(zg.astype(f32))
    return y.astype(zx.dtype), jnp.stack([h_f, h_b], axis=1)


def merge_branches(o_a, o_b, o_c, zgate, w_proj_a, w_proj_b, w_proj_c, w_out):
    g = jax.nn.sigmoid(zgate.astype(jnp.float32)).astype(o_a.dtype)
    g_a, g_b, g_c = jnp.split(g, 3, axis=-1)
    m = g_a * (o_a @ w_proj_a) + g_b * (o_b @ w_proj_b) + g_c * (o_c @ w_proj_c)
    return m @ w_out


def trunk_layer(x, mods, lb, norm_g, ffn1_w_up, ffn1_w_down, ffn2_w_up, ffn2_w_down, w_in,
                hgrn_norm_g, na_rpb, lru_conv_w, lru_conv_b, lru_w_a, lru_b_a, lru_w_x, lru_b_x,
                lru_lambda, w_proj_a, w_proj_b, w_proj_c, w_out, hg_state, lru_state, ctx_k, ctx_v):
    B, N, _ = x.shape
    x = ffn_sublayer(x, mods, 0, norm_g[0], ffn1_w_up, ffn1_w_down)
    h = modulated_norm(x, mods, 1, norm_g[1])
    zq, zf_fwd, zf_bwd, zi, zo, nq, nk, nv, lx, lg, zgate = split_projection(h @ w_in)
    o_a, s_hg = hgrn2_mixer(zq, zf_fwd, zf_bwd, zi, zo, lb, hgrn_norm_g, hg_state)
    heads = lambda t: t.reshape(B, N, NA_HEADS, NA_HEAD_DIM)
    q, k, v = heads(nq), heads(nk), heads(nv)
    if ctx_k is None:
        o_b = context_attention(q, k, v)
    else:
        o_b = neighbourhood_attention(q, k, v, ctx_k, ctx_v, na_rpb)
    o_c, s_lru = rglru_mixer(lx, lg, lru_conv_w, lru_conv_b, lru_w_a, lru_b_a, lru_w_x, lru_b_x,
                             lru_lambda, lru_state)
    x = x + gate_of(mods, 1) * merge_branches(o_a, o_b, o_c, zgate, w_proj_a, w_proj_b, w_proj_c, w_out)
    x = ffn_sublayer(x, mods, 2, norm_g[2], ffn2_w_up, ffn2_w_down)
    return x, k, v, s_hg, s_lru


def setup_inputs(seed: int = 0) -> dict:
    key = jax.random.key(seed)
    ks = iter(jax.random.split(key, 40))
    f32 = jnp.float32
    nrm = lambda shape, scale: jax.random.normal(next(ks), shape, f32) * scale
    a0 = jax.random.uniform(next(ks), (DEPTH, 2, LRU_WIDTH), f32, minval=0.9, maxval=0.999)
    return {
        'x_prompt': nrm((BATCH, SEQ, D_MODEL), 1.0),
        'x_sample': nrm((DEC_BATCH, DEC_SEQ, D_MODEL), 1.0),
        'cache_na_k': nrm((DEC_BATCH, DEPTH, PAST_LEN, NA_HEADS, NA_HEAD_DIM), 1.0),
        'cache_na_v': nrm((DEC_BATCH, DEPTH, PAST_LEN, NA_HEADS, NA_HEAD_DIM), 1.0),
        'state_hgrn': nrm((DEC_BATCH, DEPTH, 2, HG_HEADS, HG_DK, HG_DV), 1.0),
        'state_lru': nrm((DEC_BATCH, DEPTH, 2, LRU_WIDTH), 0.5),
        'c': nrm((DEC_BATCH, D_MODEL), 1.0),
        'c_ctx': nrm((D_MODEL,), 1.0),
        'mod_w': nrm((DEPTH, D_MODEL, N_MOD * D_MODEL), 0.5 * D_MODEL ** -0.5),
        'mod_b': nrm((DEPTH, N_MOD * D_MODEL), 0.02),
        'norm_g': 1.0 + nrm((DEPTH, 3, D_MODEL), 0.1),
        'ffn1_w_up': nrm((DEPTH, D_MODEL, 2 * D_FF), D_MODEL ** -0.5),
        'ffn1_w_down': nrm((DEPTH, D_FF, D_MODEL), D_FF ** -0.5),
        'ffn2_w_up': nrm((DEPTH, D_MODEL, 2 * D_FF), D_MODEL ** -0.5),
        'ffn2_w_down': nrm((DEPTH, D_FF, D_MODEL), D_FF ** -0.5),
        'w_in': nrm((DEPTH, D_MODEL, D_IN), D_MODEL ** -0.5),
        'hgrn_lb_logits': nrm((DEPTH, 2, HG_WIDTH), 1.0),
        'hgrn_norm_g': 1.0 + nrm((DEPTH, HG_HEADS, HG_DV), 0.1),
        'na_rpb': nrm((DEPTH, NA_HEADS, 2 * NA_KH - 1, 2 * NA_KW - 1), 0.1),
        'lru_conv_w': nrm((DEPTH, LRU_CONV, LRU_WIDTH), LRU_CONV ** -0.5),
        'lru_conv_b': nrm((DEPTH, LRU_WIDTH), 0.02),
        'lru_w_a': nrm((DEPTH, 2, LRU_BLOCKS, LRU_BW, LRU_BW), LRU_BW ** -0.5),
        'lru_b_a': nrm((DEPTH, 2, LRU_WIDTH), 0.1),
        'lru_w_x': nrm((DEPTH, 2, LRU_BLOCKS, LRU_BW, LRU_BW), LRU_BW ** -0.5),
        'lru_b_x': nrm((DEPTH, 2, LRU_WIDTH), 0.1),
        'lru_lambda': jnp.log(a0) - jnp.log1p(-a0),
        'w_proj_a': nrm((DEPTH, HG_WIDTH, D_MODEL), HG_WIDTH ** -0.5),
        'w_proj_b': nrm((DEPTH, NA_WIDTH, D_MODEL), NA_WIDTH ** -0.5),
        'w_proj_c': nrm((DEPTH, LRU_WIDTH, D_MODEL), LRU_WIDTH ** -0.5),
        'w_out': nrm((DEPTH, D_MODEL, D_MODEL), D_MODEL ** -0.5),
        'final_norm_g': 1.0 + nrm((D_MODEL,), 0.1),
    }


def reference(x_prompt, x_sample, cache_na_k, cache_na_v, state_hgrn, state_lru, c, c_ctx,
              mod_w, mod_b, norm_g, ffn1_w_up, ffn1_w_down, ffn2_w_up, ffn2_w_down, w_in,
              hgrn_lb_logits, hgrn_norm_g, na_rpb, lru_conv_w, lru_conv_b, lru_w_a, lru_b_a,
              lru_w_x, lru_b_x, lru_lambda, w_proj_a, w_proj_b, w_proj_c, w_out, final_norm_g):
    lb_all = hgrn_lower_bounds(hgrn_lb_logits)

    def weights(l):
        return (norm_g[l], ffn1_w_up[l], ffn1_w_down[l], ffn2_w_up[l], ffn2_w_down[l], w_in[l],
                hgrn_norm_g[l], na_rpb[l], lru_conv_w[l], lru_conv_b[l], lru_w_a[l], lru_b_a[l],
                lru_w_x[l], lru_b_x[l], lru_lambda[l], w_proj_a[l], w_proj_b[l], w_proj_c[l], w_out[l])

    b_ctx = x_prompt.shape[0]
    zero_hg = jnp.zeros((b_ctx, 2, HG_HEADS, HG_DK, HG_DV), jnp.float32)
    zero_lru = jnp.zeros((b_ctx, 2, LRU_WIDTH), jnp.float32)
    xc = x_prompt
    ks, vs, hgs, lrus = [], [], [], []
    for l in range(DEPTH):
        mods = adaln_params(c_ctx[None], mod_w[l], mod_b[l])
        xc, k_l, v_l, s_hg, s_lru = trunk_layer(xc, mods, lb_all[l], *weights(l), zero_hg, zero_lru, None, None)
        ks.append(k_l)
        vs.append(v_l)
        hgs.append(s_hg)
        lrus.append(s_lru)
    y_prompt = rmsnorm(xc, final_norm_g)

    xs = x_sample
    for l in range(DEPTH):
        mods = adaln_params(c, mod_w[l], mod_b[l])
        xs = trunk_layer(xs, mods, lb_all[l], *weights(l), state_hgrn[:, l], state_lru[:, l],
                         cache_na_k[:, l], cache_na_v[:, l])[0]
    y_sample = rmsnorm(xs, final_norm_g)

    new_cache_na_k = jnp.stack(ks, axis=1)
    new_cache_na_v = jnp.stack(vs, axis=1)
    new_state_hgrn = jnp.stack(hgs, axis=1)
    new_state_lru = jnp.stack(lrus, axis=1)
    return (y_prompt, y_sample, new_cache_na_k, new_cache_na_v, new_state_hgrn, new_state_lru)
```

```cpp
#include <hip/hip_runtime.h>
#include <cstdio>
#include <cstdint>
namespace pg8 {
#define PG8_LAS __attribute__((address_space(3)))
typedef unsigned short bf16_t;
typedef short bf16x8 __attribute__((ext_vector_type(8)));
typedef float f32x4 __attribute__((ext_vector_type(4)));
typedef unsigned u32x4 __attribute__((ext_vector_type(4)));
constexpr int BM = 256, BK = 64, HALF = 128, HTB = HALF * BK * 2  , STAGE_BYTES = 8 * HTB, NXCD = 8, WGM = 8;

__host__ __device__ __forceinline__ int lds_byte(int r, int c) { const int st = (r >> 4) * 2 + (c >> 5), rr = r & 15, cc = c & 31, ob = rr * 64 + cc * 2; return st * 1024 + (ob ^ (((ob >> 9) & 1) << 5)); }
__host__ __device__ __forceinline__ void stage_rc(int b, int& R, int& C) { const int st = b / 1024, sb = b % 1024, swz = sb ^ (((sb >> 9) & 1) << 5); R = (st >> 1) * 16 + swz / 64; C = (st & 1) * 32 + (swz % 64) / 2; }
__host__ __device__ __forceinline__ int perm32(int rho) { const int n = rho >> 4, i = rho & 15; return 8 * (i >> 2) + 4 * n + (i & 3); }

struct Unit { int pm, pn; };
struct Gemm { const bf16_t* A; const bf16_t* Bt; int M, N, K; };

struct StaticOrder {
    int nM, nN, nwg, G, c;
    __host__ __device__ void init(int M, int N, int G_, int c_) { nM = M / BM; nN = N / BM; nwg = nM * nN; G = G_; c = c_; }
    __host__ __device__ bool next(int i, Unit& u) const {
        const long L = (long)i * G + c; if (L >= nwg) return false;
        int wgid = (int)L; { const int q = nwg / NXCD, r = nwg % NXCD, xcd = wgid % NXCD, off = wgid / NXCD; wgid = (xcd < r ? xcd * (q + 1) : r * (q + 1) + (xcd - r) * q) + off; }
        const int nig = WGM * nN, gid = wgid / nig, fm = gid * WGM, gsz = (nM - fm) < WGM ? (nM - fm) : WGM;
        u.pm = fm + ((wgid % nig) % gsz); u.pn = (wgid % nig) / gsz; return true;
    }
    __device__ __forceinline__ void a_ready(const Unit&) const {}
    __device__ __forceinline__ void done(const Unit&) const {}
};
typedef float f32x2_cv __attribute__((ext_vector_type(2)));
typedef __bf16 bf16x2_cv __attribute__((ext_vector_type(2)));
__device__ __forceinline__ unsigned cvt_pk_bf16(float lo, float hi) { const f32x2_cv v = {lo, hi}; return __builtin_bit_cast(unsigned, __builtin_convertvector(v, bf16x2_cv)); }
typedef float f32x2 __attribute__((ext_vector_type(2)));

typedef unsigned u32x2 __attribute__((ext_vector_type(2)));
#ifndef PROBE_NOGATE
#define PROBE_NOGATE 0
#endif
#ifndef PROBE_GCONST
#define PROBE_GCONST 0
#endif
#ifndef PROBE_GRAW
#define PROBE_GRAW 0
#endif
#ifndef PROBE_QKV32
#define PROBE_QKV32 0
#endif
__device__ __forceinline__ float silu_f(float a) { return a * __builtin_amdgcn_rcpf(1.0f + __expf(-a)); }
__device__ __forceinline__ float sigmoid_f(float a) { return __builtin_amdgcn_rcpf(1.0f + __expf(-a)); }
__device__ __forceinline__ int opq_(int v) { asm volatile("" : "+v"(v)); return v; }

struct EpiSwiglu {
    static constexpr bool PERM = true, AFTER_DRAIN = false;
    bf16_t* O; int ldo;
    __device__ __forceinline__ void operator()(const f32x4 (&acc)[2][2][4][2], const Unit& u, int wr, int wc, int fr_, int fq_) const {
        const int fr = opq_(fr_), fq = opq_(fq_);
        const int row0 = u.pm * BM + wr * 64 + fr, col0 = u.pn * HALF + wc * 32 + 8 * fq;
#pragma unroll
        for (int ai = 0; ai < 2; ++ai)
#pragma unroll
            for (int m = 0; m < 4; ++m) { bf16_t* rowp = O + (size_t)(row0 + ai * HALF + m * 16) * ldo + col0;
                const f32x4 a0 = acc[ai][0][m][0], a1 = acc[ai][0][m][1], u0 = acc[ai][1][m][0], u1 = acc[ai][1][m][1];
                f32x4 v0, v1;
#pragma unroll
                for (int j = 0; j < 4; ++j) { v0[j] = silu_f(a0[j]) * u0[j]; v1[j] = silu_f(a1[j]) * u1[j]; }
                u32x4 w; w.x = cvt_pk_bf16(v0[0], v0[1]); w.y = cvt_pk_bf16(v0[2], v0[3]); w.z = cvt_pk_bf16(v1[0], v1[1]); w.w = cvt_pk_bf16(v1[2], v1[3]);
                *(u32x4*)rowp = w; }
    }
};
struct EpiResid {
    static constexpr bool PERM = false, AFTER_DRAIN = false;
    float* X; int ldx; const float* mods_l; int slot; float coef;
    __device__ __forceinline__ void operator()(const f32x4 (&acc)[2][2][4][2], const Unit& u, int wr, int wc, int fr_, int fq_) const {
        const int fr = opq_(fr_), fq = opq_(fq_);
        const int row0 = u.pm * BM + wr * 64 + fr, col0 = u.pn * BM + wc * 32 + 4 * fq;
        const int cidx = u.pm < 16 ? 0 : 1 + ((u.pm - 16) >> 2);
        const float* g = mods_l + (size_t)(cidx * 9 + 3 * slot + 2) * 2048 + col0;
        f32x4 gv[2][2];
#pragma unroll
        for (int bj = 0; bj < 2; ++bj)
#pragma unroll
            for (int n = 0; n < 2; ++n) gv[bj][n] = *(const f32x4*)(g + bj * HALF + n * 16) * coef;
#pragma unroll
        for (int ai = 0; ai < 2; ++ai)
#pragma unroll
            for (int m = 0; m < 4; ++m) { float* rowp = X + (size_t)(row0 + ai * HALF + m * 16) * ldx + col0;
#pragma unroll
                for (int bj = 0; bj < 2; ++bj)
#pragma unroll
                    for (int n = 0; n < 2; ++n) { f32x4* p = (f32x4*)(rowp + bj * HALF + n * 16); *p = *p + gv[bj][n] * acc[ai][bj][m][n]; } }
    }
};
struct EpiZ {
    static constexpr bool PERM = false, AFTER_DRAIN = false;
    float* ZF; bf16_t* QB; bf16_t* KB; bf16_t* VT; bf16_t* GB; float* outk; float* outv; int layer; float* Q32;
    __device__ __forceinline__ void operator()(const f32x4 (&acc)[2][2][4][2], const Unit& u, int wr, int wc, int fr_, int fq_) const {
        const int fr = opq_(fr_), fq = opq_(fq_);
        const int rl0 = wr * 64 + fr, ct0 = wc * 32 + 4 * fq, pn = u.pn;
#if PROBE_QKV32
        if (pn >= 10 && pn < 22) { float* base = Q32 + (size_t)(u.pm * BM + rl0) * 3072 + (pn - 10) * 256 + ct0;
#pragma unroll
            for (int ai = 0; ai < 2; ++ai)
#pragma unroll
                for (int m = 0; m < 4; ++m) { float* rowp = base + (size_t)(ai * HALF + m * 16) * 3072;
#pragma unroll
                    for (int bj = 0; bj < 2; ++bj)
#pragma unroll
                        for (int n = 0; n < 2; ++n) *(f32x4*)(rowp + bj * HALF + n * 16) = acc[ai][bj][m][n]; } }
#endif
        if (pn < 10 || (pn >= 22 && pn < 26)) {
            float* base = ZF + (size_t)(u.pm * BM + rl0) * 3584 + (pn < 10 ? pn * 256 : 2560 + (pn - 22) * 256) + ct0;
#pragma unroll
            for (int ai = 0; ai < 2; ++ai)
#pragma unroll
                for (int m = 0; m < 4; ++m) { float* rowp = base + (size_t)(ai * HALF + m * 16) * 3584;
#pragma unroll
                    for (int bj = 0; bj < 2; ++bj)
#pragma unroll
                        for (int n = 0; n < 2; ++n) *(f32x4*)(rowp + bj * HALF + n * 16) = acc[ai][bj][m][n]; }
        } else if (pn < 18) {
            bf16_t* dst = (pn < 14 ? QB + (pn - 10) * 256 : KB + (pn - 14) * 256) + (size_t)(u.pm * BM + rl0) * 1024 + ct0;
            float* ko = (pn >= 14 && u.pm < 16) ? outk + ((size_t)(u.pm * 2 + layer) * 256 + rl0) * 1024 + (pn - 14) * 256 + ct0 : nullptr;
#pragma unroll
            for (int ai = 0; ai < 2; ++ai)
#pragma unroll
                for (int m = 0; m < 4; ++m) { const size_t ro = (size_t)(ai * HALF + m * 16) * 1024;
#pragma unroll
                    for (int bj = 0; bj < 2; ++bj)
#pragma unroll
                        for (int n = 0; n < 2; ++n) { const f32x4 v = acc[ai][bj][m][n]; u32x2 w; w.x = cvt_pk_bf16(v[0], v[1]); w.y = cvt_pk_bf16(v[2], v[3]);
                            *(u32x2*)(dst + ro + bj * HALF + n * 16) = w; if (ko) *(f32x4*)(ko + ro + bj * HALF + n * 16) = v; } }
        } else if (pn < 22) {
            const bool ctx = u.pm < 16; const int L = ctx ? 256 : 1024, t0 = (ctx ? 0 : ((u.pm - 16) & 3) * 256) + rl0;
            bf16_t* vb = ctx ? VT + (size_t)u.pm * 8 * 128 * 256 : VT + (size_t)4096 * 1024 + (size_t)((u.pm - 16) >> 2) * 8 * 128 * 1024;
            vb += (size_t)(2 * (pn - 18)) * 128 * L + (size_t)ct0 * L + t0;
            float* vo = ctx ? outv + ((size_t)(u.pm * 2 + layer) * 256 + rl0) * 1024 + (pn - 18) * 256 + ct0 : nullptr;
#pragma unroll
            for (int ai = 0; ai < 2; ++ai)
#pragma unroll
                for (int m = 0; m < 4; ++m) { const int tr = ai * HALF + m * 16;
#pragma unroll
                    for (int bj = 0; bj < 2; ++bj)
#pragma unroll
                        for (int n = 0; n < 2; ++n) { const f32x4 v = acc[ai][bj][m][n]; bf16_t* p = vb + (size_t)(bj * 128 + n * 16) * L + tr;
                            const unsigned w0 = cvt_pk_bf16(v[0], v[1]), w1 = cvt_pk_bf16(v[2], v[3]);
                            p[0] = (bf16_t)(w0 & 0xffffu); p[L] = (bf16_t)(w0 >> 16); p[2 * L] = (bf16_t)(w1 & 0xffffu); p[3 * L] = (bf16_t)(w1 >> 16);
                            if (vo) *(f32x4*)(vo + (size_t)tr * 1024 + bj * HALF + n * 16) = v; } }
        } else {
            bf16_t* dst = GB + (size_t)(u.pm * BM + rl0) * 6144 + (pn - 26) * 256 + ct0;
#pragma unroll
            for (int ai = 0; ai < 2; ++ai)
#pragma unroll
                for (int m = 0; m < 4; ++m) { const size_t ro = (size_t)(ai * HALF + m * 16) * 6144;
#pragma unroll
                    for (int bj = 0; bj < 2; ++bj)
#pragma unroll
                        for (int n = 0; n < 2; ++n) { const f32x4 v = acc[ai][bj][m][n]; u32x2 w; w.x = cvt_pk_bf16(sigmoid_f(v[0]), sigmoid_f(v[1])); w.y = cvt_pk_bf16(sigmoid_f(v[2]), sigmoid_f(v[3]));
#if PROBE_GCONST
                            w.x = 0x3f003f00u; w.y = 0x3f003f00u;
#endif
#if PROBE_GRAW
                            w.x = cvt_pk_bf16(v[0] * 0.01f, v[1] * 0.01f); w.y = cvt_pk_bf16(v[2] * 0.01f, v[3] * 0.01f);
#endif
                            *(u32x2*)(dst + ro + bj * HALF + n * 16) = w; } }
        }
    }
};
struct EpiMerge {
    static constexpr bool PERM = false, AFTER_DRAIN = false;
    const bf16_t* Gg; float* MACC; bf16_t* MB; int mode;
    __device__ __forceinline__ void operator()(const f32x4 (&acc)[2][2][4][2], const Unit& u, int wr, int wc, int fr_, int fq_) const {
        const int fr = opq_(fr_), fq = opq_(fq_);
        const int row0 = u.pm * BM + wr * 64 + fr, col0 = u.pn * BM + wc * 32 + 4 * fq;
#pragma unroll
        for (int ai = 0; ai < 2; ++ai)
#pragma unroll
            for (int m = 0; m < 4; ++m) { const size_t row = (size_t)(row0 + ai * HALF + m * 16);
#pragma unroll
                for (int bj = 0; bj < 2; ++bj)
#pragma unroll
                    for (int n = 0; n < 2; ++n) { const int c = col0 + bj * HALF + n * 16;
#if PROBE_NOGATE
                        const u32x2 gw = {0x3f003f00u, 0x3f003f00u}; f32x4 v = acc[ai][bj][m][n];
#else
                        const u32x2 gw = *(const u32x2*)(Gg + row * 6144 + c); f32x4 v = acc[ai][bj][m][n];
#endif
                        v[0] *= __uint_as_float(gw.x << 16); v[1] *= __uint_as_float(gw.x & 0xffff0000u); v[2] *= __uint_as_float(gw.y << 16); v[3] *= __uint_as_float(gw.y & 0xffff0000u);
                        f32x4* mp = (f32x4*)(MACC + row * 2048 + c);
                        if (mode == 0) *mp = v;
                        else if (mode == 1) *mp = *mp + v;
                        else { v = *mp + v; u32x2 w; w.x = cvt_pk_bf16(v[0], v[1]); w.y = cvt_pk_bf16(v[2], v[3]); *(u32x2*)(MB + row * 2048 + c) = w; } } }
    }
};
template <class Epi, class Sched, bool ALIGN_EPI = false, bool SP2 = false>
__device__ __forceinline__ void gemm_phase(PG8_LAS unsigned char* lds, const Gemm g, const Sched& S, const Epi& E) {
    int tid_ = threadIdx.x; asm volatile("" : "+v"(tid_));
    const int tid = tid_, wid = __builtin_amdgcn_readfirstlane(tid >> 6), lane = tid & 63, wr = wid >> 2, wc = wid & 3, fr = lane & 15, fq = lane >> 4;
    const int K = g.K, nt = K / BK;
    unsigned voffA[2], voffB[2];
#pragma unroll
    for (int i = 0; i < 2; ++i) { int R, C; stage_rc(tid * 16 + i * 8192, R, C); const int Rb = Epi::PERM ? ((R & ~31) + perm32(R & 31)) : R;
        voffA[i] = (unsigned)(R * K + C) * 2u; voffB[i] = (unsigned)(Rb * K + C) * 2u; }
    const size_t kstep = (size_t)(BK * 2);
    const size_t hstep = (size_t)HALF * K * 2;
    const size_t tstep = 2 * hstep;
    const unsigned ldsw = (unsigned)wid * 1024u;
    const int aoff = lds_byte(wr * 64 + fr, fq * 8), boff = lds_byte(wc * 32 + fr, fq * 8);
#define PG8_SA(b, h) (((b) * 2 + (h)) * HTB)
#define PG8_SB(b, h) ((4 + (b) * 2 + (h)) * HTB)
#define PG8_STAGE(bufoff, gbase, voff) do { _Pragma("unroll") for (int _i = 0; _i < 2; ++_i) \
        __builtin_amdgcn_global_load_lds((const unsigned*)((const char*)(gbase) + (voff)[_i]), (PG8_LAS unsigned*)(lds + (bufoff) + ldsw + _i * 8192), 16, 0, 0); } while (0)
#define PG8_LDA(dst, b, h) do { _Pragma("unroll") for (int m = 0; m < 4; ++m) _Pragma("unroll") for (int k = 0; k < 2; ++k) dst[m][k] = *(const PG8_LAS bf16x8*)(lds + PG8_SA(b, h) + aoff + m * 2048 + k * 1024); } while (0)
#define PG8_LDB(dst, b, h) do { _Pragma("unroll") for (int n = 0; n < 2; ++n) _Pragma("unroll") for (int k = 0; k < 2; ++k) dst[n][k] = *(const PG8_LAS bf16x8*)(lds + PG8_SB(b, h) + boff + n * 2048 + k * 1024); } while (0)
#define PG8_MMA(ai, bj, At, Bt) do { __builtin_amdgcn_s_setprio(1); _Pragma("unroll") for (int m = 0; m < 4; ++m) _Pragma("unroll") for (int n = 0; n < 2; ++n) _Pragma("unroll") for (int k = 0; k < 2; ++k) \
        acc[ai][bj][m][n] = __builtin_amdgcn_mfma_f32_16x16x32_bf16(Bt[n][k], At[m][k], acc[ai][bj][m][n], 0, 0, 0); __builtin_amdgcn_s_setprio(0); } while (0)
#define PG8_WAIT_V(n) asm volatile("s_waitcnt vmcnt(" #n ")" ::: "memory")
#define PG8_WAIT_L(n) asm volatile("s_waitcnt lgkmcnt(" #n ")" ::: "memory")
#define PG8_BAR __builtin_amdgcn_s_barrier()
#define PG8_SCHED __builtin_amdgcn_sched_barrier(0)
    Unit cur, nxt; int ui = 0;
    if (!S.next(0, cur)) return;
    f32x4 acc[2][2][4][2];
#pragma unroll
    for (int a = 0; a < 2; ++a)
#pragma unroll
        for (int b = 0; b < 2; ++b)
#pragma unroll
            for (int m = 0; m < 4; ++m)
#pragma unroll
                for (int n = 0; n < 2; ++n) acc[a][b][m][n] = (f32x4){0.f, 0.f, 0.f, 0.f};
    bf16x8 At[4][2], B0[2][2], B1[2][2];
    const char* cA = (const char*)g.A + (size_t)cur.pm * tstep; const char* cB = (const char*)g.Bt + (size_t)cur.pn * tstep;
    S.a_ready(cur);
    if constexpr (SP2) {
        PG8_STAGE(PG8_SB(0, 0), cB, voffB); PG8_STAGE(PG8_SB(0, 1), cB + hstep, voffB); PG8_STAGE(PG8_SA(0, 0), cA, voffA); PG8_STAGE(PG8_SA(0, 1), cA + hstep, voffA);
        if (wr == 1) PG8_BAR;
        PG8_WAIT_V(2); PG8_BAR;
        PG8_STAGE(PG8_SB(1, 0), cB + kstep, voffB); PG8_STAGE(PG8_SA(1, 0), cA + kstep, voffA); PG8_STAGE(PG8_SB(1, 1), cB + hstep + kstep, voffB);
        PG8_WAIT_V(6); PG8_BAR;
    } else {
        PG8_STAGE(PG8_SB(0, 0), cB, voffB); PG8_STAGE(PG8_SA(0, 0), cA, voffA); PG8_STAGE(PG8_SB(0, 1), cB + hstep, voffB); PG8_STAGE(PG8_SA(0, 1), cA + hstep, voffA);
        if (wr == 1) PG8_BAR;
        PG8_WAIT_V(4); PG8_BAR;
        PG8_STAGE(PG8_SB(1, 0), cB + kstep, voffB); PG8_STAGE(PG8_SA(1, 0), cA + kstep, voffA); PG8_STAGE(PG8_SB(1, 1), cB + hstep + kstep, voffB);
        PG8_WAIT_V(6); PG8_BAR;
    }
    for (;;) {
        const bool has_next = S.next(ui + 1, nxt);
        const char* nA = has_next ? (const char*)g.A + (size_t)nxt.pm * tstep : cA; const char* nB = has_next ? (const char*)g.Bt + (size_t)nxt.pn * tstep : cB;
        for (int t = 0; t < nt; t += 2) {
            const bool last = (t == nt - 2);
            const char* a1 = cA + (size_t)(t + 1) * kstep;
            const char* a2 = last ? nA : cA + (size_t)(t + 2) * kstep; const char* b2 = last ? nB : cB + (size_t)(t + 2) * kstep;
            const char* a3 = a2 + kstep; const char* b3 = b2 + kstep;
            if (last && has_next) S.a_ready(nxt);
            if constexpr (SP2) {
            PG8_LDB(B0, 0, 0); PG8_LDB(B1, 0, 1); PG8_SCHED; PG8_LDA(At, 0, 0); PG8_STAGE(PG8_SA(1, 1), a1 + hstep, voffA);
            PG8_WAIT_V(8); PG8_WAIT_L(0); PG8_BAR; PG8_MMA(0, 0, At, B0); PG8_MMA(0, 1, At, B1); PG8_BAR; PG8_SCHED;
            PG8_LDA(At, 0, 1); PG8_STAGE(PG8_SB(0, 0), b2, voffB); PG8_STAGE(PG8_SB(0, 1), b2 + hstep, voffB); PG8_STAGE(PG8_SA(0, 0), a2, voffA);
            PG8_WAIT_V(8); PG8_WAIT_L(0); PG8_BAR; PG8_MMA(1, 0, At, B0); PG8_MMA(1, 1, At, B1); PG8_BAR; PG8_SCHED;
            PG8_LDB(B0, 1, 0); PG8_LDB(B1, 1, 1); PG8_SCHED; PG8_LDA(At, 1, 0); PG8_STAGE(PG8_SA(0, 1), a2 + hstep, voffA);
            PG8_WAIT_V(8); PG8_WAIT_L(0); PG8_BAR; PG8_MMA(0, 0, At, B0); PG8_MMA(0, 1, At, B1); PG8_BAR; PG8_SCHED;
            PG8_LDA(At, 1, 1); PG8_STAGE(PG8_SB(1, 0), b3, voffB); PG8_STAGE(PG8_SB(1, 1), b3 + hstep, voffB); PG8_STAGE(PG8_SA(1, 0), a3, voffA);
            PG8_WAIT_V(8); PG8_WAIT_L(0); PG8_BAR; PG8_MMA(1, 0, At, B0); PG8_MMA(1, 1, At, B1); PG8_BAR; PG8_SCHED;
            } else {
            PG8_LDB(B0, 0, 0); PG8_SCHED; PG8_LDA(At, 0, 0); PG8_STAGE(PG8_SA(1, 1), a1 + hstep, voffA);
            PG8_WAIT_L(8); PG8_BAR; PG8_WAIT_L(0); PG8_MMA(0, 0, At, B0); PG8_BAR; PG8_SCHED;
            PG8_LDB(B1, 0, 1); PG8_STAGE(PG8_SB(0, 0), b2, voffB);
            PG8_BAR; PG8_WAIT_L(0); PG8_MMA(0, 1, At, B1); PG8_BAR;
            PG8_LDA(At, 0, 1); PG8_STAGE(PG8_SA(0, 0), a2, voffA);
            PG8_BAR; PG8_WAIT_L(0); PG8_MMA(1, 0, At, B0); PG8_BAR; PG8_SCHED;
            PG8_STAGE(PG8_SB(0, 1), b2 + hstep, voffB);
            PG8_WAIT_V(6); PG8_BAR; PG8_MMA(1, 1, At, B1); PG8_BAR;
            PG8_LDB(B0, 1, 0); PG8_SCHED; PG8_LDA(At, 1, 0); PG8_STAGE(PG8_SA(0, 1), a2 + hstep, voffA);
            PG8_WAIT_L(8); PG8_BAR; PG8_WAIT_L(0); PG8_MMA(0, 0, At, B0); PG8_BAR; PG8_SCHED;
            PG8_LDB(B1, 1, 1); PG8_STAGE(PG8_SB(1, 0), b3, voffB);
            PG8_BAR; PG8_WAIT_L(0); PG8_MMA(0, 1, At, B1); PG8_BAR;
            PG8_LDA(At, 1, 1); PG8_STAGE(PG8_SA(1, 0), a3, voffA);
            PG8_BAR; PG8_WAIT_L(0); PG8_MMA(1, 0, At, B0); PG8_BAR; PG8_SCHED;
            PG8_STAGE(PG8_SB(1, 1), b3 + hstep, voffB);
            PG8_WAIT_V(6); PG8_BAR; PG8_MMA(1, 1, At, B1); PG8_BAR;
            }
        }
        if constexpr (ALIGN_EPI) { if (wr == 0) PG8_BAR; }
        if constexpr (!Epi::AFTER_DRAIN) { E(acc, cur, wr, wc, fr, fq); S.done(cur); }
        if (!has_next) break;
#pragma unroll
        for (int a = 0; a < 2; ++a)
#pragma unroll
            for (int b = 0; b < 2; ++b)
#pragma unroll
                for (int m = 0; m < 4; ++m)
#pragma unroll
                    for (int n = 0; n < 2; ++n) acc[a][b][m][n] = (f32x4){0.f, 0.f, 0.f, 0.f};
        cur = nxt; cA = nA; cB = nB; ++ui;
        if constexpr (ALIGN_EPI) { if (wr == 1) PG8_BAR; }
    }
    PG8_WAIT_V(0);
    if constexpr (!ALIGN_EPI) { if (wr == 0) PG8_BAR; }
    PG8_BAR;
    if constexpr (Epi::AFTER_DRAIN) { E.fused(acc, cur, wr, wc, fr, fq, lds, wid, lane); S.done(cur); }
#undef PG8_SA
#undef PG8_SB
#undef PG8_STAGE
#undef PG8_LDA
#undef PG8_LDB
#undef PG8_MMA
#undef PG8_WAIT_V
#undef PG8_WAIT_L
#undef PG8_BAR
#undef PG8_SCHED
}
}

constexpr int DM = 2048, DFF = 5632, DIN = 12800, NCTX = 4096, NLAT = 2048, MTOK = 6144, DEPTH = 2;
constexpr int SEQ = 256, DSEQ = 1024, NSEQ = 18;
constexpr int ZQ = 0, ZFF = 512, ZFB = 1024, ZI = 1536, ZO = 2048, ZLX = 2560, ZLG = 3072, ZFW = 3584;
constexpr int NWAVES = 8, NTHREADS = 512;
constexpr size_t MiB = 1u << 20;
constexpr size_t WS_CTL = 0, CTL_ZERO_BYTES = 1 * MiB;
constexpr size_t WS_W = 2 * MiB, W_LAYER = 198 * MiB;
constexpr size_t WO_UP1 = 0, WO_DN1 = 44 * MiB, WO_UP2 = 66 * MiB, WO_DN2 = 110 * MiB, WO_IN = 132 * MiB, WO_PA = 182 * MiB, WO_PB = 184 * MiB, WO_PC = 188 * MiB, WO_OUT = 190 * MiB;
constexpr size_t WS_X = 398 * MiB;
constexpr size_t WS_H = 446 * MiB;
constexpr size_t WS_HID = 470 * MiB;
constexpr size_t WS_ZF = 536 * MiB;
constexpr size_t WS_QB = 620 * MiB;
constexpr size_t WS_KB = 632 * MiB;
constexpr size_t WS_VT = 644 * MiB;
constexpr size_t WS_GB = 656 * MiB;
constexpr size_t WS_CKB = 728 * MiB;
constexpr size_t WS_CVT = 732 * MiB;
constexpr size_t WS_OA = 836 * MiB, WS_OB = 842 * MiB, WS_OC = 854 * MiB;
constexpr size_t WS_MACC = 860 * MiB;
constexpr size_t WS_MB = 908 * MiB;
constexpr size_t WS_MODP = 932 * MiB;
constexpr size_t WS_MODS = 946 * MiB;
constexpr size_t WS_HOL = 947 * MiB;
constexpr size_t WS_HQD = 971 * MiB;
constexpr size_t WS_HSL = 995 * MiB;
constexpr size_t WS_HDEC = 1043 * MiB;
constexpr size_t WS_LHL = 1044 * MiB;
constexpr size_t WS_LPP = 1068 * MiB;
constexpr size_t WS_END = 1092 * MiB;
constexpr int CW_BAR = 4096;
constexpr int CW_Q = 16384;
constexpr int RING_BYTES = 131072, LDSCTL_OFF = 143360, LDS_BYTES = 147456;

#define GAS __attribute__((address_space(1)))
#define LAS __attribute__((address_space(3)))
typedef unsigned short bf16;
typedef unsigned v4u __attribute__((ext_vector_type(4)));
typedef unsigned v2u __attribute__((ext_vector_type(2)));
typedef float f32x4 __attribute__((ext_vector_type(4)));
typedef short bf16x8 __attribute__((ext_vector_type(8)));
typedef GAS unsigned gu32;
#define RLX_AGENT __ATOMIC_RELAXED, __HIP_MEMORY_SCOPE_AGENT
#define LDS_WAIT() asm volatile("s_waitcnt lgkmcnt(0)" ::: "memory")
#define VM_WAIT() asm volatile("s_waitcnt vmcnt(0)" ::: "memory")
__device__ __forceinline__ unsigned f2bf(float f) { unsigned u = __builtin_bit_cast(unsigned, f); return (u + 0x7fffu + ((u >> 16) & 1u)) >> 16; }
__device__ __forceinline__ unsigned pk2(float lo, float hi) { return pg8::cvt_pk_bf16(lo, hi); }
__device__ __forceinline__ float wave_sum(float v) {
#pragma unroll
    for (int o = 1; o < 64; o <<= 1) v += __shfl_xor(v, o);
    return v;
}
using pg8::silu_f; using pg8::sigmoid_f;
#define XB_TMO      128
#define XB_XCNT(j)  (256  + 64 * (j))
#define XB_XSUB(j)  (1280 + 64 * (j))
#define XB_XGEN(j)  (2304 + 64 * (j))
#define XB_TOP      3328
#define XB_TOPGEN   3392
#define XCD_BAR_WORDS 3456
#define XB_SPIN_CAP (1u << 18)

__device__ __forceinline__ unsigned xb_ld(unsigned* p)              { return __hip_atomic_load(p, __ATOMIC_RELAXED, __HIP_MEMORY_SCOPE_AGENT); }
__device__ __forceinline__ unsigned xb_add(unsigned* p, unsigned v) { return __hip_atomic_fetch_add(p, v, __ATOMIC_RELAXED, __HIP_MEMORY_SCOPE_AGENT); }
__device__ __forceinline__ unsigned xb_xcc_id() { return (unsigned)__builtin_amdgcn_s_getreg((3 << 11) | 20) & 0xFu; }
#define XB_SPIN(cond, bar) do { unsigned _sp = 0; while (cond) { __builtin_amdgcn_s_sleep(1); \
    if ((++_sp & 255u) == 0u) { if (xb_ld(&(bar)[XB_TMO])) break; if (_sp > XB_SPIN_CAP) { atomicAdd(&(bar)[XB_TMO], 1u); break; } } } } while (0)

struct XcdBarrier {
    unsigned* bar; unsigned x;
    volatile LAS unsigned* st;
};

__device__ __forceinline__ XcdBarrier xcd_barrier_post(unsigned* bar, volatile LAS unsigned* st) {
    XcdBarrier b; b.bar = bar; b.x = xb_xcc_id(); b.st = st;
    if (threadIdx.x == 0) (void)xb_add(&bar[XB_XCNT(b.x)], 1u);
    return b;
}
__device__ __forceinline__ void xcd_barrier_complete(unsigned* bar, unsigned x, unsigned& nloc, unsigned& nx) {
    const unsigned G = gridDim.x * gridDim.y * gridDim.z;
    unsigned sum, cnt, mine, sp = 0u;
    for (;;) {
        sum = 0u; cnt = 0u; mine = 0u;
#pragma unroll
        for (unsigned j = 0; j < 16; ++j) { const unsigned c = xb_ld(&bar[XB_XCNT(j)]); sum += c; cnt += (c > 0u) ? 1u : 0u; mine = (j == x) ? c : mine; }
        if (sum == G) break;
        __builtin_amdgcn_s_sleep(1);
        if ((++sp & 255u) == 0u) { if (xb_ld(&bar[XB_TMO])) break; if (sp > XB_SPIN_CAP) { atomicAdd(&bar[XB_TMO], 1u); break; } }
    }
    nloc = mine > 0u ? mine : 1u; nx = cnt > 0u ? cnt : 1u;
}

__device__ __forceinline__ void xcd_barrier(const XcdBarrier& b) {
    asm volatile("s_waitcnt vmcnt(0)" ::: "memory");
    __syncthreads();
    if (threadIdx.x == 0) {
        unsigned* bar = b.bar;
        __builtin_amdgcn_s_waitcnt(0);
        unsigned nloc = b.st[0], nx = b.st[1];
        if (nloc == 0u) { xcd_barrier_complete(bar, b.x, nloc, nx); b.st[0] = nloc; b.st[1] = nx; }
        const unsigned old = xb_add(&bar[XB_XSUB(b.x)], 1u);
        const unsigned gen = old / nloc;
        if (old + 1u == (gen + 1u) * nloc) {
            __builtin_amdgcn_fence(__ATOMIC_RELEASE, "agent");
            asm volatile("s_waitcnt vmcnt(0)" ::: "memory");
            const unsigned og = xb_add(&bar[XB_TOP], 1u);
            const unsigned tg = og / nx;
            if (og + 1u == (tg + 1u) * nx) xb_add(&bar[XB_TOPGEN], 1u);
            else XB_SPIN(xb_ld(&bar[XB_TOPGEN]) == tg, bar);
            __builtin_amdgcn_fence(__ATOMIC_ACQUIRE, "agent");
            xb_add(&bar[XB_XGEN(b.x)], 1u);
            asm volatile("s_waitcnt vmcnt(0)" ::: "memory");
        } else {
            XB_SPIN(xb_ld(&bar[XB_XGEN(b.x)]) == gen, bar);
            __builtin_amdgcn_fence(__ATOMIC_ACQUIRE, "agent");
            asm volatile("s_waitcnt vmcnt(0)" ::: "memory");
        }
    }
    __syncthreads();
}

struct Args { const float* in[31]; float* out; unsigned char* ws; int ph_lo, ph_hi; };
enum { I_XP = 0, I_XS, I_CK, I_CV, I_SHG, I_SLRU, I_C, I_CCTX, I_MODW, I_MODB, I_NORMG, I_F1UP, I_F1DN, I_F2UP, I_F2DN, I_WIN, I_LBL, I_HGN, I_RPB, I_CONVW, I_CONVB,
       I_LWA, I_LBA, I_LWX, I_LBX, I_LAM, I_PA, I_PB, I_PC, I_WOUT, I_FNG };
constexpr size_t OUT_Y = 0, OUT_K = 12582912, OUT_V = 20971520, OUT_SH = 29360128, OUT_SL = 33554432;

#ifndef PROBE_ZERO_YS
#define PROBE_ZERO_YS 0
#endif
#ifndef PROBE_ZERO_YP
#define PROBE_ZERO_YP 0
#endif
struct Frame { LAS unsigned char* lds; int tid, lane, wave, G, gw, NGW; };
__device__ __forceinline__ int opq(int v) { asm volatile("" : "+v"(v)); return v; }

__device__ __forceinline__ int next_unit(gu32* head, volatile LAS unsigned* slot) {
    __syncthreads();
    if (threadIdx.x == 0) *slot = __hip_atomic_fetch_add(head, 1u, RLX_AGENT);
    __syncthreads();
    return (int)*slot;
}

__device__ __forceinline__ void p0_transpose_item(const float* W, int K, int N, bf16* WT, int dst_row0, LAS float* scr, int k0, int n0, int lane) {
#pragma unroll 8
    for (int i = 0; i < 32; ++i) { const int kk = 2 * i + (lane >> 5); scr[kk * 33 + (lane & 31)] = __builtin_nontemporal_load(W + (size_t)(k0 + kk) * N + n0 + (lane & 31)); }
    LDS_WAIT(); asm volatile("" ::: "memory");
    const int c = lane & 7;
#pragma unroll
    for (int j = 0; j < 4; ++j) { const int n = (lane >> 3) + 8 * j; const LAS float* s = scr + (8 * c) * 33 + n;
        v4u o; o.x = pk2(s[0 * 33], s[1 * 33]); o.y = pk2(s[2 * 33], s[3 * 33]); o.z = pk2(s[4 * 33], s[5 * 33]); o.w = pk2(s[6 * 33], s[7 * 33]);
        *(v4u*)(WT + (size_t)(dst_row0 + n) * K + k0 + 8 * c) = o; }
    LDS_WAIT(); asm volatile("" ::: "memory");
}
constexpr int CV_UP = 32 * 352, CV_DN = 88 * 64, CV_IN = 32 * 400, CV_A = 8 * 64, CV_B = 16 * 64, CV_O = 32 * 64, CV_PER_LAYER = 2 * CV_UP + 2 * CV_DN + CV_IN + 2 * CV_A + CV_B + CV_O;
constexpr int CV_CLAIM = 16, CV_CPL = CV_PER_LAYER / CV_CLAIM, CV_NCLAIM = DEPTH * CV_CPL, CV_STATIC = CV_UP / CV_CLAIM;
static_assert(CV_PER_LAYER % CV_CLAIM == 0 && CV_UP % CV_CLAIM == 0, "claims");
__device__ __forceinline__ int cv_need(int l, int j) {
    constexpr int T_DN1 = (CV_UP + CV_DN) / CV_CLAIM, T_IN = T_DN1 + CV_IN / CV_CLAIM, T_MRG = T_IN + (2 * CV_A + CV_B) / CV_CLAIM, T_OUT = T_MRG + CV_O / CV_CLAIM, T_UP2 = T_OUT + CV_UP / CV_CLAIM, T_DN2 = T_UP2 + CV_DN / CV_CLAIM;
    const int r = j == 0 ? T_DN1 : j <= 2 ? T_IN : j <= 5 ? T_MRG : j == 6 ? T_OUT : j <= 8 ? T_UP2 : j == 9 ? T_DN2 : T_DN2 + CV_STATIC;
    const int n = l * CV_CPL + r; return n < CV_NCLAIM ? n : CV_NCLAIM;
}
__device__ __forceinline__ void cv_item(const Args& A, int it, LAS float* scr, int lane) {
    const int l = it / CV_PER_LAYER; int r = it % CV_PER_LAYER;
    unsigned char* wl = A.ws + WS_W + (size_t)l * W_LAYER;
    const float* W; int K, N; bf16* WT; int up = 0;
    if (r < CV_UP) { W = A.in[I_F1UP] + (size_t)l * DM * 2 * DFF; K = DM; N = 2 * DFF; WT = (bf16*)(wl + WO_UP1); up = 1; }
    else if ((r -= CV_UP) < CV_DN) { W = A.in[I_F1DN] + (size_t)l * DFF * DM; K = DFF; N = DM; WT = (bf16*)(wl + WO_DN1); }
    else if ((r -= CV_DN) < CV_IN) { W = A.in[I_WIN] + (size_t)l * DM * DIN; K = DM; N = DIN; WT = (bf16*)(wl + WO_IN); }
    else if ((r -= CV_IN) < CV_A) { W = A.in[I_PA] + (size_t)l * 512 * DM; K = 512; N = DM; WT = (bf16*)(wl + WO_PA); }
    else if ((r -= CV_A) < CV_B) { W = A.in[I_PB] + (size_t)l * 1024 * DM; K = 1024; N = DM; WT = (bf16*)(wl + WO_PB); }
    else if ((r -= CV_B) < CV_A) { W = A.in[I_PC] + (size_t)l * 512 * DM; K = 512; N = DM; WT = (bf16*)(wl + WO_PC); }
    else if ((r -= CV_A) < CV_O) { W = A.in[I_WOUT] + (size_t)l * DM * DM; K = DM; N = DM; WT = (bf16*)(wl + WO_OUT); }
    else if ((r -= CV_O) < CV_UP) { W = A.in[I_F2UP] + (size_t)l * DM * 2 * DFF; K = DM; N = 2 * DFF; WT = (bf16*)(wl + WO_UP2); up = 1; }
    else { r -= CV_UP; W = A.in[I_F2DN] + (size_t)l * DFF * DM; K = DFF; N = DM; WT = (bf16*)(wl + WO_DN2); }
    const int nblk = N / 32, kb = r / nblk, nb = r % nblk, n0 = 32 * nb;
    int drow = n0;
    if (up) { const int j0 = n0 < DFF ? n0 : n0 - DFF; drow = 256 * (j0 >> 7) + (j0 & 127) + (n0 < DFF ? 0 : 128); }
    p0_transpose_item(W, K, N, WT, drow, scr, 64 * kb, n0, lane);
}
__device__ __forceinline__ void p0_convert(const Frame& F_, const Args& A) {
    Frame F = F_; F.tid = opq(F_.tid); F.lane = F.tid & 63;
    LAS float* scr = (LAS float*)(F.lds + F.wave * 16384);
    for (int it = F.gw; it < CV_UP; it += F.NGW) cv_item(A, it, scr, F.lane);
}
__device__ __forceinline__ void cv_until(const Frame& F_, const Args& A, gu32* head, int need, gu32* fin, volatile LAS unsigned* slot) {
    Frame F = F_; F.tid = opq(F_.tid); F.lane = F.tid & 63;
    LAS float* scr = (LAS float*)(F.lds + F.wave * 16384);
    if (fin) { __syncthreads(); if (F.tid == 0) __hip_atomic_fetch_add(fin, 1u, RLX_AGENT); }
    for (;;) {
        __syncthreads();
        if (F.tid == 0) { const unsigned f = fin ? __hip_atomic_load(fin, RLX_AGENT) : 0xffffffffu, h = CV_STATIC + __hip_atomic_load(head, RLX_AGENT);
            slot[1] = f; slot[0] = (h >= (unsigned)need && f >= (unsigned)F.G) ? 0x7fffffffu : CV_STATIC + __hip_atomic_fetch_add(head, 1u, RLX_AGENT); }
        __syncthreads();
        const int c = (int)slot[0]; const bool others_done = slot[1] >= (unsigned)F.G;
        if (c >= CV_NCLAIM) break;
        cv_item(A, c * CV_CLAIM + 2 * F.wave, scr, F.lane); cv_item(A, c * CV_CLAIM + 2 * F.wave + 1, scr, F.lane);
        if (c >= need && others_done) break;
    }
}
__device__ __forceinline__ void p0_cache(const Frame& F_, const Args& A) {
    Frame F = F_; F.tid = opq(F_.tid); F.lane = F.tid & 63;
    const int gt = blockIdx.x * NTHREADS + F.tid, NT = F.G * NTHREADS;
    bf16* CKB = (bf16*)(A.ws + WS_CKB); bf16* CVT = (bf16*)(A.ws + WS_CVT);
    for (int i = gt; i < 2 * 2 * 512 * 1024 / 8; i += NT) { const float* p = A.in[I_CK] + (size_t)i * 8; const f32x4 a = *(const f32x4*)p, b = *(const f32x4*)(p + 4);
        v4u o; o.x = pk2(a.x, a.y); o.y = pk2(a.z, a.w); o.z = pk2(b.x, b.y); o.w = pk2(b.z, b.w); *(v4u*)(CKB + (size_t)i * 8) = o; }
    for (int i = gt; i < 2 * 2 * 64 * 1024; i += NT) {
        const int hd = i & 1023, jb = (i >> 10) & 63, bl = i >> 16; const float* p = A.in[I_CV] + ((size_t)(bl * 512 + jb * 8)) * 1024 + hd;
        v4u o; o.x = pk2(p[0], p[1024]); o.y = pk2(p[2048], p[3072]); o.z = pk2(p[4096], p[5120]); o.w = pk2(p[6144], p[7168]);
        *(v4u*)(CVT + ((size_t)(bl * 8 + (hd >> 7)) * 128 + (hd & 127)) * 512 + jb * 8) = o; }
}
__device__ __forceinline__ void p0_mods_partial(const Frame& F_, const Args& A) {
    Frame F = F_; F.tid = opq(F_.tid); F.lane = F.tid & 63;
    float* MODP = (float*)(A.ws + WS_MODP);
    const float* cc = A.in[I_CCTX]; const float* c1 = A.in[I_C];
    for (int task = F.gw; task < 2 * 32 * 72; task += F.NGW) {
        const int l = task / 2304, r = task % 2304, kc = r / 72, nb = r % 72, n = nb * 256 + F.lane * 4;
        const float* w = A.in[I_MODW] + ((size_t)l * DM + kc * 64) * 18432 + n;
        f32x4 a0 = {0.f, 0.f, 0.f, 0.f}, a1 = a0, a2 = a0;
#pragma unroll 4
        for (int k = 0; k < 64; ++k) { const f32x4 wv = *(const f32x4*)(w + (size_t)k * 18432); const int kk = kc * 64 + k;
            const float s0 = silu_f(cc[kk]), s1 = silu_f(c1[kk]), s2 = silu_f(c1[DM + kk]);
            a0 += wv * s0; a1 += wv * s1; a2 += wv * s2; }
        float* o = MODP + (size_t)kc * 110592 + (size_t)l * 55296 + n;
        *(f32x4*)(o) = a0; *(f32x4*)(o + 18432) = a1; *(f32x4*)(o + 2 * 18432) = a2;
    }
}
__device__ __forceinline__ void p0_mods_reduce(const Frame& F_, const Args& A) {
    Frame F = F_; F.tid = opq(F_.tid); F.lane = F.tid & 63;
    const float* MODP = (const float*)(A.ws + WS_MODP); float* MODS = (float*)(A.ws + WS_MODS);
    for (int idx = blockIdx.x * NTHREADS + F.tid; idx < 110592; idx += F.G * NTHREADS) {
        const int l = idx / 55296, n = idx % 18432; float s = A.in[I_MODB][l * 18432 + n];
#pragma unroll 8
        for (int kc = 0; kc < 32; ++kc) s += MODP[(size_t)kc * 110592 + idx];
        MODS[idx] = s;
    }
}
template <int MODE>
__device__ __forceinline__ void norm_rows(const Frame& F_, const float* x0, const float* x1, float* xcopy, const float* g, const float* mods_l, int slot, bf16* H, float* outf) {
    Frame F = F_; F.tid = opq(F_.tid); F.lane = F.tid & 63;
    for (int row = F.gw; row < MTOK; row += F.NGW) {
        const float* xr = row < NCTX ? x0 + (size_t)row * DM : x1 + (size_t)(row - NCTX) * DM;
        const int cidx = row < NCTX ? 0 : 1 + ((row - NCTX) >> 10);
        f32x4 v[8]; float ss = 0.f;
#pragma unroll
        for (int j = 0; j < 8; ++j) { v[j] = *(const f32x4*)(xr + 4 * F.lane + 256 * j); ss += (v[j].x * v[j].x + v[j].y * v[j].y) + (v[j].z * v[j].z + v[j].w * v[j].w); }
        const float rstd = 1.0f / sqrtf(wave_sum(ss) * (1.0f / DM) + 1e-6f);
        if (MODE == 0) {
            const float* sh = mods_l + (size_t)(cidx * 9 + 3 * slot) * DM; const float* sc = sh + DM;
#pragma unroll
            for (int j = 0; j < 8; ++j) { const int c = 4 * F.lane + 256 * j; const f32x4 gg = *(const f32x4*)(g + c), s1 = *(const f32x4*)(sc + c), s0 = *(const f32x4*)(sh + c);
                const f32x4 y = v[j] * rstd * gg * (s1 + 1.0f) + s0; v2u o; o.x = pk2(y.x, y.y); o.y = pk2(y.z, y.w);
                *(v2u*)(H + (size_t)row * DM + c) = o;
                if (xcopy) *(f32x4*)(xcopy + (size_t)row * DM + c) = v[j]; }
        } else {
#pragma unroll
            for (int j = 0; j < 8; ++j) { const int c = 4 * F.lane + 256 * j; const f32x4 gg = *(const f32x4*)(g + c);
                f32x4 yv = v[j] * rstd * gg;
#if PROBE_ZERO_YS
                if (row >= NCTX) yv = (f32x4){0.f, 0.f, 0.f, 0.f};
#endif
#if PROBE_ZERO_YP
                if (row < NCTX) yv = (f32x4){0.f, 0.f, 0.f, 0.f};
#endif
                *(f32x4*)(outf + (size_t)row * DM + c) = yv; }
        }
    }
}

constexpr int AK_STRIDE = 272, AV_STRIDE = 528, A_K_OFF = 0, A_V_OFF = 69632;
constexpr float NA_SCALE = 0.08838834764831845f;
__device__ __forceinline__ void attn_stage(LAS unsigned char* lds, int tid, const bf16* kbase, size_t kstride, const bf16* vbase, size_t vstride) {
    v4u kx[8], vx[8];
#pragma unroll
    for (int i = 0; i < 8; ++i) { const int idx = tid + 512 * i; kx[i] = *(const v4u*)(kbase + (size_t)(idx >> 4) * kstride + (idx & 15) * 8); }
#pragma unroll
    for (int i = 0; i < 8; ++i) { const int idx = tid + 512 * i; vx[i] = *(const v4u*)(vbase + (size_t)(idx >> 5) * vstride + (idx & 31) * 8); }
#pragma unroll
    for (int i = 0; i < 8; ++i) { const int idx = tid + 512 * i; *(LAS v4u*)(lds + A_K_OFF + (idx >> 4) * AK_STRIDE + (idx & 15) * 16) = kx[i]; }
#pragma unroll
    for (int i = 0; i < 8; ++i) { const int idx = tid + 512 * i; *(LAS v4u*)(lds + A_V_OFF + (idx >> 5) * AV_STRIDE + (idx & 31) * 16) = vx[i]; }
}
template <class KF, class VF>
__device__ __forceinline__ void attn_stage32(LAS unsigned char* lds, int tid, KF kf, VF vf) {
    { const int key = tid >> 1, half = tid & 1; const float* p = kf(key) + 64 * half; LAS unsigned char* dst = lds + A_K_OFF + key * AK_STRIDE + half * 128;
#pragma unroll
      for (int i = 0; i < 8; ++i) { const f32x4 a = *(const f32x4*)(p + 8 * i), b = *(const f32x4*)(p + 8 * i + 4);
          v4u o; o.x = pk2(a.x, a.y); o.y = pk2(a.z, a.w); o.z = pk2(b.x, b.y); o.w = pk2(b.z, b.w); *(LAS v4u*)(dst + 16 * i) = o; } }
    { const int kp = tid >> 2, dq = tid & 3; const float* p0 = vf(2 * kp) + 32 * dq; const float* p1 = vf(2 * kp + 1) + 32 * dq;
#pragma unroll
      for (int i = 0; i < 8; ++i) { const f32x4 a = *(const f32x4*)(p0 + 4 * i), b = *(const f32x4*)(p1 + 4 * i);
#pragma unroll
          for (int j = 0; j < 4; ++j) *(LAS unsigned*)(lds + A_V_OFF + (32 * dq + 4 * i + j) * AV_STRIDE + kp * 4) = pk2(a[j], b[j]); } }
}
__device__ __forceinline__ void attn_load_q32(const float* qrow, int g, bf16x8 (&qf)[4]) {
#pragma unroll
    for (int s = 0; s < 4; ++s) { const f32x4 a = *(const f32x4*)(qrow + 32 * s + 8 * g), b = *(const f32x4*)(qrow + 32 * s + 8 * g + 4);
        v4u o; o.x = pk2(a.x, a.y); o.y = pk2(a.z, a.w); o.z = pk2(b.x, b.y); o.w = pk2(b.z, b.w); qf[s] = __builtin_bit_cast(bf16x8, o); }
}
struct AttnState { float m, l; f32x4 ot[8]; };
template <int NKS, bool LOCAL, class BF>
__device__ __forceinline__ void attn_chunk(LAS unsigned char* lds, const bf16x8 (&qf)[4], AttnState& st, int lane, int t0, BF bias) {
    const int g = lane >> 4, c = lane & 15;
    f32x4 sc[NKS][2];
#pragma unroll
    for (int i = 0; i < NKS; ++i) { const int T0 = LOCAL ? 4 * i + t0 : 2 * i;
#pragma unroll
        for (int a = 0; a < 2; ++a) { f32x4 acc = {0.f, 0.f, 0.f, 0.f};
#pragma unroll
            for (int s = 0; s < 4; ++s) { const bf16x8 kfr = *(const LAS bf16x8*)(lds + A_K_OFF + (16 * (T0 + a) + c) * AK_STRIDE + 64 * s + 16 * g);
                acc = __builtin_amdgcn_mfma_f32_16x16x32_bf16(kfr, qf[s], acc, 0, 0, 0); }
            sc[i][a] = acc; } }
    float mx = -3.0e38f;
#pragma unroll
    for (int i = 0; i < NKS; ++i) { const int T0 = LOCAL ? 4 * i + t0 : 2 * i;
#pragma unroll
        for (int a = 0; a < 2; ++a)
#pragma unroll
            for (int r = 0; r < 4; ++r) { float s = sc[i][a][r] * NA_SCALE; if (LOCAL) s = bias(16 * (T0 + a) + 4 * g + r, s); sc[i][a][r] = s; mx = fmaxf(mx, s); } }
    mx = fmaxf(mx, __shfl_xor(mx, 16)); mx = fmaxf(mx, __shfl_xor(mx, 32));
    const float mnew = fmaxf(st.m, mx), alpha = __expf(st.m - mnew); float sum = 0.f;
#pragma unroll
    for (int i = 0; i < NKS; ++i)
#pragma unroll
        for (int a = 0; a < 2; ++a)
#pragma unroll
            for (int r = 0; r < 4; ++r) { const float p = __expf(sc[i][a][r] - mnew); sc[i][a][r] = p; sum += p; }
    sum += __shfl_xor(sum, 16); sum += __shfl_xor(sum, 32);
    st.l = st.l * alpha + sum; st.m = mnew;
#pragma unroll
    for (int dt = 0; dt < 8; ++dt) st.ot[dt] = st.ot[dt] * alpha;
#pragma unroll
    for (int i = 0; i < NKS; ++i) { const int T0 = LOCAL ? 4 * i + t0 : 2 * i;
        v4u pb; pb.x = pk2(sc[i][0][0], sc[i][0][1]); pb.y = pk2(sc[i][0][2], sc[i][0][3]); pb.z = pk2(sc[i][1][0], sc[i][1][1]); pb.w = pk2(sc[i][1][2], sc[i][1][3]);
        const bf16x8 pfr = __builtin_bit_cast(bf16x8, pb);
#pragma unroll
        for (int dt = 0; dt < 8; ++dt) { const LAS unsigned char* vp = lds + A_V_OFF + (16 * dt + c) * AV_STRIDE + (16 * T0 + 4 * g) * 2;
            const v2u lo = *(const LAS v2u*)vp, hi = *(const LAS v2u*)(vp + 32); v4u av; av.x = lo.x; av.y = lo.y; av.z = hi.x; av.w = hi.y;
            st.ot[dt] = __builtin_amdgcn_mfma_f32_16x16x32_bf16(__builtin_bit_cast(bf16x8, av), pfr, st.ot[dt], 0, 0, 0); } }
}
__device__ __forceinline__ void attn_load_q(const bf16* qrow, int g, bf16x8 (&qf)[4]) {
#pragma unroll
    for (int s = 0; s < 4; ++s) qf[s] = *(const bf16x8*)(qrow + 32 * s + 8 * g);
}
__device__ __forceinline__ void attn_store(const AttnState& st, bf16* orow, int g) {
    const float inv = 1.0f / st.l;
#pragma unroll
    for (int dt = 0; dt < 8; ++dt) { v2u o; o.x = pk2(st.ot[dt][0] * inv, st.ot[dt][1] * inv); o.y = pk2(st.ot[dt][2] * inv, st.ot[dt][3] * inv); *(v2u*)(orow + 16 * dt + 4 * g) = o; }
}
__device__ __forceinline__ void attn_ctx_unit(const Frame& F_, const Args& A, int u) {
    Frame F = F_; F.tid = opq(F_.tid); F.lane = F.tid & 63;
    const int b = u >> 4, h = (u >> 1) & 7, qh = u & 1, g = F.lane >> 4, c = F.lane & 15;
    const bf16* QB = (const bf16*)(A.ws + WS_QB); const bf16* KB = (const bf16*)(A.ws + WS_KB); const bf16* VT = (const bf16*)(A.ws + WS_VT);
    const int row = b * SEQ + qh * 128 + 16 * F.wave + c;
    bf16x8 qf[4];
#if PROBE_QKV32
    { const float* Z3 = (const float*)(A.ws + 736 * MiB); const float* zb = Z3 + (size_t)(b * SEQ) * 3072 + h * 128;
      attn_stage32(F.lds, F.tid, [&](int k) { return zb + (size_t)k * 3072 + 1024; }, [&](int k) { return zb + (size_t)k * 3072 + 2048; });
      attn_load_q32(Z3 + (size_t)row * 3072 + h * 128, g, qf); }
#else
    attn_stage(F.lds, F.tid, KB + (size_t)(b * SEQ) * 1024 + h * 128, 1024, VT + (size_t)(b * 8 + h) * 128 * 256, 256);
    attn_load_q(QB + (size_t)row * 1024 + h * 128, g, qf);
#endif
    AttnState st; st.m = -3.0e38f; st.l = 0.f;
#pragma unroll
    for (int dt = 0; dt < 8; ++dt) st.ot[dt] = (f32x4){0.f, 0.f, 0.f, 0.f};
    __syncthreads();
    attn_chunk<8, false>(F.lds, qf, st, F.lane, 0, [](int, float s) { return s; });
    attn_store(st, (bf16*)(A.ws + WS_OB) + (size_t)row * 1024 + h * 128, g);
}
__device__ __forceinline__ void attn_na_unit(const Frame& F_, const Args& A, int u, int layer) {
    Frame F = F_; F.tid = opq(F_.tid); F.lane = F.tid & 63;
    const int b = u >> 7, h = (u >> 4) & 7, r = u & 15, g = F.lane >> 4, c = F.lane & 15, w = F.wave;
    const bf16* QB = (const bf16*)(A.ws + WS_QB); const bf16* KB = (const bf16*)(A.ws + WS_KB); const bf16* VT = (const bf16*)(A.ws + WS_VT);
    const int kr0 = min(max(r - 4, 0), 8);
    const int qc = 8 * w + (c & 7), row = NCTX + b * DSEQ + r * 64 + qc;
    const int wstart = min(max(qc - 8, 0), 48), t0 = min(max(8 * w - 8, 0), 40) >> 4;
    const float* rpb = A.in[I_RPB] + (size_t)(layer * 8 + h) * 15 * 31;
    bf16x8 qf[4];
#if PROBE_QKV32
    attn_load_q32((const float*)(A.ws + 736 * MiB) + (size_t)row * 3072 + h * 128, g, qf);
#else
    attn_load_q(QB + (size_t)row * 1024 + h * 128, g, qf);
#endif
    AttnState st; st.m = -3.0e38f; st.l = 0.f;
#pragma unroll
    for (int dt = 0; dt < 8; ++dt) st.ot[dt] = (f32x4){0.f, 0.f, 0.f, 0.f};
#if PROBE_QKV32
    const float* Z3 = (const float*)(A.ws + 736 * MiB); const float* zl = Z3 + (size_t)(NCTX + b * DSEQ) * 3072 + h * 128;
    for (int ci = 0; ci < 2; ++ci) {
        const int krow = kr0 + 4 * ci;
        if (ci) __syncthreads();
        attn_stage32(F.lds, F.tid, [&](int k) { return zl + (size_t)(krow * 64 + k) * 3072 + 1024; }, [&](int k) { return zl + (size_t)(krow * 64 + k) * 3072 + 2048; });
        __syncthreads();
        attn_chunk<4, true>(F.lds, qf, st, F.lane, t0, [&](int kk, float s) {
            const int ky = krow + (kk >> 6), kx = kk & 63; const bool ok = kx >= wstart && kx < wstart + 16;
            const int dy = ky - r + 7, dx = min(max(kx - qc + 15, 0), 30);
            return ok ? s + rpb[dy * 31 + dx] : -1.0e30f; });
    }
    const float* ck = A.in[I_CK] + ((size_t)(b * 2 + layer) * 512 * 8 + h) * 128; const float* cv = A.in[I_CV] + ((size_t)(b * 2 + layer) * 512 * 8 + h) * 128;
    for (int ci = 0; ci < 2; ++ci) {
        __syncthreads();
        attn_stage32(F.lds, F.tid, [&](int k) { return ck + (size_t)(ci * 256 + k) * 1024; }, [&](int k) { return cv + (size_t)(ci * 256 + k) * 1024; });
        __syncthreads();
        attn_chunk<8, false>(F.lds, qf, st, F.lane, 0, [](int, float s) { return s; });
    }
#else
    const bf16* kl = KB + (size_t)(NCTX + b * DSEQ) * 1024 + h * 128; const bf16* vl = VT + (size_t)4096 * 1024 + (size_t)(b * 8 + h) * 128 * 1024;
    for (int ci = 0; ci < 2; ++ci) {
        const int krow = kr0 + 4 * ci;
        if (ci) __syncthreads();
        attn_stage(F.lds, F.tid, kl + (size_t)(krow * 64) * 1024, 1024, vl + krow * 64, 1024);
        __syncthreads();
        attn_chunk<4, true>(F.lds, qf, st, F.lane, t0, [&](int kk, float s) {
            const int ky = krow + (kk >> 6), kx = kk & 63; const bool ok = kx >= wstart && kx < wstart + 16;
            const int dy = ky - r + 7, dx = min(max(kx - qc + 15, 0), 30);
            return ok ? s + rpb[dy * 31 + dx] : -1.0e30f; });
    }
    const bf16* ck = (const bf16*)(A.ws + WS_CKB) + (size_t)(b * 2 + layer) * 512 * 1024 + h * 128; const bf16* cv = (const bf16*)(A.ws + WS_CVT) + (size_t)((b * 2 + layer) * 8 + h) * 128 * 512;
    for (int ci = 0; ci < 2; ++ci) {
        __syncthreads();
        attn_stage(F.lds, F.tid, ck + (size_t)(ci * 256) * 1024, 1024, cv + ci * 256, 512);
        __syncthreads();
        attn_chunk<8, false>(F.lds, qf, st, F.lane, 0, [](int, float s) { return s; });
    }
#endif
    if (c < 8) attn_store(st, (bf16*)(A.ws + WS_OB) + (size_t)row * 1024 + h * 128, g);
}

__device__ __forceinline__ int hg_slot(int s, int h, int dir, int c) { return s < 16 ? s * 32 + c * 8 + h * 2 + dir : 512 + (s - 16) * 128 + c * 8 + h * 2 + dir; }
template <int CTRL> __device__ __forceinline__ float dpp_xor(float v) { return __builtin_bit_cast(float, __builtin_amdgcn_update_dpp(0, __builtin_bit_cast(int, v), CTRL, 0xf, 0xf, true)); }
__device__ __forceinline__ void hgrn_local_unit(const Frame& F_, const Args& A, int u, int layer) {
    Frame F = F_; F.tid = opq(F_.tid); F.lane = F.tid & 63;
    int s, c, hd;
    if (u < 512) { s = u >> 5; c = (u >> 3) & 3; hd = u & 7; } else { const int v = u - 512; s = 16 + (v >> 7); c = (v >> 3) & 15; hd = v & 7; }
    const int h = hd >> 1, dir = hd & 1, tokbase = s < 16 ? s * SEQ : NCTX + (s - 16) * DSEQ, g = F.lane >> 4, c15 = F.lane & 15, w = F.wave;
    const float* Z = (const float*)(A.ws + WS_ZF);
    constexpr int LS = 132, AS = 68;
    LAS float* Qt = (LAS float*)F.lds; LAS float* Kt = Qt + 64 * LS; LAS float* Vs = Kt + 64 * LS; LAS float* Bs = Vs + 64 * LS; LAS float* SC = Bs + 64 * LS; LAS float* As = Bs;
    const int d = F.tid & 127;
    {   float lbv = 0.f;
        if (layer == 1) { const float* lg = A.in[I_LBL]; lbv = sigmoid_f(lg[1024 + dir * 512 + h * 128 + d] - lg[dir * 512 + h * 128 + d]); }
        for (int i = F.tid >> 7; i < 64; i += 4) { const int t = dir ? 64 * c + 63 - i : 64 * c + i; const float* zr = Z + (size_t)(tokbase + t) * ZFW + h * 128 + d;
            const float zq = zr[ZQ], zf = zr[dir ? ZFB : ZFF], zv = zr[ZI], f = lbv + (1.f - lbv) * sigmoid_f(zf);
            Qt[i * LS + d] = silu_f(zq); Kt[i * LS + d] = (1.f - lbv) * sigmoid_f(-zf); Vs[i * LS + d] = zv; Bs[i * LS + d] = __logf(fmaxf(f, 1e-30f)); }
    }
    __syncthreads();
    if (F.tid < 128) { float b = 0.f;
#pragma unroll 8
        for (int i = 0; i < 64; ++i) { b += Bs[i * LS + d]; Bs[i * LS + d] = b; } }
    __syncthreads();
    {   float* QD = (float*)(A.ws + WS_HQD);
        for (int i = F.tid >> 7; i < 64; i += 4) { const int I = i >> 4, t = dir ? 64 * c + 63 - i : 64 * c + i;
            const float bi = Bs[i * LS + d], bs = I ? Bs[(16 * I - 1) * LS + d] : 0.f, be = Bs[(16 * I + 15) * LS + d], q = Qt[i * LS + d], k = Kt[i * LS + d];
            QD[((size_t)(tokbase + t) * 2 + dir) * 512 + h * 128 + d] = q * __expf(bi);
            Qt[i * LS + d] = q * __expf(bi - bs); Kt[i * LS + d] = k * __expf(be - bi); }
        for (int idx = F.tid; idx < 14 * 128; idx += NTHREADS) { const int v = idx >> 7, dd = idx & 127; int I, J;
            if (v < 6) { I = v < 1 ? 1 : (v < 3 ? 2 : 3); J = v < 1 ? 0 : (v < 3 ? v - 1 : v - 3); } else if (v < 10) { I = v - 6; J = I; } else { I = 4; J = v - 10; }
            const float bsI = I ? Bs[(16 * I - 1) * LS + dd] : 0.f, beJ = Bs[(16 * J + 15) * LS + dd];
            SC[idx] = __expf(bsI - beJ);
            if (v == 13) ((float*)(A.ws + WS_HDEC))[(size_t)u * 128 + dd] = __expf(bsI); }
    }
    __syncthreads();
    {
        float av[16];
#pragma unroll
        for (int ks = 0; ks < 16; ++ks) { const int j = 4 * ks + g; av[ks] = Kt[j * LS + 16 * w + c15] * SC[(10 + (j >> 4)) * 128 + 16 * w + c15]; }
        float* SL = (float*)(A.ws + WS_HSL) + (size_t)u * 16384;
        for (int et = 0; et < 8; ++et) { f32x4 acc = {0.f, 0.f, 0.f, 0.f};
#pragma unroll
            for (int ks = 0; ks < 16; ++ks) acc = __builtin_amdgcn_mfma_f32_16x16x4f32(av[ks], Vs[(4 * ks + g) * LS + 16 * et + c15], acc, 0, 0, 0);
#pragma unroll
            for (int r = 0; r < 4; ++r) SL[(16 * w + 4 * g + r) * 128 + 16 * et + c15] = acc[r]; }
    }
    for (int tl = w; tl < 10; tl += 8) {
        int I, J, sv;
        if (tl < 4) { I = tl; J = tl; sv = 6 + tl; } else { const int v = tl - 4; I = v < 1 ? 1 : (v < 3 ? 2 : 3); J = v < 1 ? 0 : (v < 3 ? v - 1 : v - 3); sv = v; }
        f32x4 acc = {0.f, 0.f, 0.f, 0.f};
#pragma unroll 8
        for (int ks = 0; ks < 32; ++ks) { const int dd = 4 * ks + g;
            acc = __builtin_amdgcn_mfma_f32_16x16x4f32(Qt[(16 * I + c15) * LS + dd] * SC[sv * 128 + dd], Kt[(16 * J + c15) * LS + dd], acc, 0, 0, 0); }
#pragma unroll
        for (int r = 0; r < 4; ++r) As[(16 * I + 4 * g + r) * AS + 16 * J + c15] = (I == J && c15 > 4 * g + r) ? 0.f : acc[r];
    }
    __syncthreads();
    {   float* OL = (float*)(A.ws + WS_HOL);
#pragma unroll
        for (int I = 0; I < 4; ++I) { f32x4 acc = {0.f, 0.f, 0.f, 0.f};
            for (int ks = 0; ks < 4 * (I + 1); ++ks) acc = __builtin_amdgcn_mfma_f32_16x16x4f32(As[(16 * I + c15) * AS + 4 * ks + g], Vs[(4 * ks + g) * LS + 16 * w + c15], acc, 0, 0, 0);
#pragma unroll
            for (int r = 0; r < 4; ++r) { const int i = 16 * I + 4 * g + r, t = dir ? 64 * c + 63 - i : 64 * c + i; OL[((size_t)(tokbase + t) * 2 + dir) * 512 + h * 128 + 16 * w + c15] = acc[r]; } }
    }
}
__device__ __forceinline__ void hgrn_final_unit(const Frame& F_, const Args& A, int u, int layer) {
    Frame F = F_; F.tid = opq(F_.tid); F.lane = F.tid & 63;
    int s, c, h, nC;
    if (u < 128) { s = 16 + (u >> 6); c = (u >> 2) & 15; h = u & 3; nC = 16; } else { const int v = u - 128; s = v >> 4; c = (v >> 2) & 3; h = v & 3; nC = 4; }
    const int tokbase = s < 16 ? s * SEQ : NCTX + (s - 16) * DSEQ, g = F.lane >> 4, c15 = F.lane & 15, w = F.wave;
    constexpr int LS = 132;
    LAS float* Ss = (LAS float*)F.lds; LAS float* Qd = Ss + 128 * LS; LAS float* Os = Qd + 64 * LS;
    const float* HSL = (const float*)(A.ws + WS_HSL); const float* HDEC = (const float*)(A.ws + WS_HDEC); const float* QD = (const float*)(A.ws + WS_HQD);
    f32x4 acc[4];
#pragma unroll
    for (int tt = 0; tt < 4; ++tt) acc[tt] = (f32x4){0.f, 0.f, 0.f, 0.f};
    for (int dir = 0; dir < 2; ++dir) {
        f32x4 S[8];
        if (s >= 16) { const float* s0 = A.in[I_SHG] + ((size_t)(((s - 16) * 2 + layer) * 2 + dir) * 4 + h) * 16384;
#pragma unroll
            for (int j = 0; j < 8; ++j) S[j] = *(const f32x4*)(s0 + 4 * (F.tid + 512 * j)); }
        else {
#pragma unroll
            for (int j = 0; j < 8; ++j) S[j] = (f32x4){0.f, 0.f, 0.f, 0.f}; }
        const int nprev = dir ? nC - 1 - c : c;
        if (nprev > 0) {
            f32x4 cur[8]; float dcur[8];
            { const int sl = hg_slot(s, h, dir, dir ? nC - 1 : 0);
#pragma unroll
              for (int j = 0; j < 8; ++j) { const int idx4 = F.tid + 512 * j; dcur[j] = HDEC[(size_t)sl * 128 + (idx4 >> 5)]; cur[j] = *(const f32x4*)(HSL + (size_t)sl * 16384 + 4 * idx4); } }
            for (int q = 0; q < nprev; ++q) {
                f32x4 nxt[8]; float dnx[8];
                const int qn = q + 1 < nprev ? q + 1 : q, sl = hg_slot(s, h, dir, dir ? nC - 1 - qn : qn);
#pragma unroll
                for (int j = 0; j < 8; ++j) { const int idx4 = F.tid + 512 * j; dnx[j] = HDEC[(size_t)sl * 128 + (idx4 >> 5)]; nxt[j] = *(const f32x4*)(HSL + (size_t)sl * 16384 + 4 * idx4); }
#pragma unroll
                for (int j = 0; j < 8; ++j) { S[j] = S[j] * dcur[j] + cur[j]; cur[j] = nxt[j]; dcur[j] = dnx[j]; }
            }
        }
        if (s < 16 && (dir ? c == 0 : c == nC - 1)) {
            const int sl = hg_slot(s, h, dir, c); float* so = A.out + OUT_SH + ((size_t)((s * 2 + layer) * 2 + dir) * 4 + h) * 16384;
#pragma unroll
            for (int j = 0; j < 8; ++j) { const int idx4 = F.tid + 512 * j; const float dc = HDEC[(size_t)sl * 128 + (idx4 >> 5)];
                *(f32x4*)(so + 4 * idx4) = S[j] * dc + *(const f32x4*)(HSL + (size_t)sl * 16384 + 4 * idx4); } }
        if (dir) __syncthreads();
#pragma unroll
        for (int j = 0; j < 8; ++j) { const int idx4 = F.tid + 512 * j; *(LAS f32x4*)(Ss + (idx4 >> 5) * LS + 4 * (idx4 & 31)) = S[j]; }
#pragma unroll
        for (int j = 0; j < 4; ++j) { const int idx4 = F.tid + 512 * j, i = idx4 >> 5;
            *(LAS f32x4*)(Qd + i * LS + 4 * (idx4 & 31)) = *(const f32x4*)(QD + ((size_t)(tokbase + 64 * c + i) * 2 + dir) * 512 + h * 128 + 4 * (idx4 & 31)); }
        __syncthreads();
        for (int ks = 0; ks < 32; ++ks) { const float bv = Ss[(4 * ks + g) * LS + 16 * w + c15];
#pragma unroll
            for (int tt = 0; tt < 4; ++tt) acc[tt] = __builtin_amdgcn_mfma_f32_16x16x4f32(Qd[(16 * tt + c15) * LS + 4 * ks + g], bv, acc[tt], 0, 0, 0); }
    }
    const float* OL = (const float*)(A.ws + WS_HOL);
#pragma unroll
    for (int tt = 0; tt < 4; ++tt)
#pragma unroll
        for (int r = 0; r < 4; ++r) { const int t = 16 * tt + 4 * g + r; const float* ol = OL + (size_t)(tokbase + 64 * c + t) * 1024 + h * 128 + 16 * w + c15;
            Os[t * LS + 16 * w + c15] = acc[tt][r] + ol[0] + ol[512]; }
    __syncthreads();
    {
        const int t = F.tid >> 3, seg = F.tid & 7; const size_t row = (size_t)(tokbase + 64 * c + t);
        f32x4 o[4]; float ss = 0.f;
#pragma unroll
        for (int j = 0; j < 4; ++j) { o[j] = *(const LAS f32x4*)(Os + t * LS + 16 * seg + 4 * j); ss += (o[j].x * o[j].x + o[j].y * o[j].y) + (o[j].z * o[j].z + o[j].w * o[j].w); }
        ss += __shfl_xor(ss, 1); ss += __shfl_xor(ss, 2); ss += __shfl_xor(ss, 4);
        const float rstd = 1.0f / sqrtf(ss * (1.0f / 128.f) + 1e-6f);
        const float* gn = A.in[I_HGN] + (size_t)(layer * 4 + h) * 128 + 16 * seg; const float* zo = (const float*)(A.ws + WS_ZF) + row * ZFW + ZO + h * 128 + 16 * seg;
        unsigned pk[8];
#pragma unroll
        for (int j = 0; j < 4; ++j) { const f32x4 gg = *(const f32x4*)(gn + 4 * j), zz = *(const f32x4*)(zo + 4 * j);
            pk[2 * j] = pk2(o[j].x * rstd * gg.x * silu_f(zz.x), o[j].y * rstd * gg.y * silu_f(zz.y)); pk[2 * j + 1] = pk2(o[j].z * rstd * gg.z * silu_f(zz.z), o[j].w * rstd * gg.w * silu_f(zz.w)); }
        bf16* oa = (bf16*)(A.ws + WS_OA) + row * 512 + h * 128 + 16 * seg;
        *(v4u*)oa = (v4u){pk[0], pk[1], pk[2], pk[3]}; *(v4u*)(oa + 8) = (v4u){pk[4], pk[5], pk[6], pk[7]};
    }
}

__device__ __forceinline__ float neg_expm1(float x) {
    return x > -0.03f ? -x * (1.f + x * (0.5f + x * (0.16666667f + x * 0.041666668f))) : 1.f - __expf(x);
}
__device__ __forceinline__ void lru_gate_unit(const Frame& F_, const Args& A, int u, int layer) {
    Frame F = F_; F.tid = opq(F_.tid); F.lane = F.tid & 63;
    const int k = u & 7, tt = (u >> 3) * 8 + F.wave, lane = F.lane, g = lane >> 4, c15 = lane & 15, r0 = 16 * tt;
    const int sstart = r0 < NCTX ? (r0 & ~255) : NCTX + ((r0 - NCTX) & ~1023), send = sstart + (r0 < NCTX ? SEQ : DSEQ);
    const float* Z = (const float*)(A.ws + WS_ZF);
    constexpr int WS_ = 68;
    LAS float* xs = (LAS float*)(F.lds + F.wave * 12544); LAS float* au = xs + 1088;
    LAS float* Wa = (LAS float*)(F.lds + 8 * 12544); LAS float* Wx = Wa + 64 * WS_;
    {   const int ch = 64 * k + lane; const float* cw = A.in[I_CONVW] + (size_t)layer * 4 * 512 + ch; const float w0 = cw[0], w1 = cw[512], w2 = cw[1024], w3 = cw[1536], cb = A.in[I_CONVB][layer * 512 + ch];
        float lx[19];
#pragma unroll
        for (int j = 0; j < 19; ++j) { const int row = r0 - 2 + j; lx[j] = (row >= sstart && row < send) ? Z[(size_t)row * ZFW + ZLX + ch] : 0.f; }
#pragma unroll
        for (int j = 0; j < 16; ++j) xs[j * 65 + lane] = cb + w0 * lx[j] + w1 * lx[j + 1] + w2 * lx[j + 2] + w3 * lx[j + 3]; }
    float* LHL = (float*)(A.ws + WS_LHL); float* LPP = (float*)(A.ws + WS_LPP);
    for (int dir = 0; dir < 2; ++dir) {
        if (dir) __syncthreads();
        {   const float* wsa = A.in[I_LWA] + (size_t)((layer * 2 + dir) * 8 + k) * 4096; const float* wsx = A.in[I_LWX] + (size_t)((layer * 2 + dir) * 8 + k) * 4096;
#pragma unroll
            for (int j = 0; j < 2; ++j) { const int r4 = F.tid + 512 * j;
                *(LAS f32x4*)(Wa + (r4 >> 4) * WS_ + 4 * (r4 & 15)) = *(const f32x4*)(wsa + 4 * r4); *(LAS f32x4*)(Wx + (r4 >> 4) * WS_ + 4 * (r4 & 15)) = *(const f32x4*)(wsx + 4 * r4); } }
        __syncthreads();
        f32x4 aa[4], ax[4];
#pragma unroll
        for (int jt = 0; jt < 4; ++jt) { aa[jt] = (f32x4){0.f, 0.f, 0.f, 0.f}; ax[jt] = aa[jt]; }
#pragma unroll 4
        for (int ks = 0; ks < 16; ++ks) { const float a = xs[c15 * 65 + 4 * ks + g];
#pragma unroll
            for (int jt = 0; jt < 4; ++jt) { const int wi = (4 * ks + g) * WS_ + 16 * jt + c15;
                aa[jt] = __builtin_amdgcn_mfma_f32_16x16x4f32(a, Wa[wi], aa[jt], 0, 0, 0); ax[jt] = __builtin_amdgcn_mfma_f32_16x16x4f32(a, Wx[wi], ax[jt], 0, 0, 0); } }
        const int pb = (layer * 2 + dir) * 512 + 64 * k;
#pragma unroll
        for (int jt = 0; jt < 4; ++jt) { const int chl = 16 * jt + c15; const float ba = A.in[I_LBA][pb + chl], bx = A.in[I_LBX][pb + chl], sp = log1pf(__expf(-A.in[I_LAM][pb + chl]));
#pragma unroll
            for (int r = 0; r < 4; ++r) { const int j = 4 * g + r; const float rg = sigmoid_f(aa[jt][r] + ba), ig = sigmoid_f(ax[jt][r] + bx);
                const float la = -8.0f * rg * sp, av = __expf(la), mult = __builtin_amdgcn_sqrtf(neg_expm1(2.0f * la)), uv = mult * ig * xs[j * 65 + chl];
                au[(j * 64 + chl) * 2] = av; au[(j * 64 + chl) * 2 + 1] = uv; } }
        LDS_WAIT(); asm volatile("" ::: "memory");
        float hh = 0.f, P = 1.f;
#pragma unroll
        for (int jj = 0; jj < 16; ++jj) { const int j = dir ? 15 - jj : jj; const float av = au[(j * 64 + lane) * 2], uv = au[(j * 64 + lane) * 2 + 1];
            hh = av * hh + uv; P *= av; const size_t o = ((size_t)(r0 + j) * 2 + dir) * 512 + 64 * k + lane; LHL[o] = hh; LPP[o] = P; }
        LDS_WAIT(); asm volatile("" ::: "memory");
    }
}
__device__ __forceinline__ float gelu_tanh(float x) { const float t = 0.7978845608028654f * (x + 0.044715f * x * x * x); return 0.5f * x * (1.0f + tanhf(t)); }
__device__ __forceinline__ void lru_final_unit(const Frame& F_, const Args& A, int tt, int layer) {
    Frame F = F_; F.tid = opq(F_.tid); F.lane = F.tid & 63;
    const int ch = F.tid, r0 = 16 * tt;
    const int s = r0 < NCTX ? r0 >> 8 : 16 + ((r0 - NCTX) >> 10), f0 = (r0 < NCTX ? (r0 & ~255) : NCTX + ((r0 - NCTX) & ~1023)) >> 4, nt = r0 < NCTX ? 16 : 64;
    const float* LHL = (const float*)(A.ws + WS_LHL); const float* LPP = (const float*)(A.ws + WS_LPP); const float* Z = (const float*)(A.ws + WS_ZF);
    float cf = 0.f, cb = 0.f;
    if (s >= 16) { const float* h0 = A.in[I_SLRU] + (size_t)((s - 16) * 2 + layer) * 1024; cf = h0[ch]; cb = h0[512 + ch]; }
    {   int j = f0;
        for (; j + 8 <= tt; j += 8) { float hv[8], pv[8];
#pragma unroll
            for (int q = 0; q < 8; ++q) { const size_t o = ((size_t)(16 * (j + q) + 15) * 2 + 0) * 512 + ch; hv[q] = LHL[o]; pv[q] = LPP[o]; }
#pragma unroll
            for (int q = 0; q < 8; ++q) cf = hv[q] + pv[q] * cf; }
        for (; j < tt; ++j) { const size_t o = ((size_t)(16 * j + 15) * 2 + 0) * 512 + ch; cf = LHL[o] + LPP[o] * cf; } }
    {   int j = f0 + nt - 1;
        for (; j - 8 >= tt; j -= 8) { float hv[8], pv[8];
#pragma unroll
            for (int q = 0; q < 8; ++q) { const size_t o = ((size_t)(16 * (j - q)) * 2 + 1) * 512 + ch; hv[q] = LHL[o]; pv[q] = LPP[o]; }
#pragma unroll
            for (int q = 0; q < 8; ++q) cb = hv[q] + pv[q] * cb; }
        for (; j > tt; --j) { const size_t o = ((size_t)(16 * j) * 2 + 1) * 512 + ch; cb = LHL[o] + LPP[o] * cb; } }
    bf16* OC = (bf16*)(A.ws + WS_OC);
#pragma unroll 4
    for (int i = 0; i < 16; ++i) { const size_t row = (size_t)(r0 + i), o0 = (row * 2) * 512 + ch, o1 = o0 + 512;
        const float hf = LHL[o0] + LPP[o0] * cf, hb = LHL[o1] + LPP[o1] * cb, y = (hf + hb) * gelu_tanh(Z[row * ZFW + ZLG + ch]);
        OC[row * 512 + ch] = (bf16)f2bf(y);
        if (s < 16) { if (i == 15 && tt == f0 + nt - 1) A.out[OUT_SL + (size_t)((s * 2 + layer) * 2 + 0) * 512 + ch] = hf;
                      if (i == 0 && tt == f0) A.out[OUT_SL + (size_t)((s * 2 + layer) * 2 + 1) * 512 + ch] = hb; } }
}

#ifndef DUP_P0C
#define DUP_P0C 0
#endif
#ifndef DUP_P0M
#define DUP_P0M 0
#endif
#ifndef DUP_H1
#define DUP_H1 0
#endif
#ifndef DUP_UP1
#define DUP_UP1 0
#endif
#ifndef DUP_NA
#define DUP_NA 0
#endif
#ifndef DUP_CA
#define DUP_CA 0
#endif
#ifndef DUP_L1
#define DUP_L1 0
#endif
#ifndef DUP_H3
#define DUP_H3 0
#endif
#ifndef DUP_L2
#define DUP_L2 0
#endif
#ifndef DUP_NORM
#define DUP_NORM 0
#endif
#ifndef PROBE_NOCACHE
#define PROBE_NOCACHE 0
#endif
#ifndef PROBE_MEMSET
#define PROBE_MEMSET 0
#endif
#ifndef MK_N_LAUNCHES
#define MK_N_LAUNCHES 1
#endif
constexpr int N_PHASES = 3 + 12 * DEPTH;
__global__ void __launch_bounds__(NTHREADS, 2) trunk_fwd(Args A) {
    extern __shared__ __attribute__((aligned(16))) unsigned char lds_raw[];
    Frame F; F.lds = (LAS unsigned char*)lds_raw; F.tid = threadIdx.x; F.lane = F.tid & 63; F.wave = __builtin_amdgcn_readfirstlane(F.tid >> 6);
    F.G = gridDim.x; F.gw = blockIdx.x * NWAVES + F.wave; F.NGW = F.G * NWAVES;
    volatile LAS unsigned* MISC = (volatile LAS unsigned*)(F.lds + LDSCTL_OFF);
    for (int u = F.tid; u < (LDS_BYTES - LDSCTL_OFF) / 4; u += NTHREADS) MISC[u] = 0u;
    __syncthreads();
    gu32* ctl = (gu32*)(A.ws + WS_CTL);
    XcdBarrier bar; bar.bar = (unsigned*)(ctl + CW_BAR); bar.x = 0; bar.st = nullptr;
    if (MK_N_LAUNCHES == 1) bar = xcd_barrier_post((unsigned*)(ctl + CW_BAR), MISC + 8);
    const int lo = A.ph_lo, hi = A.ph_hi;
#define IN(k) (lo <= (k) && (k) < hi)
#define SEAM(k) do { if (IN(k) && IN((k) + 1)) { XcdBarrier b2_ = bar; asm volatile("" : "+s"(b2_.bar)); xcd_barrier(b2_); } } while (0)
    gu32* cvq = ctl + CW_Q + 30 * 64;
#define CV_END(l_, j_, gemm_) do { if (IN(3 + 12 * (l_) + (j_))) cv_until(F, A, cvq, cv_need((l_), (j_)), (gemm_) ? ctl + CW_Q + (32 + 12 * (l_) + (j_)) * 64 : (gu32*)nullptr, MISC + 20); } while (0)
    unsigned char* ws = A.ws;
    float* X = (float*)(ws + WS_X); bf16* H = (bf16*)(ws + WS_H); bf16* HID = (bf16*)(ws + WS_HID);
    float* MODS = (float*)(ws + WS_MODS);
    LAS unsigned char* ring = F.lds;

#ifndef NO_P0
    if (IN(0)) { p0_convert(F, A); p0_mods_partial(F, A);
#if !PROBE_NOCACHE
        p0_cache(F, A);
#endif
    }
#if DUP_P0C
    if (IN(0)) { __syncthreads(); p0_convert(F, A); }
#endif
#if DUP_P0M
    if (IN(0)) { __syncthreads(); p0_mods_partial(F, A); }
#endif
    #endif
        SEAM(0);
#ifndef NO_P1
    if (IN(1)) p0_mods_reduce(F, A);
    #endif
        SEAM(1);
#ifndef NO_P2
    if (IN(2)) norm_rows<0>(F, A.in[I_XP], A.in[I_XS], X, A.in[I_NORMG], MODS, 0, H, nullptr);
    #endif
        SEAM(2);

    for (int l = 0; l < DEPTH; ++l) {
        const int pb = 3 + 12 * l;
        unsigned char* wl = ws + WS_W + (size_t)l * W_LAYER;
        const float* mods_l = MODS + (size_t)l * 3 * 9 * DM;
        const float* ng = A.in[I_NORMG] + (size_t)l * 3 * DM;
#ifndef NO_G0
        if (IN(pb + 0)) { pg8::Gemm g{H, (const bf16*)(wl + WO_UP1), MTOK, 2 * DFF, DM}; pg8::StaticOrder S; S.init(MTOK, 2 * DFF, F.G, (int)blockIdx.x);
            pg8::EpiSwiglu E{HID, DFF}; pg8::gemm_phase<pg8::EpiSwiglu, pg8::StaticOrder, true, true>(ring, g, S, E);
#if DUP_UP1
            __syncthreads(); pg8::gemm_phase<pg8::EpiSwiglu, pg8::StaticOrder, true, true>(ring, g, S, E);
#endif
        }
        #endif
        CV_END(l, 0, 1);
        SEAM(pb + 0);
#ifndef NO_G1
        if (IN(pb + 1)) { pg8::Gemm g{HID, (const bf16*)(wl + WO_DN1), MTOK, DM, DFF}; pg8::StaticOrder S; S.init(MTOK, DM, F.G, (int)blockIdx.x);
            pg8::EpiResid E{X, DM, mods_l, 0, 0.5f}; pg8::gemm_phase<pg8::EpiResid, pg8::StaticOrder, true, true>(ring, g, S, E); }
        #endif
        CV_END(l, 1, 1);
        SEAM(pb + 1);
#ifndef NO_N2
        if (IN(pb + 2)) norm_rows<0>(F, X, X + (size_t)NCTX * DM, nullptr, ng + DM, mods_l, 1, H, nullptr);
#if DUP_NORM
        if (IN(pb + 2)) norm_rows<0>(F, X, X + (size_t)NCTX * DM, nullptr, ng + DM, mods_l, 1, H, nullptr);
#endif
        #endif
        CV_END(l, 2, 0);
        SEAM(pb + 2);
#ifndef NO_G3
        if (IN(pb + 3)) { pg8::Gemm g{H, (const bf16*)(wl + WO_IN), MTOK, DIN, DM}; pg8::StaticOrder S; S.init(MTOK, DIN, F.G, (int)blockIdx.x);
            pg8::EpiZ E{(float*)(ws + WS_ZF), (bf16*)(ws + WS_QB), (bf16*)(ws + WS_KB), (bf16*)(ws + WS_VT), (bf16*)(ws + WS_GB), A.out + OUT_K, A.out + OUT_V, l, (float*)(ws + 736 * MiB)}; pg8::gemm_phase<pg8::EpiZ, pg8::StaticOrder, true, true>(ring, g, S, E); }
        #endif
        CV_END(l, 3, 1);
        SEAM(pb + 3);
        if (IN(pb + 4)) {
            gu32* q = ctl + CW_Q + (l * 8) * 64;
            #ifndef NO_H1
            for (int u; (u = next_unit(q + 0 * 64, MISC + 16)) < 768;) hgrn_local_unit(F, A, u, l);
#endif
#if DUP_H1
            for (int u; (u = next_unit(q + 6 * 64, MISC + 16)) < 768;) hgrn_local_unit(F, A, u, l);
#endif
            #ifndef NO_NA
            for (int u; (u = next_unit(q + 1 * 64, MISC + 16)) < 256;) attn_na_unit(F, A, u, l);
#endif
#if DUP_NA
            for (int u; (u = next_unit(q + 6 * 64, MISC + 16)) < 256;) attn_na_unit(F, A, u, l);
#endif
            #ifndef NO_CA
            for (int u; (u = next_unit(q + 2 * 64, MISC + 16)) < 256;) attn_ctx_unit(F, A, u);
#endif
#if DUP_CA
            for (int u; (u = next_unit(q + 6 * 64, MISC + 16)) < 256;) attn_ctx_unit(F, A, u);
#endif
            #ifndef NO_L1
            for (int u; (u = next_unit(q + 3 * 64, MISC + 16)) < 384;) lru_gate_unit(F, A, u, l);
#endif
#if DUP_L1
            for (int u; (u = next_unit(q + 6 * 64, MISC + 16)) < 384;) lru_gate_unit(F, A, u, l);
#endif
        }
        CV_END(l, 4, 0);
        SEAM(pb + 4);
        if (IN(pb + 5)) {
            gu32* q = ctl + CW_Q + (l * 8) * 64;
            #ifndef NO_H3
            for (int u; (u = next_unit(q + 4 * 64, MISC + 16)) < 384;) hgrn_final_unit(F, A, u, l);
#endif
#if DUP_H3
            for (int u; (u = next_unit(q + 7 * 64, MISC + 16)) < 384;) hgrn_final_unit(F, A, u, l);
#endif
            #ifndef NO_L2
            for (int u; (u = next_unit(q + 5 * 64, MISC + 16)) < 384;) lru_final_unit(F, A, u, l);
#endif
#if DUP_L2
            for (int u; (u = next_unit(q + 7 * 64, MISC + 16)) < 384;) lru_final_unit(F, A, u, l);
#endif
        }
        CV_END(l, 5, 0);
        SEAM(pb + 5);
#ifndef NO_G6
        if (IN(pb + 6)) {
            __syncthreads();
            float* MACC = (float*)(ws + WS_MACC); bf16* MB = (bf16*)(ws + WS_MB);
            { pg8::Gemm g{(const bf16*)(ws + WS_OA), (const bf16*)(wl + WO_PA), MTOK, DM, 512}; pg8::StaticOrder S; S.init(MTOK, DM, F.G, (int)blockIdx.x);
              pg8::EpiMerge E{(const bf16*)(ws + WS_GB), MACC, MB, 0}; pg8::gemm_phase<pg8::EpiMerge, pg8::StaticOrder, true, true>(ring, g, S, E); }
            { pg8::Gemm g{(const bf16*)(ws + WS_OB), (const bf16*)(wl + WO_PB), MTOK, DM, 1024}; pg8::StaticOrder S; S.init(MTOK, DM, F.G, (int)blockIdx.x);
              pg8::EpiMerge E{(const bf16*)(ws + WS_GB) + DM, MACC, MB, 1}; pg8::gemm_phase<pg8::EpiMerge, pg8::StaticOrder, true, true>(ring, g, S, E); }
            { pg8::Gemm g{(const bf16*)(ws + WS_OC), (const bf16*)(wl + WO_PC), MTOK, DM, 512}; pg8::StaticOrder S; S.init(MTOK, DM, F.G, (int)blockIdx.x);
              pg8::EpiMerge E{(const bf16*)(ws + WS_GB) + 2 * DM, MACC, MB, 2}; pg8::gemm_phase<pg8::EpiMerge, pg8::StaticOrder, true, true>(ring, g, S, E); }
        }
        #endif
        CV_END(l, 6, 1);
        SEAM(pb + 6);
#ifndef NO_G7
        if (IN(pb + 7)) { pg8::Gemm g{(const bf16*)(ws + WS_MB), (const bf16*)(wl + WO_OUT), MTOK, DM, DM}; pg8::StaticOrder S; S.init(MTOK, DM, F.G, (int)blockIdx.x);
            pg8::EpiResid E{X, DM, mods_l, 1, 1.0f}; pg8::gemm_phase<pg8::EpiResid, pg8::StaticOrder, true, true>(ring, g, S, E); }
        #endif
        CV_END(l, 7, 1);
        SEAM(pb + 7);
#ifndef NO_N8
        if (IN(pb + 8)) norm_rows<0>(F, X, X + (size_t)NCTX * DM, nullptr, ng + 2 * DM, mods_l, 2, H, nullptr);
        #endif
        CV_END(l, 8, 0);
        SEAM(pb + 8);
#ifndef NO_G9
        if (IN(pb + 9)) { pg8::Gemm g{H, (const bf16*)(wl + WO_UP2), MTOK, 2 * DFF, DM}; pg8::StaticOrder S; S.init(MTOK, 2 * DFF, F.G, (int)blockIdx.x);
            pg8::EpiSwiglu E{HID, DFF}; pg8::gemm_phase<pg8::EpiSwiglu, pg8::StaticOrder, true, true>(ring, g, S, E); }
        #endif
        CV_END(l, 9, 1);
        SEAM(pb + 9);
#ifndef NO_G10
        if (IN(pb + 10)) { pg8::Gemm g{HID, (const bf16*)(wl + WO_DN2), MTOK, DM, DFF}; pg8::StaticOrder S; S.init(MTOK, DM, F.G, (int)blockIdx.x);
            pg8::EpiResid E{X, DM, mods_l, 2, 0.5f}; pg8::gemm_phase<pg8::EpiResid, pg8::StaticOrder, true, true>(ring, g, S, E); }
        #endif
        CV_END(l, 10, 1);
        SEAM(pb + 10);
#ifndef NO_N11
        if (IN(pb + 11)) {
            if (l + 1 < DEPTH) norm_rows<0>(F, X, X + (size_t)NCTX * DM, nullptr, ng + 3 * DM, mods_l + 3 * 9 * DM, 0, H, nullptr);
            else norm_rows<1>(F, X, X + (size_t)NCTX * DM, nullptr, A.in[I_FNG], nullptr, 0, nullptr, A.out + OUT_Y);
        }
        #endif
        CV_END(l, 11, 0);
        SEAM(pb + 11);
    }
#undef IN
#undef SEAM
}

extern "C" void kernel_launch(void* const* d_in, const int* in_sizes, int n_in, void* d_out, int out_size, void* d_ws, size_t ws_size, hipStream_t stream) {
    static int grid = 0;
    if (grid == 0) {
        if (n_in != 31 || out_size != 33587200 || ws_size < WS_END) { fprintf(stderr, "kernel_launch: unexpected shapes (n_in %d, out %d, ws %zu); nothing launched\n", n_in, out_size, ws_size); grid = -1; return; }
        int dev = 0, cus = 0, per_cu = 0;
        if (hipGetDevice(&dev) != hipSuccess || hipDeviceGetAttribute(&cus, hipDeviceAttributeMultiprocessorCount, dev) != hipSuccess) { grid = -1; return; }
        if (hipFuncSetAttribute((const void*)trunk_fwd, hipFuncAttributeMaxDynamicSharedMemorySize, LDS_BYTES) != hipSuccess) { fprintf(stderr, "kernel_launch: hipFuncSetAttribute failed\n"); grid = -1; return; }
        if (hipOccupancyMaxActiveBlocksPerMultiprocessor(&per_cu, (const void*)trunk_fwd, NTHREADS, LDS_BYTES) != hipSuccess || per_cu < 1) { fprintf(stderr, "kernel_launch: occupancy query says %d blocks per CU\n", per_cu); (void)hipGetLastError(); grid = -1; return; }
        grid = cus;
    }
    if (grid < 0) return;
    if (hipMemsetAsync((char*)d_ws + WS_CTL, 0, CTL_ZERO_BYTES, stream) != hipSuccess) return;
#if PROBE_MEMSET
    (void)hipMemsetAsync((char*)d_ws + PROBE_MS_LO * MiB, 0, (PROBE_MS_HI - PROBE_MS_LO) * MiB, stream);
#endif
    Args a{};
    for (int i = 0; i < 31; ++i) a.in[i] = (const float*)d_in[i];
    a.out = (float*)d_out; a.ws = (unsigned char*)d_ws;
#if MK_N_LAUNCHES == 1
    a.ph_lo = 0; a.ph_hi = N_PHASES;
    hipLaunchKernelGGL(trunk_fwd, dim3(grid), dim3(NTHREADS), LDS_BYTES, stream, a);
#else
    for (int p = 0; p < N_PHASES; ++p) { a.ph_lo = p; a.ph_hi = p + 1; hipLaunchKernelGGL(trunk_fwd, dim3(grid), dim3(NTHREADS), LDS_BYTES, stream, a); }
#endif
}
```

```cpp
#include <hip/hip_runtime.h>
#include <cstdio>
#include <cstdint>
namespace pg8 {
#define PG8_LAS __attribute__((address_space(3)))
typedef unsigned short bf16_t;
typedef short bf16x8 __attribute__((ext_vector_type(8)));
typedef float f32x4 __attribute__((ext_vector_type(4)));
typedef unsigned u32x4 __attribute__((ext_vector_type(4)));
constexpr int BM = 256, BK = 64, HALF = 128, HTB = HALF * BK * 2  , STAGE_BYTES = 8 * HTB, NXCD = 8, WGM = 8;

__host__ __device__ __forceinline__ int lds_byte(int r, int c) { const int st = (r >> 4) * 2 + (c >> 5), rr = r & 15, cc = c & 31, ob = rr * 64 + cc * 2; return st * 1024 + (ob ^ (((ob >> 9) & 1) << 5)); }
__host__ __device__ __forceinline__ void stage_rc(int b, int& R, int& C) { const int st = b / 1024, sb = b % 1024, swz = sb ^ (((sb >> 9) & 1) << 5); R = (st >> 1) * 16 + swz / 64; C = (st & 1) * 32 + (swz % 64) / 2; }
__host__ __device__ __forceinline__ int perm32(int rho) { const int n = rho >> 4, i = rho & 15; return 8 * (i >> 2) + 4 * n + (i & 3); }

struct Unit { int pm, pn; };
struct Gemm { const bf16_t* A; const bf16_t* Bt; int M, N, K; };

struct StaticOrder {
    int nM, nN, nwg, G, c;
    __host__ __device__ void init(int M, int N, int G_, int c_) { nM = M / BM; nN = N / BM; nwg = nM * nN; G = G_; c = c_; }
    __host__ __device__ bool next(int i, Unit& u) const {
        const long L = (long)i * G + c; if (L >= nwg) return false;
        int wgid = (int)L; { const int q = nwg / NXCD, r = nwg % NXCD, xcd = wgid % NXCD, off = wgid / NXCD; wgid = (xcd < r ? xcd * (q + 1) : r * (q + 1) + (xcd - r) * q) + off; }
        const int nig = WGM * nN, gid = wgid / nig, fm = gid * WGM, gsz = (nM - fm) < WGM ? (nM - fm) : WGM;
        u.pm = fm + ((wgid % nig) % gsz); u.pn = (wgid % nig) / gsz; return true;
    }
    __device__ __forceinline__ void a_ready(const Unit&) const {}
    __device__ __forceinline__ void done(const Unit&) const {}
};
typedef float f32x2_cv __attribute__((ext_vector_type(2)));
typedef __bf16 bf16x2_cv __attribute__((ext_vector_type(2)));
__device__ __forceinline__ unsigned cvt_pk_bf16(float lo, float hi) { const f32x2_cv v = {lo, hi}; return __builtin_bit_cast(unsigned, __builtin_convertvector(v, bf16x2_cv)); }
typedef float f32x2 __attribute__((ext_vector_type(2)));

typedef unsigned u32x2 __attribute__((ext_vector_type(2)));
#ifndef PROBE_NOGATE
#define PROBE_NOGATE 0
#endif
#ifndef PROBE_GCONST
#define PROBE_GCONST 0
#endif
#ifndef PROBE_GRAW
#define PROBE_GRAW 0
#endif
#ifndef PROBE_QKV32
#define PROBE_QKV32 0
#endif
__device__ __forceinline__ float silu_f(float a) { return a * __builtin_amdgcn_rcpf(1.0f + __expf(-a)); }
__device__ __forceinline__ float sigmoid_f(float a) { return __builtin_amdgcn_rcpf(1.0f + __expf(-a)); }
__device__ __forceinline__ int opq_(int v) { asm volatile("" : "+v"(v)); return v; }

struct EpiSwiglu {
    static constexpr bool PERM = true, AFTER_DRAIN = false;
    bf16_t* O; int ldo;
    __device__ __forceinline__ void operator()(const f32x4 (&acc)[2][2][4][2], const Unit& u, int wr, int wc, int fr_, int fq_) const {
        const int fr = opq_(fr_), fq = opq_(fq_);
        const int row0 = u.pm * BM + wr * 64 + fr, col0 = u.pn * HALF + wc * 32 + 8 * fq;
#pragma unroll
        for (int ai = 0; ai < 2; ++ai)
#pragma unroll
            for (int m = 0; m < 4; ++m) { bf16_t* rowp = O + (size_t)(row0 + ai * HALF + m * 16) * ldo + col0;
                const f32x4 a0 = acc[ai][0][m][0], a1 = acc[ai][0][m][1], u0 = acc[ai][1][m][0], u1 = acc[ai][1][m][1];
                f32x4 v0, v1;
#pragma unroll
                for (int j = 0; j < 4; ++j) { v0[j] = silu_f(a0[j]) * u0[j]; v1[j] = silu_f(a1[j]) * u1[j]; }
                u32x4 w; w.x = cvt_pk_bf16(v0[0], v0[1]); w.y = cvt_pk_bf16(v0[2], v0[3]); w.z = cvt_pk_bf16(v1[0], v1[1]); w.w = cvt_pk_bf16(v1[2], v1[3]);
                *(u32x4*)rowp = w; }
    }
};
struct EpiResid {
    static constexpr bool PERM = false, AFTER_DRAIN = false;
    float* X; int ldx; const float* mods_l; int slot; float coef;
    __device__ __forceinline__ void operator()(const f32x4 (&acc)[2][2][4][2], const Unit& u, int wr, int wc, int fr_, int fq_) const {
        const int fr = opq_(fr_), fq = opq_(fq_);
        const int row0 = u.pm * BM + wr * 64 + fr, col0 = u.pn * BM + wc * 32 + 4 * fq;
        const int cidx = u.pm < 16 ? 0 : 1 + ((u.pm - 16) >> 2);
        const float* g = mods_l + (size_t)(cidx * 9 + 3 * slot + 2) * 2048 + col0;
        f32x4 gv[2][2];
#pragma unroll
        for (int bj = 0; bj < 2; ++bj)
#pragma unroll
            for (int n = 0; n < 2; ++n) gv[bj][n] = *(const f32x4*)(g + bj * HALF + n * 16) * coef;
#pragma unroll
        for (int ai = 0; ai < 2; ++ai)
#pragma unroll
            for (int m = 0; m < 4; ++m) { float* rowp = X + (size_t)(row0 + ai * HALF + m * 16) * ldx + col0;
#pragma unroll
                for (int bj = 0; bj < 2; ++bj)
#pragma unroll
                    for (int n = 0; n < 2; ++n) { f32x4* p = (f32x4*)(rowp + bj * HALF + n * 16); *p = *p + gv[bj][n] * acc[ai][bj][m][n]; } }
    }
};
struct EpiZ {
    static constexpr bool PERM = false, AFTER_DRAIN = false;
    float* ZF; bf16_t* QB; bf16_t* KB; bf16_t* VT; bf16_t* GB; float* outk; float* outv; int layer; float* Q32;
    __device__ __forceinline__ void operator()(const f32x4 (&acc)[2][2][4][2], const Unit& u, int wr, int wc, int fr_, int fq_) const {
        const int fr = opq_(fr_), fq = opq_(fq_);
        const int rl0 = wr * 64 + fr, ct0 = wc * 32 + 4 * fq, pn = u.pn;
#if PROBE_QKV32
        if (pn >= 10 && pn < 22) { float* base = Q32 + (size_t)(u.pm * BM + rl0) * 3072 + (pn - 10) * 256 + ct0;
#pragma unroll
            for (int ai = 0; ai < 2; ++ai)
#pragma unroll
                for (int m = 0; m < 4; ++m) { float* rowp = base + (size_t)(ai * HALF + m * 16) * 3072;
#pragma unroll
                    for (int bj = 0; bj < 2; ++bj)
#pragma unroll
                        for (int n = 0; n < 2; ++n) *(f32x4*)(rowp + bj * HALF + n * 16) = acc[ai][bj][m][n]; } }
#endif
        if (pn < 10 || (pn >= 22 && pn < 26)) {
            float* base = ZF + (size_t)(u.pm * BM + rl0) * 3584 + (pn < 10 ? pn * 256 : 2560 + (pn - 22) * 256) + ct0;
#pragma unroll
            for (int ai = 0; ai < 2; ++ai)
#pragma unroll
                for (int m = 0; m < 4; ++m) { float* rowp = base + (size_t)(ai * HALF + m * 16) * 3584;
#pragma unroll
                    for (int bj = 0; bj < 2; ++bj)
#pragma unroll
                        for (int n = 0; n < 2; ++n) *(f32x4*)(rowp + bj * HALF + n * 16) = acc[ai][bj][m][n]; }
        } else if (pn < 18) {
            bf16_t* dst = (pn < 14 ? QB + (pn - 10) * 256 : KB + (pn - 14) * 256) + (size_t)(u.pm * BM + rl0) * 1024 + ct0;
            float* ko = (pn >= 14 && u.pm < 16) ? outk + ((size_t)(u.pm * 2 + layer) * 256 + rl0) * 1024 + (pn - 14) * 256 + ct0 : nullptr;
#pragma unroll
            for (int ai = 0; ai < 2; ++ai)
#pragma unroll
                for (int m = 0; m < 4; ++m) { const size_t ro = (size_t)(ai * HALF + m * 16) * 1024;
#pragma unroll
                    for (int bj = 0; bj < 2; ++bj)
#pragma unroll
                        for (int n = 0; n < 2; ++n) { const f32x4 v = acc[ai][bj][m][n]; u32x2 w; w.x = cvt_pk_bf16(v[0], v[1]); w.y = cvt_pk_bf16(v[2], v[3]);
                            *(u32x2*)(dst + ro + bj * HALF + n * 16) = w; if (ko) *(f32x4*)(ko + ro + bj * HALF + n * 16) = v; } }
        } else if (pn < 22) {
            const bool ctx = u.pm < 16; const int L = ctx ? 256 : 1024, t0 = (ctx ? 0 : ((u.pm - 16) & 3) * 256) + rl0;
            bf16_t* vb = ctx ? VT + (size_t)u.pm * 8 * 128 * 256 : VT + (size_t)4096 * 1024 + (size_t)((u.pm - 16) >> 2) * 8 * 128 * 1024;
            vb += (size_t)(2 * (pn - 18)) * 128 * L + (size_t)ct0 * L + t0;
            float* vo = ctx ? outv + ((size_t)(u.pm * 2 + layer) * 256 + rl0) * 1024 + (pn - 18) * 256 + ct0 : nullptr;
#pragma unroll
            for (int ai = 0; ai < 2; ++ai)
#pragma unroll
                for (int m = 0; m < 4; ++m) { const int tr = ai * HALF + m * 16;
#pragma unroll
                    for (int bj = 0; bj < 2; ++bj)
#pragma unroll
                        for (int n = 0; n < 2; ++n) { const f32x4 v = acc[ai][bj][m][n]; bf16_t* p = vb + (size_t)(bj * 128 + n * 16) * L + tr;
                            const unsigned w0 = cvt_pk_bf16(v[0], v[1]), w1 = cvt_pk_bf16(v[2], v[3]);
                            p[0] = (bf16_t)(w0 & 0xffffu); p[L] = (bf16_t)(w0 >> 16); p[2 * L] = (bf16_t)(w1 & 0xffffu); p[3 * L] = (bf16_t)(w1 >> 16);
                            if (vo) *(f32x4*)(vo + (size_t)tr * 1024 + bj * HALF + n * 16) = v; } }
        } else {
            bf16_t* dst = GB + (size_t)(u.pm * BM + rl0) * 6144 + (pn - 26) * 256 + ct0;
#pragma unroll
            for (int ai = 0; ai < 2; ++ai)
#pragma unroll
                for (int m = 0; m < 4; ++m) { const size_t ro = (size_t)(ai * HALF + m * 16) * 6144;
#pragma unroll
                    for (int bj = 0; bj < 2; ++bj)
#pragma unroll
                        for (int n = 0; n < 2; ++n) { const f32x4 v = acc[ai][bj][m][n]; u32x2 w; w.x = cvt_pk_bf16(sigmoid_f(v[0]), sigmoid_f(v[1])); w.y = cvt_pk_bf16(sigmoid_f(v[2]), sigmoid_f(v[3]));
#if PROBE_GCONST
                            w.x = 0x3f003f00u; w.y = 0x3f003f00u;
#endif
#if PROBE_GRAW
                            w.x = cvt_pk_bf16(v[0] * 0.01f, v[1] * 0.01f); w.y = cvt_pk_bf16(v[2] * 0.01f, v[3] * 0.01f);
#endif
                            *(u32x2*)(dst + ro + bj * HALF + n * 16) = w; } }
        }
    }
};
struct EpiMerge {
    static constexpr bool PERM = false, AFTER_DRAIN = false;
    const bf16_t* Gg; float* MACC; bf16_t* MB; int mode;
    __device__ __forceinline__ void operator()(const f32x4 (&acc)[2][2][4][2], const Unit& u, int wr, int wc, int fr_, int fq_) const {
        const int fr = opq_(fr_), fq = opq_(fq_);
        const int row0 = u.pm * BM + wr * 64 + fr, col0 = u.pn * BM + wc * 32 + 4 * fq;
#pragma unroll
        for (int ai = 0; ai < 2; ++ai)
#pragma unroll
            for (int m = 0; m < 4; ++m) { const size_t row = (size_t)(row0 + ai * HALF + m * 16);
#pragma unroll
                for (int bj = 0; bj < 2; ++bj)
#pragma unroll
                    for (int n = 0; n < 2; ++n) { const int c = col0 + bj * HALF + n * 16;
#if PROBE_NOGATE
                        const u32x2 gw = {0x3f003f00u, 0x3f003f00u}; f32x4 v = acc[ai][bj][m][n];
#else
                        const u32x2 gw = *(const u32x2*)(Gg + row * 6144 + c); f32x4 v = acc[ai][bj][m][n];
#endif
                        v[0] *= __uint_as_float(gw.x << 16); v[1] *= __uint_as_float(gw.x & 0xffff0000u); v[2] *= __uint_as_float(gw.y << 16); v[3] *= __uint_as_float(gw.y & 0xffff0000u);
                        f32x4* mp = (f32x4*)(MACC + row * 2048 + c);
                        if (mode == 0) *mp = v;
                        else if (mode == 1) *mp = *mp + v;
                        else { v = *mp + v; u32x2 w; w.x = cvt_pk_bf16(v[0], v[1]); w.y = cvt_pk_bf16(v[2], v[3]); *(u32x2*)(MB + row * 2048 + c) = w; } } }
    }
};
template <class Epi, class Sched, bool ALIGN_EPI = false, bool SP2 = false>
__device__ __forceinline__ void gemm_phase(PG8_LAS unsigned char* lds, const Gemm g, const Sched& S, const Epi& E) {
    int tid_ = threadIdx.x; asm volatile("" : "+v"(tid_));
    const int tid = tid_, wid = __builtin_amdgcn_readfirstlane(tid >> 6), lane = tid & 63, wr = wid >> 2, wc = wid & 3, fr = lane & 15, fq = lane >> 4;
    const int K = g.K, nt = K / BK;
    unsigned voffA[2], voffB[2];
#pragma unroll
    for (int i = 0; i < 2; ++i) { int R, C; stage_rc(tid * 16 + i * 8192, R, C); const int Rb = Epi::PERM ? ((R & ~31) + perm32(R & 31)) : R;
        voffA[i] = (unsigned)(R * K + C) * 2u; voffB[i] = (unsigned)(Rb * K + C) * 2u; }
    const size_t kstep = (size_t)(BK * 2);
    const size_t hstep = (size_t)HALF * K * 2;
    const size_t tstep = 2 * hstep;
    const unsigned ldsw = (unsigned)wid * 1024u;
    const int aoff = lds_byte(wr * 64 + fr, fq * 8), boff = lds_byte(wc * 32 + fr, fq * 8);
#define PG8_SA(b, h) (((b) * 2 + (h)) * HTB)
#define PG8_SB(b, h) ((4 + (b) * 2 + (h)) * HTB)
#define PG8_STAGE(bufoff, gbase, voff) do { _Pragma("unroll") for (int _i = 0; _i < 2; ++_i) \
        __builtin_amdgcn_global_load_lds((const unsigned*)((const char*)(gbase) + (voff)[_i]), (PG8_LAS unsigned*)(lds + (bufoff) + ldsw + _i * 8192), 16, 0, 0); } while (0)
#define PG8_LDA(dst, b, h) do { _Pragma("unroll") for (int m = 0; m < 4; ++m) _Pragma("unroll") for (int k = 0; k < 2; ++k) dst[m][k] = *(const PG8_LAS bf16x8*)(lds + PG8_SA(b, h) + aoff + m * 2048 + k * 1024); } while (0)
#define PG8_LDB(dst, b, h) do { _Pragma("unroll") for (int n = 0; n < 2; ++n) _Pragma("unroll") for (int k = 0; k < 2; ++k) dst[n][k] = *(const PG8_LAS bf16x8*)(lds + PG8_SB(b, h) + boff + n * 2048 + k * 1024); } while (0)
#define PG8_MMA(ai, bj, At, Bt) do { __builtin_amdgcn_s_setprio(1); _Pragma("unroll") for (int m = 0; m < 4; ++m) _Pragma("unroll") for (int n = 0; n < 2; ++n) _Pragma("unroll") for (int k = 0; k < 2; ++k) \
        acc[ai][bj][m][n] = __builtin_amdgcn_mfma_f32_16x16x32_bf16(Bt[n][k], At[m][k], acc[ai][bj][m][n], 0, 0, 0); __builtin_amdgcn_s_setprio(0); } while (0)
#define PG8_WAIT_V(n) asm volatile("s_waitcnt vmcnt(" #n ")" ::: "memory")
#define PG8_WAIT_L(n) asm volatile("s_waitcnt lgkmcnt(" #n ")" ::: "memory")
#define PG8_BAR __builtin_amdgcn_s_barrier()
#define PG8_SCHED __builtin_amdgcn_sched_barrier(0)
    Unit cur, nxt; int ui = 0;
    if (!S.next(0, cur)) return;
    f32x4 acc[2][2][4][2];
#pragma unroll
    for (int a = 0; a < 2; ++a)
#pragma unroll
        for (int b = 0; b < 2; ++b)
#pragma unroll
            for (int m = 0; m < 4; ++m)
#pragma unroll
                for (int n = 0; n < 2; ++n) acc[a][b][m][n] = (f32x4){0.f, 0.f, 0.f, 0.f};
    bf16x8 At[4][2], B0[2][2], B1[2][2];
    const char* cA = (const char*)g.A + (size_t)cur.pm * tstep; const char* cB = (const char*)g.Bt + (size_t)cur.pn * tstep;
    S.a_ready(cur);
    if constexpr (SP2) {
        PG8_STAGE(PG8_SB(0, 0), cB, voffB); PG8_STAGE(PG8_SB(0, 1), cB + hstep, voffB); PG8_STAGE(PG8_SA(0, 0), cA, voffA); PG8_STAGE(PG8_SA(0, 1), cA + hstep, voffA);
        if (wr == 1) PG8_BAR;
        PG8_WAIT_V(2); PG8_BAR;
        PG8_STAGE(PG8_SB(1, 0), cB + kstep, voffB); PG8_STAGE(PG8_SA(1, 0), cA + kstep, voffA); PG8_STAGE(PG8_SB(1, 1), cB + hstep + kstep, voffB);
        PG8_WAIT_V(6); PG8_BAR;
    } else {
        PG8_STAGE(PG8_SB(0, 0), cB, voffB); PG8_STAGE(PG8_SA(0, 0), cA, voffA); PG8_STAGE(PG8_SB(0, 1), cB + hstep, voffB); PG8_STAGE(PG8_SA(0, 1), cA + hstep, voffA);
        if (wr == 1) PG8_BAR;
        PG8_WAIT_V(4); PG8_BAR;
        PG8_STAGE(PG8_SB(1, 0), cB + kstep, voffB); PG8_STAGE(PG8_SA(1, 0), cA + kstep, voffA); PG8_STAGE(PG8_SB(1, 1), cB + hstep + kstep, voffB);
        PG8_WAIT_V(6); PG8_BAR;
    }
    for (;;) {
        const bool has_next = S.next(ui + 1, nxt);
        const char* nA = has_next ? (const char*)g.A + (size_t)nxt.pm * tstep : cA; const char* nB = has_next ? (const char*)g.Bt + (size_t)nxt.pn * tstep : cB;
        for (int t = 0; t < nt; t += 2) {
            const bool last = (t == nt - 2);
            const char* a1 = cA + (size_t)(t + 1) * kstep;
            const char* a2 = last ? nA : cA + (size_t)(t + 2) * kstep; const char* b2 = last ? nB : cB + (size_t)(t + 2) * kstep;
            const char* a3 = a2 + kstep; const char* b3 = b2 + kstep;
            if (last && has_next) S.a_ready(nxt);
            if constexpr (SP2) {
            PG8_LDB(B0, 0, 0); PG8_LDB(B1, 0, 1); PG8_SCHED; PG8_LDA(At, 0, 0); PG8_STAGE(PG8_SA(1, 1), a1 + hstep, voffA);
            PG8_WAIT_V(8); PG8_WAIT_L(0); PG8_BAR; PG8_MMA(0, 0, At, B0); PG8_MMA(0, 1, At, B1); PG8_BAR; PG8_SCHED;
            PG8_LDA(At, 0, 1); PG8_STAGE(PG8_SB(0, 0), b2, voffB); PG8_STAGE(PG8_SB(0, 1), b2 + hstep, voffB); PG8_STAGE(PG8_SA(0, 0), a2, voffA);
            PG8_WAIT_V(8); PG8_WAIT_L(0); PG8_BAR; PG8_MMA(1, 0, At, B0); PG8_MMA(1, 1, At, B1); PG8_BAR; PG8_SCHED;
            PG8_LDB(B0, 1, 0); PG8_LDB(B1, 1, 1); PG8_SCHED; PG8_LDA(At, 1, 0); PG8_STAGE(PG8_SA(0, 1), a2 + hstep, voffA);
            PG8_WAIT_V(8); PG8_WAIT_L(0); PG8_BAR; PG8_MMA(0, 0, At, B0); PG8_MMA(0, 1, At, B1); PG8_BAR; PG8_SCHED;
            PG8_LDA(At, 1, 1); PG8_STAGE(PG8_SB(1, 0), b3, voffB); PG8_STAGE(PG8_SB(1, 1), b3 + hstep, voffB); PG8_STAGE(PG8_SA(1, 0), a3, voffA);
            PG8_WAIT_V(8); PG8_WAIT_L(0); PG8_BAR; PG8_MMA(1, 0, At, B0); PG8_MMA(1, 1, At, B1); PG8_BAR; PG8_SCHED;
            } else {
            PG8_LDB(B0, 0, 0); PG8_SCHED; PG8_LDA(At, 0, 0); PG8_STAGE(PG8_SA(1, 1), a1 + hstep, voffA);
            PG8_WAIT_L(8); PG8_BAR; PG8_WAIT_L(0); PG8_MMA(0, 0, At, B0); PG8_BAR; PG8_SCHED;
            PG8_LDB(B1, 0, 1); PG8_STAGE(PG8_SB(0, 0), b2, voffB);
            PG8_BAR; PG8_WAIT_L(0); PG8_MMA(0, 1, At, B1); PG8_BAR;
            PG8_LDA(At, 0, 1); PG8_STAGE(PG8_SA(0, 0), a2, voffA);
            PG8_BAR; PG8_WAIT_L(0); PG8_MMA(1, 0, At, B0); PG8_BAR; PG8_SCHED;
            PG8_STAGE(PG8_SB(0, 1), b2 + hstep, voffB);
            PG8_WAIT_V(6); PG8_BAR; PG8_MMA(1, 1, At, B1); PG8_BAR;
            PG8_LDB(B0, 1, 0); PG8_SCHED; PG8_LDA(At, 1, 0); PG8_STAGE(PG8_SA(0, 1), a2 + hstep, voffA);
            PG8_WAIT_L(8); PG8_BAR; PG8_WAIT_L(0); PG8_MMA(0, 0, At, B0); PG8_BAR; PG8_SCHED;
            PG8_LDB(B1, 1, 1); PG8_STAGE(PG8_SB(1, 0), b3, voffB);
            PG8_BAR; PG8_WAIT_L(0); PG8_MMA(0, 1, At, B1); PG8_BAR;
            PG8_LDA(At, 1, 1); PG8_STAGE(PG8_SA(1, 0), a3, voffA);
            PG8_BAR; PG8_WAIT_L(0); PG8_MMA(1, 0, At, B0); PG8_BAR; PG8_SCHED;
            PG8_STAGE(PG8_SB(1, 1), b3 + hstep, voffB);
            PG8_WAIT_V(6); PG8_BAR; PG8_MMA(1, 1, At, B1); PG8_BAR;
            }
        }
        if constexpr (ALIGN_EPI) { if (wr == 0) PG8_BAR; }
        if constexpr (!Epi::AFTER_DRAIN) { E(acc, cur, wr, wc, fr, fq); S.done(cur); }
        if (!has_next) break;
#pragma unroll
        for (int a = 0; a < 2; ++a)
#pragma unroll
            for (int b = 0; b < 2; ++b)
#pragma unroll
                for (int m = 0; m < 4; ++m)
#pragma unroll
                    for (int n = 0; n < 2; ++n) acc[a][b][m][n] = (f32x4){0.f, 0.f, 0.f, 0.f};
        cur = nxt; cA = nA; cB = nB; ++ui;
        if constexpr (ALIGN_EPI) { if (wr == 1) PG8_BAR; }
    }
    PG8_WAIT_V(0);
    if constexpr (!ALIGN_EPI) { if (wr == 0) PG8_BAR; }
    PG8_BAR;
    if constexpr (Epi::AFTER_DRAIN) { E.fused(acc, cur, wr, wc, fr, fq, lds, wid, lane); S.done(cur); }
#undef PG8_SA
#undef PG8_SB
#undef PG8_STAGE
#undef PG8_LDA
#undef PG8_LDB
#undef PG8_MMA
#undef PG8_WAIT_V
#undef PG8_WAIT_L
#undef PG8_BAR
#undef PG8_SCHED
}
}

constexpr int DM = 2048, DFF = 5632, DIN = 12800, NCTX = 4096, NLAT = 2048, MTOK = 6144, DEPTH = 2;
constexpr int SEQ = 256, DSEQ = 1024, NSEQ = 18;
constexpr int ZQ = 0, ZFF = 512, ZFB = 1024, ZI = 1536, ZO = 2048, ZLX = 2560, ZLG = 3072, ZFW = 3584;
constexpr int NWAVES = 8, NTHREADS = 512;
constexpr size_t MiB = 1u << 20;
constexpr size_t WS_CTL = 0, CTL_ZERO_BYTES = 1 * MiB;
constexpr size_t WS_W = 2 * MiB, W_LAYER = 198 * MiB;
constexpr size_t WO_UP1 = 0, WO_DN1 = 44 * MiB, WO_UP2 = 66 * MiB, WO_DN2 = 110 * MiB, WO_IN = 132 * MiB, WO_PA = 182 * MiB, WO_PB = 184 * MiB, WO_PC = 188 * MiB, WO_OUT = 190 * MiB;
constexpr size_t WS_X = 398 * MiB;
constexpr size_t WS_H = 446 * MiB;
constexpr size_t WS_HID = 470 * MiB;
constexpr size_t WS_ZF = 536 * MiB;
constexpr size_t WS_QB = 620 * MiB;
constexpr size_t WS_KB = 632 * MiB;
constexpr size_t WS_VT = 644 * MiB;
constexpr size_t WS_GB = 656 * MiB;
constexpr size_t WS_CKB = 728 * MiB;
constexpr size_t WS_CVT = 732 * MiB;
constexpr size_t WS_OA = 836 * MiB, WS_OB = 842 * MiB, WS_OC = 854 * MiB;
constexpr size_t WS_MACC = 860 * MiB;
constexpr size_t WS_MB = 908 * MiB;
constexpr size_t WS_MODP = 932 * MiB;
constexpr size_t WS_MODS = 946 * MiB;
constexpr size_t WS_HOL = 947 * MiB;
constexpr size_t WS_HQD = 971 * MiB;
constexpr size_t WS_HSL = 995 * MiB;
constexpr size_t WS_HDEC = 1043 * MiB;
constexpr size_t WS_LHL = 1044 * MiB;
constexpr size_t WS_LPP = 1068 * MiB;
constexpr size_t WS_END = 1092 * MiB;
constexpr int CW_BAR = 4096;
constexpr int CW_Q = 16384;
constexpr int RING_BYTES = 131072, LDSCTL_OFF = 143360, LDS_BYTES = 147456;

#define GAS __attribute__((address_space(1)))
#define LAS __attribute__((address_space(3)))
typedef unsigned short bf16;
typedef unsigned v4u __attribute__((ext_vector_type(4)));
typedef unsigned v2u __attribute__((ext_vector_type(2)));
typedef float f32x4 __attribute__((ext_vector_type(4)));
typedef short bf16x8 __attribute__((ext_vector_type(8)));
typedef GAS unsigned gu32;
#define RLX_AGENT __ATOMIC_RELAXED, __HIP_MEMORY_SCOPE_AGENT
#define LDS_WAIT() asm volatile("s_waitcnt lgkmcnt(0)" ::: "memory")
#define VM_WAIT() asm volatile("s_waitcnt vmcnt(0)" ::: "memory")
__device__ __forceinline__ unsigned f2bf(float f) { unsigned u = __builtin_bit_cast(unsigned, f); return (u + 0x7fffu + ((u >> 16) & 1u)) >> 16; }
__device__ __forceinline__ unsigned pk2(float lo, float hi) { return pg8::cvt_pk_bf16(lo, hi); }
__device__ __forceinline__ float wave_sum(float v) {
#pragma unroll
    for (int o = 1; o < 64; o <<= 1) v += __shfl_xor(v, o);
    return v;
}
using pg8::silu_f; using pg8::sigmoid_f;
#define XB_TMO      128
#define XB_XCNT(j)  (256  + 64 * (j))
#define XB_XSUB(j)  (1280 + 64 * (j))
#define XB_XGEN(j)  (2304 + 64 * (j))
#define XB_TOP      3328
#define XB_TOPGEN   3392
#define XCD_BAR_WORDS 3456
#define XB_SPIN_CAP (1u << 18)

__device__ __forceinline__ unsigned xb_ld(unsigned* p)              { return __hip_atomic_load(p, __ATOMIC_RELAXED, __HIP_MEMORY_SCOPE_AGENT); }
__device__ __forceinline__ unsigned xb_add(unsigned* p, unsigned v) { return __hip_atomic_fetch_add(p, v, __ATOMIC_RELAXED, __HIP_MEMORY_SCOPE_AGENT); }
__device__ __forceinline__ unsigned xb_xcc_id() { return (unsigned)__builtin_amdgcn_s_getreg((3 << 11) | 20) & 0xFu; }
#define XB_SPIN(cond, bar) do { unsigned _sp = 0; while (cond) { __builtin_amdgcn_s_sleep(1); \
    if ((++_sp & 255u) == 0u) { if (xb_ld(&(bar)[XB_TMO])) break; if (_sp > XB_SPIN_CAP) { atomicAdd(&(bar)[XB_TMO], 1u); break; } } } } while (0)

struct XcdBarrier {
    unsigned* bar; unsigned x;
    volatile LAS unsigned* st;
};

__device__ __forceinline__ XcdBarrier xcd_barrier_post(unsigned* bar, volatile LAS unsigned* st) {
    XcdBarrier b; b.bar = bar; b.x = xb_xcc_id(); b.st = st;
    if (threadIdx.x == 0) (void)xb_add(&bar[XB_XCNT(b.x)], 1u);
    return b;
}
__device__ __forceinline__ void xcd_barrier_complete(unsigned* bar, unsigned x, unsigned& nloc, unsigned& nx) {
    const unsigned G = gridDim.x * gridDim.y * gridDim.z;
    unsigned sum, cnt, mine, sp = 0u;
    for (;;) {
        sum = 0u; cnt = 0u; mine = 0u;
#pragma unroll
        for (unsigned j = 0; j < 16; ++j) { const unsigned c = xb_ld(&bar[XB_XCNT(j)]); sum += c; cnt += (c > 0u) ? 1u : 0u; mine = (j == x) ? c : mine; }
        if (sum == G) break;
        __builtin_amdgcn_s_sleep(1);
        if ((++sp & 255u) == 0u) { if (xb_ld(&bar[XB_TMO])) break; if (sp > XB_SPIN_CAP) { atomicAdd(&bar[XB_TMO], 1u); break; } }
    }
    nloc = mine > 0u ? mine : 1u; nx = cnt > 0u ? cnt : 1u;
}

__device__ __forceinline__ void xcd_barrier(const XcdBarrier& b) {
    asm volatile("s_waitcnt vmcnt(0)" ::: "memory");
    __syncthreads();
    if (threadIdx.x == 0) {
        unsigned* bar = b.bar;
        __builtin_amdgcn_s_waitcnt(0);
        unsigned nloc = b.st[0], nx = b.st[1];
        if (nloc == 0u) { xcd_barrier_complete(bar, b.x, nloc, nx); b.st[0] = nloc; b.st[1] = nx; }
        const unsigned old = xb_add(&bar[XB_XSUB(b.x)], 1u);
        const unsigned gen = old / nloc;
        if (old + 1u == (gen + 1u) * nloc) {
            __builtin_amdgcn_fence(__ATOMIC_RELEASE, "agent");
            asm volatile("s_waitcnt vmcnt(0)" ::: "memory");
            const unsigned og = xb_add(&bar[XB_TOP], 1u);
            const unsigned tg = og / nx;
            if (og + 1u == (tg + 1u) * nx) xb_add(&bar[XB_TOPGEN], 1u);
            else XB_SPIN(xb_ld(&bar[XB_TOPGEN]) == tg, bar);
            __builtin_amdgcn_fence(__ATOMIC_ACQUIRE, "agent");
            xb_add(&bar[XB_XGEN(b.x)], 1u);
            asm volatile("s_waitcnt vmcnt(0)" ::: "memory");
        } else {
            XB_SPIN(xb_ld(&bar[XB_XGEN(b.x)]) == gen, bar);
            __builtin_amdgcn_fence(__ATOMIC_ACQUIRE, "agent");
            asm volatile("s_waitcnt vmcnt(0)" ::: "memory");
        }
    }
    __syncthreads();
}

struct Args { const float* in[31]; float* out; unsigned char* ws; int ph_lo, ph_hi; };
enum { I_XP = 0, I_XS, I_CK, I_CV, I_SHG, I_SLRU, I_C, I_CCTX, I_MODW, I_MODB, I_NORMG, I_F1UP, I_F1DN, I_F2UP, I_F2DN, I_WIN, I_LBL, I_HGN, I_RPB, I_CONVW, I_CONVB,
       I_LWA, I_LBA, I_LWX, I_LBX, I_LAM, I_PA, I_PB, I_PC, I_WOUT, I_FNG };
constexpr size_t OUT_Y = 0, OUT_K = 12582912, OUT_V = 20971520, OUT_SH = 29360128, OUT_SL = 33554432;

#ifndef PROBE_ZERO_YS
#define PROBE_ZERO_YS 0
#endif
#ifndef PROBE_ZERO_YP
#define PROBE_ZERO_YP 0
#endif
struct Frame { LAS unsigned char* lds; int tid, lane, wave, G, gw, NGW; };
__device__ __forceinline__ int opq(int v) { asm volatile("" : "+v"(v)); return v; }

__device__ __forceinline__ int next_unit(gu32* head, volatile LAS unsigned* slot) {
    __syncthreads();
    if (threadIdx.x == 0) *slot = __hip_atomic_fetch_add(head, 1u, RLX_AGENT);
    __syncthreads();
    return (int)*slot;
}

__device__ __forceinline__ void cv_load(const float* W, int N, int k0, int n0, int lane, float (&v)[32]) {
#pragma unroll
    for (int i = 0; i < 32; ++i) v[i] = __builtin_nontemporal_load(W + (size_t)(k0 + 2 * i + (lane >> 5)) * N + n0 + (lane & 31));
}
__device__ __forceinline__ void cv_store(const float (&v)[32], int K, bf16* WT, int dst_row0, LAS float* scr, int k0, int lane) {
#pragma unroll
    for (int i = 0; i < 32; ++i) scr[(2 * i + (lane >> 5)) * 33 + (lane & 31)] = v[i];
    LDS_WAIT(); asm volatile("" ::: "memory");
    const int c = lane & 7;
#pragma unroll
    for (int j = 0; j < 4; ++j) { const int n = (lane >> 3) + 8 * j; const LAS float* s = scr + (8 * c) * 33 + n;
        v4u o; o.x = pk2(s[0 * 33], s[1 * 33]); o.y = pk2(s[2 * 33], s[3 * 33]); o.z = pk2(s[4 * 33], s[5 * 33]); o.w = pk2(s[6 * 33], s[7 * 33]);
        *(v4u*)(WT + (size_t)(dst_row0 + n) * K + k0 + 8 * c) = o; }
    LDS_WAIT(); asm volatile("" ::: "memory");
}
constexpr int CV_UP = 32 * 352, CV_DN = 88 * 64, CV_IN = 32 * 400, CV_A = 8 * 64, CV_B = 16 * 64, CV_O = 32 * 64, CV_PER_LAYER = 2 * CV_UP + 2 * CV_DN + CV_IN + 2 * CV_A + CV_B + CV_O;
constexpr int CV_CLAIM = 16, CV_CPL = CV_PER_LAYER / CV_CLAIM, CV_NCLAIM = DEPTH * CV_CPL, CV_STATIC = CV_UP / CV_CLAIM;
static_assert(CV_PER_LAYER % CV_CLAIM == 0 && CV_UP % CV_CLAIM == 0, "claims");
__device__ __forceinline__ int cv_need(int l, int j) {
    constexpr int T_DN1 = (CV_UP + CV_DN) / CV_CLAIM, T_IN = T_DN1 + CV_IN / CV_CLAIM, T_MRG = T_IN + (2 * CV_A + CV_B) / CV_CLAIM, T_OUT = T_MRG + CV_O / CV_CLAIM, T_UP2 = T_OUT + CV_UP / CV_CLAIM, T_DN2 = T_UP2 + CV_DN / CV_CLAIM;
    const int r = j == 0 ? T_DN1 : j <= 2 ? T_IN : j <= 5 ? T_MRG : j == 6 ? T_OUT : j <= 8 ? T_UP2 : j == 9 ? T_DN2 : T_DN2 + CV_STATIC;
    const int n = l * CV_CPL + r; return n < CV_NCLAIM ? n : CV_NCLAIM;
}
struct CvItem { const float* W; bf16* WT; int K, N, k0, n0, drow; };
__device__ __forceinline__ CvItem cv_decode(const Args& A, int it) {
    const int l = it / CV_PER_LAYER; int r = it % CV_PER_LAYER;
    unsigned char* wl = A.ws + WS_W + (size_t)l * W_LAYER;
    const float* W; int K, N; bf16* WT; int up = 0;
    if (r < CV_UP) { W = A.in[I_F1UP] + (size_t)l * DM * 2 * DFF; K = DM; N = 2 * DFF; WT = (bf16*)(wl + WO_UP1); up = 1; }
    else if ((r -= CV_UP) < CV_DN) { W = A.in[I_F1DN] + (size_t)l * DFF * DM; K = DFF; N = DM; WT = (bf16*)(wl + WO_DN1); }
    else if ((r -= CV_DN) < CV_IN) { W = A.in[I_WIN] + (size_t)l * DM * DIN; K = DM; N = DIN; WT = (bf16*)(wl + WO_IN); }
    else if ((r -= CV_IN) < CV_A) { W = A.in[I_PA] + (size_t)l * 512 * DM; K = 512; N = DM; WT = (bf16*)(wl + WO_PA); }
    else if ((r -= CV_A) < CV_B) { W = A.in[I_PB] + (size_t)l * 1024 * DM; K = 1024; N = DM; WT = (bf16*)(wl + WO_PB); }
    else if ((r -= CV_B) < CV_A) { W = A.in[I_PC] + (size_t)l * 512 * DM; K = 512; N = DM; WT = (bf16*)(wl + WO_PC); }
    else if ((r -= CV_A) < CV_O) { W = A.in[I_WOUT] + (size_t)l * DM * DM; K = DM; N = DM; WT = (bf16*)(wl + WO_OUT); }
    else if ((r -= CV_O) < CV_UP) { W = A.in[I_F2UP] + (size_t)l * DM * 2 * DFF; K = DM; N = 2 * DFF; WT = (bf16*)(wl + WO_UP2); up = 1; }
    else { r -= CV_UP; W = A.in[I_F2DN] + (size_t)l * DFF * DM; K = DFF; N = DM; WT = (bf16*)(wl + WO_DN2); }
    const int nblk = N / 32, kb = r / nblk, nb = r % nblk, n0 = 32 * nb;
    int drow = n0;
    if (up) { const int j0 = n0 < DFF ? n0 : n0 - DFF; drow = 256 * (j0 >> 7) + (j0 & 127) + (n0 < DFF ? 0 : 128); }
    CvItem c; c.W = W; c.WT = WT; c.K = K; c.N = N; c.k0 = 64 * kb; c.n0 = n0; c.drow = drow; return c;
}
__device__ __forceinline__ void p0_convert(const Frame& F_, const Args& A) {
    Frame F = F_; F.tid = opq(F_.tid); F.lane = F.tid & 63;
    LAS float* scr = (LAS float*)(F.lds + F.wave * 16384);
    for (int it = F.gw; it < CV_UP; it += F.NGW) { const CvItem c = cv_decode(A, it); float v[32]; cv_load(c.W, c.N, c.k0, c.n0, F.lane, v); cv_store(v, c.K, c.WT, c.drow, scr, c.k0, F.lane); }
}
__device__ __forceinline__ void cv_until(const Frame& F_, const Args& A, gu32* head, int need, gu32* fin, volatile LAS unsigned* slot) {
    Frame F = F_; F.tid = opq(F_.tid); F.lane = F.tid & 63;
    LAS float* scr = (LAS float*)(F.lds + F.wave * 16384);
    if (fin) { __syncthreads(); if (F.tid == 0) __hip_atomic_fetch_add(fin, 1u, RLX_AGENT); }
    for (;;) {
        __syncthreads();
        if (F.tid == 0) { const unsigned f = fin ? __hip_atomic_load(fin, RLX_AGENT) : 0xffffffffu, h = CV_STATIC + __hip_atomic_load(head, RLX_AGENT);
            slot[1] = f; slot[0] = (h >= (unsigned)need && f >= (unsigned)F.G) ? 0x7fffffffu : CV_STATIC + __hip_atomic_fetch_add(head, 1u, RLX_AGENT); }
        __syncthreads();
        const int c = (int)slot[0]; const bool others_done = slot[1] >= (unsigned)F.G;
        if (c >= CV_NCLAIM) break;
        { const CvItem c0 = cv_decode(A, c * CV_CLAIM + 2 * F.wave), c1 = cv_decode(A, c * CV_CLAIM + 2 * F.wave + 1); float v0[32], v1[32];
          cv_load(c0.W, c0.N, c0.k0, c0.n0, F.lane, v0); cv_load(c1.W, c1.N, c1.k0, c1.n0, F.lane, v1);
          cv_store(v0, c0.K, c0.WT, c0.drow, scr, c0.k0, F.lane); cv_store(v1, c1.K, c1.WT, c1.drow, scr, c1.k0, F.lane); }
        if (c >= need && others_done) break;
    }
}
__device__ __forceinline__ void p0_cache(const Frame& F_, const Args& A) {
    Frame F = F_; F.tid = opq(F_.tid); F.lane = F.tid & 63;
    const int gt = blockIdx.x * NTHREADS + F.tid, NT = F.G * NTHREADS;
    bf16* CKB = (bf16*)(A.ws + WS_CKB); bf16* CVT = (bf16*)(A.ws + WS_CVT);
    for (int i = gt; i < 2 * 2 * 512 * 1024 / 8; i += NT) { const float* p = A.in[I_CK] + (size_t)i * 8; const f32x4 a = *(const f32x4*)p, b = *(const f32x4*)(p + 4);
        v4u o; o.x = pk2(a.x, a.y); o.y = pk2(a.z, a.w); o.z = pk2(b.x, b.y); o.w = pk2(b.z, b.w); *(v4u*)(CKB + (size_t)i * 8) = o; }
    for (int i = gt; i < 2 * 2 * 64 * 1024; i += NT) {
        const int hd = i & 1023, jb = (i >> 10) & 63, bl = i >> 16; const float* p = A.in[I_CV] + ((size_t)(bl * 512 + jb * 8)) * 1024 + hd;
        v4u o; o.x = pk2(p[0], p[1024]); o.y = pk2(p[2048], p[3072]); o.z = pk2(p[4096], p[5120]); o.w = pk2(p[6144], p[7168]);
        *(v4u*)(CVT + ((size_t)(bl * 8 + (hd >> 7)) * 128 + (hd & 127)) * 512 + jb * 8) = o; }
}
__device__ __forceinline__ void p0_mods_partial(const Frame& F_, const Args& A) {
    Frame F = F_; F.tid = opq(F_.tid); F.lane = F.tid & 63;
    float* MODP = (float*)(A.ws + WS_MODP);
    const float* cc = A.in[I_CCTX]; const float* c1 = A.in[I_C];
    for (int task = F.gw; task < 2 * 32 * 72; task += F.NGW) {
        const int l = task / 2304, r = task % 2304, kc = r / 72, nb = r % 72, n = nb * 256 + F.lane * 4;
        const float* w = A.in[I_MODW] + ((size_t)l * DM + kc * 64) * 18432 + n;
        f32x4 a0 = {0.f, 0.f, 0.f, 0.f}, a1 = a0, a2 = a0;
#pragma unroll 4
        for (int k = 0; k < 64; ++k) { const f32x4 wv = *(const f32x4*)(w + (size_t)k * 18432); const int kk = kc * 64 + k;
            const float s0 = silu_f(cc[kk]), s1 = silu_f(c1[kk]), s2 = silu_f(c1[DM + kk]);
            a0 += wv * s0; a1 += wv * s1; a2 += wv * s2; }
        float* o = MODP + (size_t)kc * 110592 + (size_t)l * 55296 + n;
        *(f32x4*)(o) = a0; *(f32x4*)(o + 18432) = a1; *(f32x4*)(o + 2 * 18432) = a2;
    }
}
__device__ __forceinline__ void p0_mods_reduce(const Frame& F_, const Args& A) {
    Frame F = F_; F.tid = opq(F_.tid); F.lane = F.tid & 63;
    const float* MODP = (const float*)(A.ws + WS_MODP); float* MODS = (float*)(A.ws + WS_MODS);
    for (int idx = blockIdx.x * NTHREADS + F.tid; idx < 110592; idx += F.G * NTHREADS) {
        const int l = idx / 55296, n = idx % 18432; float s = A.in[I_MODB][l * 18432 + n];
#pragma unroll 8
        for (int kc = 0; kc < 32; ++kc) s += MODP[(size_t)kc * 110592 + idx];
        MODS[idx] = s;
    }
}
template <int MODE>
__device__ __forceinline__ void norm_rows(const Frame& F_, const float* x0, const float* x1, float* xcopy, const float* g, const float* mods_l, int slot, bf16* H, float* outf) {
    Frame F = F_; F.tid = opq(F_.tid); F.lane = F.tid & 63;
    for (int row = F.gw; row < MTOK; row += F.NGW) {
        const float* xr = row < NCTX ? x0 + (size_t)row * DM : x1 + (size_t)(row - NCTX) * DM;
        const int cidx = row < NCTX ? 0 : 1 + ((row - NCTX) >> 10);
        f32x4 v[8]; float ss = 0.f;
#pragma unroll
        for (int j = 0; j < 8; ++j) { v[j] = *(const f32x4*)(xr + 4 * F.lane + 256 * j); ss += (v[j].x * v[j].x + v[j].y * v[j].y) + (v[j].z * v[j].z + v[j].w * v[j].w); }
        const float rstd = 1.0f / sqrtf(wave_sum(ss) * (1.0f / DM) + 1e-6f);
        if (MODE == 0) {
            const float* sh = mods_l + (size_t)(cidx * 9 + 3 * slot) * DM; const float* sc = sh + DM;
#pragma unroll
            for (int j = 0; j < 8; ++j) { const int c = 4 * F.lane + 256 * j; const f32x4 gg = *(const f32x4*)(g + c), s1 = *(const f32x4*)(sc + c), s0 = *(const f32x4*)(sh + c);
                const f32x4 y = v[j] * rstd * gg * (s1 + 1.0f) + s0; v2u o; o.x = pk2(y.x, y.y); o.y = pk2(y.z, y.w);
                *(v2u*)(H + (size_t)row * DM + c) = o;
                if (xcopy) *(f32x4*)(xcopy + (size_t)row * DM + c) = v[j]; }
        } else {
#pragma unroll
            for (int j = 0; j < 8; ++j) { const int c = 4 * F.lane + 256 * j; const f32x4 gg = *(const f32x4*)(g + c);
                f32x4 yv = v[j] * rstd * gg;
#if PROBE_ZERO_YS
                if (row >= NCTX) yv = (f32x4){0.f, 0.f, 0.f, 0.f};
#endif
#if PROBE_ZERO_YP
                if (row < NCTX) yv = (f32x4){0.f, 0.f, 0.f, 0.f};
#endif
                *(f32x4*)(outf + (size_t)row * DM + c) = yv; }
        }
    }
}

constexpr int AK_STRIDE = 272, AV_STRIDE = 528, A_K_OFF = 0, A_V_OFF = 69632;
constexpr float NA_SCALE = 0.08838834764831845f;
__device__ __forceinline__ void attn_stage(LAS unsigned char* lds, int tid, const bf16* kbase, size_t kstride, const bf16* vbase, size_t vstride) {
    v4u kx[8], vx[8];
#pragma unroll
    for (int i = 0; i < 8; ++i) { const int idx = tid + 512 * i; kx[i] = *(const v4u*)(kbase + (size_t)(idx >> 4) * kstride + (idx & 15) * 8); }
#pragma unroll
    for (int i = 0; i < 8; ++i) { const int idx = tid + 512 * i; vx[i] = *(const v4u*)(vbase + (size_t)(idx >> 5) * vstride + (idx & 31) * 8); }
#pragma unroll
    for (int i = 0; i < 8; ++i) { const int idx = tid + 512 * i; *(LAS v4u*)(lds + A_K_OFF + (idx >> 4) * AK_STRIDE + (idx & 15) * 16) = kx[i]; }
#pragma unroll
    for (int i = 0; i < 8; ++i) { const int idx = tid + 512 * i; *(LAS v4u*)(lds + A_V_OFF + (idx >> 5) * AV_STRIDE + (idx & 31) * 16) = vx[i]; }
}
template <class KF, class VF>
__device__ __forceinline__ void attn_stage32(LAS unsigned char* lds, int tid, KF kf, VF vf) {
    { const int key = tid >> 1, half = tid & 1; const float* p = kf(key) + 64 * half; LAS unsigned char* dst = lds + A_K_OFF + key * AK_STRIDE + half * 128;
#pragma unroll
      for (int i = 0; i < 8; ++i) { const f32x4 a = *(const f32x4*)(p + 8 * i), b = *(const f32x4*)(p + 8 * i + 4);
          v4u o; o.x = pk2(a.x, a.y); o.y = pk2(a.z, a.w); o.z = pk2(b.x, b.y); o.w = pk2(b.z, b.w); *(LAS v4u*)(dst + 16 * i) = o; } }
    { const int kp = tid >> 2, dq = tid & 3; const float* p0 = vf(2 * kp) + 32 * dq; const float* p1 = vf(2 * kp + 1) + 32 * dq;
#pragma unroll
      for (int i = 0; i < 8; ++i) { const f32x4 a = *(const f32x4*)(p0 + 4 * i), b = *(const f32x4*)(p1 + 4 * i);
#pragma unroll
          for (int j = 0; j < 4; ++j) *(LAS unsigned*)(lds + A_V_OFF + (32 * dq + 4 * i + j) * AV_STRIDE + kp * 4) = pk2(a[j], b[j]); } }
}
__device__ __forceinline__ void attn_load_q32(const float* qrow, int g, bf16x8 (&qf)[4]) {
#pragma unroll
    for (int s = 0; s < 4; ++s) { const f32x4 a = *(const f32x4*)(qrow + 32 * s + 8 * g), b = *(const f32x4*)(qrow + 32 * s + 8 * g + 4);
        v4u o; o.x = pk2(a.x, a.y); o.y = pk2(a.z, a.w); o.z = pk2(b.x, b.y); o.w = pk2(b.z, b.w); qf[s] = __builtin_bit_cast(bf16x8, o); }
}
struct AttnState { float m, l; f32x4 ot[8]; };
template <int NKS, bool LOCAL, class BF>
__device__ __forceinline__ void attn_chunk(LAS unsigned char* lds, const bf16x8 (&qf)[4], AttnState& st, int lane, int t0, BF bias) {
    const int g = lane >> 4, c = lane & 15;
    f32x4 sc[NKS][2];
#pragma unroll
    for (int i = 0; i < NKS; ++i) { const int T0 = LOCAL ? 4 * i + t0 : 2 * i;
#pragma unroll
        for (int a = 0; a < 2; ++a) { f32x4 acc = {0.f, 0.f, 0.f, 0.f};
#pragma unroll
            for (int s = 0; s < 4; ++s) { const bf16x8 kfr = *(const LAS bf16x8*)(lds + A_K_OFF + (16 * (T0 + a) + c) * AK_STRIDE + 64 * s + 16 * g);
                acc = __builtin_amdgcn_mfma_f32_16x16x32_bf16(kfr, qf[s], acc, 0, 0, 0); }
            sc[i][a] = acc; } }
    float mx = -3.0e38f;
#pragma unroll
    for (int i = 0; i < NKS; ++i) { const int T0 = LOCAL ? 4 * i + t0 : 2 * i;
#pragma unroll
        for (int a = 0; a < 2; ++a)
#pragma unroll
            for (int r = 0; r < 4; ++r) { float s = sc[i][a][r] * NA_SCALE; if (LOCAL) s = bias(16 * (T0 + a) + 4 * g + r, s); sc[i][a][r] = s; mx = fmaxf(mx, s); } }
    mx = fmaxf(mx, __shfl_xor(mx, 16)); mx = fmaxf(mx, __shfl_xor(mx, 32));
    const float mnew = fmaxf(st.m, mx), alpha = __expf(st.m - mnew); float sum = 0.f;
#pragma unroll
    for (int i = 0; i < NKS; ++i)
#pragma unroll
        for (int a = 0; a < 2; ++a)
#pragma unroll
            for (int r = 0; r < 4; ++r) { const float p = __expf(sc[i][a][r] - mnew); sc[i][a][r] = p; sum += p; }
    sum += __shfl_xor(sum, 16); sum += __shfl_xor(sum, 32);
    st.l = st.l * alpha + sum; st.m = mnew;
#pragma unroll
    for (int dt = 0; dt < 8; ++dt) st.ot[dt] = st.ot[dt] * alpha;
#pragma unroll
    for (int i = 0; i < NKS; ++i) { const int T0 = LOCAL ? 4 * i + t0 : 2 * i;
        v4u pb; pb.x = pk2(sc[i][0][0], sc[i][0][1]); pb.y = pk2(sc[i][0][2], sc[i][0][3]); pb.z = pk2(sc[i][1][0], sc[i][1][1]); pb.w = pk2(sc[i][1][2], sc[i][1][3]);
        const bf16x8 pfr = __builtin_bit_cast(bf16x8, pb);
#pragma unroll
        for (int dt = 0; dt < 8; ++dt) { const LAS unsigned char* vp = lds + A_V_OFF + (16 * dt + c) * AV_STRIDE + (16 * T0 + 4 * g) * 2;
            const v2u lo = *(const LAS v2u*)vp, hi = *(const LAS v2u*)(vp + 32); v4u av; av.x = lo.x; av.y = lo.y; av.z = hi.x; av.w = hi.y;
            st.ot[dt] = __builtin_amdgcn_mfma_f32_16x16x32_bf16(__builtin_bit_cast(bf16x8, av), pfr, st.ot[dt], 0, 0, 0); } }
}
__device__ __forceinline__ void attn_load_q(const bf16* qrow, int g, bf16x8 (&qf)[4]) {
#pragma unroll
    for (int s = 0; s < 4; ++s) qf[s] = *(const bf16x8*)(qrow + 32 * s + 8 * g);
}
__device__ __forceinline__ void attn_store(const AttnState& st, bf16* orow, int g) {
    const float inv = 1.0f / st.l;
#pragma unroll
    for (int dt = 0; dt < 8; ++dt) { v2u o; o.x = pk2(st.ot[dt][0] * inv, st.ot[dt][1] * inv); o.y = pk2(st.ot[dt][2] * inv, st.ot[dt][3] * inv); *(v2u*)(orow + 16 * dt + 4 * g) = o; }
}
__device__ __forceinline__ void attn_ctx_unit(const Frame& F_, const Args& A, int u) {
    Frame F = F_; F.tid = opq(F_.tid); F.lane = F.tid & 63;
    const int b = u >> 4, h = (u >> 1) & 7, qh = u & 1, g = F.lane >> 4, c = F.lane & 15;
    const bf16* QB = (const bf16*)(A.ws + WS_QB); const bf16* KB = (const bf16*)(A.ws + WS_KB); const bf16* VT = (const bf16*)(A.ws + WS_VT);
    const int row = b * SEQ + qh * 128 + 16 * F.wave + c;
    bf16x8 qf[4];
#if PROBE_QKV32
    { const float* Z3 = (const float*)(A.ws + 736 * MiB); const float* zb = Z3 + (size_t)(b * SEQ) * 3072 + h * 128;
      attn_stage32(F.lds, F.tid, [&](int k) { return zb + (size_t)k * 3072 + 1024; }, [&](int k) { return zb + (size_t)k * 3072 + 2048; });
      attn_load_q32(Z3 + (size_t)row * 3072 + h * 128, g, qf); }
#else
    attn_stage(F.lds, F.tid, KB + (size_t)(b * SEQ) * 1024 + h * 128, 1024, VT + (size_t)(b * 8 + h) * 128 * 256, 256);
    attn_load_q(QB + (size_t)row * 1024 + h * 128, g, qf);
#endif
    AttnState st; st.m = -3.0e38f; st.l = 0.f;
#pragma unroll
    for (int dt = 0; dt < 8; ++dt) st.ot[dt] = (f32x4){0.f, 0.f, 0.f, 0.f};
    __syncthreads();
    attn_chunk<8, false>(F.lds, qf, st, F.lane, 0, [](int, float s) { return s; });
    attn_store(st, (bf16*)(A.ws + WS_OB) + (size_t)row * 1024 + h * 128, g);
}
__device__ __forceinline__ void attn_na_unit(const Frame& F_, const Args& A, int u, int layer) {
    Frame F = F_; F.tid = opq(F_.tid); F.lane = F.tid & 63;
    const int b = u >> 7, h = (u >> 4) & 7, r = u & 15, g = F.lane >> 4, c = F.lane & 15, w = F.wave;
    const bf16* QB = (const bf16*)(A.ws + WS_QB); const bf16* KB = (const bf16*)(A.ws + WS_KB); const bf16* VT = (const bf16*)(A.ws + WS_VT);
    const int kr0 = min(max(r - 4, 0), 8);
    const int qc = 8 * w + (c & 7), row = NCTX + b * DSEQ + r * 64 + qc;
    const int wstart = min(max(qc - 8, 0), 48), t0 = min(max(8 * w - 8, 0), 40) >> 4;
    const float* rpb = A.in[I_RPB] + (size_t)(layer * 8 + h) * 15 * 31;
    bf16x8 qf[4];
#if PROBE_QKV32
    attn_load_q32((const float*)(A.ws + 736 * MiB) + (size_t)row * 3072 + h * 128, g, qf);
#else
    attn_load_q(QB + (size_t)row * 1024 + h * 128, g, qf);
#endif
    AttnState st; st.m = -3.0e38f; st.l = 0.f;
#pragma unroll
    for (int dt = 0; dt < 8; ++dt) st.ot[dt] = (f32x4){0.f, 0.f, 0.f, 0.f};
#if PROBE_QKV32
    const float* Z3 = (const float*)(A.ws + 736 * MiB); const float* zl = Z3 + (size_t)(NCTX + b * DSEQ) * 3072 + h * 128;
    for (int ci = 0; ci < 2; ++ci) {
        const int krow = kr0 + 4 * ci;
        if (ci) __syncthreads();
        attn_stage32(F.lds, F.tid, [&](int k) { return zl + (size_t)(krow * 64 + k) * 3072 + 1024; }, [&](int k) { return zl + (size_t)(krow * 64 + k) * 3072 + 2048; });
        __syncthreads();
        attn_chunk<4, true>(F.lds, qf, st, F.lane, t0, [&](int kk, float s) {
            const int ky = krow + (kk >> 6), kx = kk & 63; const bool ok = kx >= wstart && kx < wstart + 16;
            const int dy = ky - r + 7, dx = min(max(kx - qc + 15, 0), 30);
            return ok ? s + rpb[dy * 31 + dx] : -1.0e30f; });
    }
    const float* ck = A.in[I_CK] + ((size_t)(b * 2 + layer) * 512 * 8 + h) * 128; const float* cv = A.in[I_CV] + ((size_t)(b * 2 + layer) * 512 * 8 + h) * 128;
    for (int ci = 0; ci < 2; ++ci) {
        __syncthreads();
        attn_stage32(F.lds, F.tid, [&](int k) { return ck + (size_t)(ci * 256 + k) * 1024; }, [&](int k) { return cv + (size_t)(ci * 256 + k) * 1024; });
        __syncthreads();
        attn_chunk<8, false>(F.lds, qf, st, F.lane, 0, [](int, float s) { return s; });
    }
#else
    const bf16* kl = KB + (size_t)(NCTX + b * DSEQ) * 1024 + h * 128; const bf16* vl = VT + (size_t)4096 * 1024 + (size_t)(b * 8 + h) * 128 * 1024;
    for (int ci = 0; ci < 2; ++ci) {
        const int krow = kr0 + 4 * ci;
        if (ci) __syncthreads();
        attn_stage(F.lds, F.tid, kl + (size_t)(krow * 64) * 1024, 1024, vl + krow * 64, 1024);
        __syncthreads();
        attn_chunk<4, true>(F.lds, qf, st, F.lane, t0, [&](int kk, float s) {
            const int ky = krow + (kk >> 6), kx = kk & 63; const bool ok = kx >= wstart && kx < wstart + 16;
            const int dy = ky - r + 7, dx = min(max(kx - qc + 15, 0), 30);
            return ok ? s + rpb[dy * 31 + dx] : -1.0e30f; });
    }
    const bf16* ck = (const bf16*)(A.ws + WS_CKB) + (size_t)(b * 2 + layer) * 512 * 1024 + h * 128; const bf16* cv = (const bf16*)(A.ws + WS_CVT) + (size_t)((b * 2 + layer) * 8 + h) * 128 * 512;
    for (int ci = 0; ci < 2; ++ci) {
        __syncthreads();
        attn_stage(F.lds, F.tid, ck + (size_t)(ci * 256) * 1024, 1024, cv + ci * 256, 512);
        __syncthreads();
        attn_chunk<8, false>(F.lds, qf, st, F.lane, 0, [](int, float s) { return s; });
    }
#endif
    if (c < 8) attn_store(st, (bf16*)(A.ws + WS_OB) + (size_t)row * 1024 + h * 128, g);
}

__device__ __forceinline__ int hg_slot(int s, int h, int dir, int c) { return s < 16 ? s * 32 + c * 8 + h * 2 + dir : 512 + (s - 16) * 128 + c * 8 + h * 2 + dir; }
template <int CTRL> __device__ __forceinline__ float dpp_xor(float v) { return __builtin_bit_cast(float, __builtin_amdgcn_update_dpp(0, __builtin_bit_cast(int, v), CTRL, 0xf, 0xf, true)); }
__device__ __forceinline__ void hgrn_local_unit(const Frame& F_, const Args& A, int u, int layer) {
    Frame F = F_; F.tid = opq(F_.tid); F.lane = F.tid & 63;
    int s, c, hd;
    if (u < 512) { s = u >> 5; c = (u >> 3) & 3; hd = u & 7; } else { const int v = u - 512; s = 16 + (v >> 7); c = (v >> 3) & 15; hd = v & 7; }
    const int h = hd >> 1, dir = hd & 1, tokbase = s < 16 ? s * SEQ : NCTX + (s - 16) * DSEQ, g = F.lane >> 4, c15 = F.lane & 15, w = F.wave;
    const float* Z = (const float*)(A.ws + WS_ZF);
    constexpr int LS = 132, AS = 68;
    LAS float* Qt = (LAS float*)F.lds; LAS float* Kt = Qt + 64 * LS; LAS float* Vs = Kt + 64 * LS; LAS float* Bs = Vs + 64 * LS; LAS float* SC = Bs + 64 * LS; LAS float* As = Bs;
    const int d = F.tid & 127;
    {   float lbv = 0.f;
        if (layer == 1) { const float* lg = A.in[I_LBL]; lbv = sigmoid_f(lg[1024 + dir * 512 + h * 128 + d] - lg[dir * 512 + h * 128 + d]); }
        for (int i = F.tid >> 7; i < 64; i += 4) { const int t = dir ? 64 * c + 63 - i : 64 * c + i; const float* zr = Z + (size_t)(tokbase + t) * ZFW + h * 128 + d;
            const float zq = zr[ZQ], zf = zr[dir ? ZFB : ZFF], zv = zr[ZI], f = lbv + (1.f - lbv) * sigmoid_f(zf);
            Qt[i * LS + d] = silu_f(zq); Kt[i * LS + d] = (1.f - lbv) * sigmoid_f(-zf); Vs[i * LS + d] = zv; Bs[i * LS + d] = __logf(fmaxf(f, 1e-30f)); }
    }
    __syncthreads();
    if (F.tid < 128) { float b = 0.f;
#pragma unroll 8
        for (int i = 0; i < 64; ++i) { b += Bs[i * LS + d]; Bs[i * LS + d] = b; } }
    __syncthreads();
    {   float* QD = (float*)(A.ws + WS_HQD);
        for (int i = F.tid >> 7; i < 64; i += 4) { const int I = i >> 4, t = dir ? 64 * c + 63 - i : 64 * c + i;
            const float bi = Bs[i * LS + d], bs = I ? Bs[(16 * I - 1) * LS + d] : 0.f, be = Bs[(16 * I + 15) * LS + d], q = Qt[i * LS + d], k = Kt[i * LS + d];
            QD[((size_t)(tokbase + t) * 2 + dir) * 512 + h * 128 + d] = q * __expf(bi);
            Qt[i * LS + d] = q * __expf(bi - bs); Kt[i * LS + d] = k * __expf(be - bi); }
        for (int idx = F.tid; idx < 14 * 128; idx += NTHREADS) { const int v = idx >> 7, dd = idx & 127; int I, J;
            if (v < 6) { I = v < 1 ? 1 : (v < 3 ? 2 : 3); J = v < 1 ? 0 : (v < 3 ? v - 1 : v - 3); } else if (v < 10) { I = v - 6; J = I; } else { I = 4; J = v - 10; }
            const float bsI = I ? Bs[(16 * I - 1) * LS + dd] : 0.f, beJ = Bs[(16 * J + 15) * LS + dd];
            SC[idx] = __expf(bsI - beJ);
            if (v == 13) ((float*)(A.ws + WS_HDEC))[(size_t)u * 128 + dd] = __expf(bsI); }
    }
    __syncthreads();
    {
        float av[16];
#pragma unroll
        for (int ks = 0; ks < 16; ++ks) { const int j = 4 * ks + g; av[ks] = Kt[j * LS + 16 * w + c15] * SC[(10 + (j >> 4)) * 128 + 16 * w + c15]; }
        float* SL = (float*)(A.ws + WS_HSL) + (size_t)u * 16384;
        for (int et = 0; et < 8; ++et) { f32x4 acc = {0.f, 0.f, 0.f, 0.f};
#pragma unroll
            for (int ks = 0; ks < 16; ++ks) acc = __builtin_amdgcn_mfma_f32_16x16x4f32(av[ks], Vs[(4 * ks + g) * LS + 16 * et + c15], acc, 0, 0, 0);
#pragma unroll
            for (int r = 0; r < 4; ++r) SL[(16 * w + 4 * g + r) * 128 + 16 * et + c15] = acc[r]; }
    }
    for (int tl = w; tl < 10; tl += 8) {
        int I, J, sv;
        if (tl < 4) { I = tl; J = tl; sv = 6 + tl; } else { const int v = tl - 4; I = v < 1 ? 1 : (v < 3 ? 2 : 3); J = v < 1 ? 0 : (v < 3 ? v - 1 : v - 3); sv = v; }
        f32x4 acc = {0.f, 0.f, 0.f, 0.f};
#pragma unroll 8
        for (int ks = 0; ks < 32; ++ks) { const int dd = 4 * ks + g;
            acc = __builtin_amdgcn_mfma_f32_16x16x4f32(Qt[(16 * I + c15) * LS + dd] * SC[sv * 128 + dd], Kt[(16 * J + c15) * LS + dd], acc, 0, 0, 0); }
#pragma unroll
        for (int r = 0; r < 4; ++r) As[(16 * I + 4 * g + r) * AS + 16 * J + c15] = (I == J && c15 > 4 * g + r) ? 0.f : acc[r];
    }
    __syncthreads();
    {   float* OL = (float*)(A.ws + WS_HOL);
#pragma unroll
        for (int I = 0; I < 4; ++I) { f32x4 acc = {0.f, 0.f, 0.f, 0.f};
            for (int ks = 0; ks < 4 * (I + 1); ++ks) acc = __builtin_amdgcn_mfma_f32_16x16x4f32(As[(16 * I + c15) * AS + 4 * ks + g], Vs[(4 * ks + g) * LS + 16 * w + c15], acc, 0, 0, 0);
#pragma unroll
            for (int r = 0; r < 4; ++r) { const int i = 16 * I + 4 * g + r, t = dir ? 64 * c + 63 - i : 64 * c + i; OL[((size_t)(tokbase + t) * 2 + dir) * 512 + h * 128 + 16 * w + c15] = acc[r]; } }
    }
}
__device__ __forceinline__ void hgrn_final_unit(const Frame& F_, const Args& A, int u, int layer) {
    Frame F = F_; F.tid = opq(F_.tid); F.lane = F.tid & 63;
    int s, c, h, nC;
    if (u < 128) { s = 16 + (u >> 6); c = (u >> 2) & 15; h = u & 3; nC = 16; } else { const int v = u - 128; s = v >> 4; c = (v >> 2) & 3; h = v & 3; nC = 4; }
    const int tokbase = s < 16 ? s * SEQ : NCTX + (s - 16) * DSEQ, g = F.lane >> 4, c15 = F.lane & 15, w = F.wave;
    constexpr int LS = 132;
    LAS float* Ss = (LAS float*)F.lds; LAS float* Qd = Ss + 128 * LS; LAS float* Os = Qd + 64 * LS;
    const float* HSL = (const float*)(A.ws + WS_HSL); const float* HDEC = (const float*)(A.ws + WS_HDEC); const float* QD = (const float*)(A.ws + WS_HQD);
    f32x4 acc[4];
#pragma unroll
    for (int tt = 0; tt < 4; ++tt) acc[tt] = (f32x4){0.f, 0.f, 0.f, 0.f};
    for (int dir = 0; dir < 2; ++dir) {
        f32x4 S[8];
        if (s >= 16) { const float* s0 = A.in[I_SHG] + ((size_t)(((s - 16) * 2 + layer) * 2 + dir) * 4 + h) * 16384;
#pragma unroll
            for (int j = 0; j < 8; ++j) S[j] = *(const f32x4*)(s0 + 4 * (F.tid + 512 * j)); }
        else {
#pragma unroll
            for (int j = 0; j < 8; ++j) S[j] = (f32x4){0.f, 0.f, 0.f, 0.f}; }
        const int nprev = dir ? nC - 1 - c : c;
        if (nprev > 0) {
            f32x4 cur[8]; float dcur[8];
            { const int sl = hg_slot(s, h, dir, dir ? nC - 1 : 0);
#pragma unroll
              for (int j = 0; j < 8; ++j) { const int idx4 = F.tid + 512 * j; dcur[j] = HDEC[(size_t)sl * 128 + (idx4 >> 5)]; cur[j] = *(const f32x4*)(HSL + (size_t)sl * 16384 + 4 * idx4); } }
            for (int q = 0; q < nprev; ++q) {
                f32x4 nxt[8]; float dnx[8];
                const int qn = q + 1 < nprev ? q + 1 : q, sl = hg_slot(s, h, dir, dir ? nC - 1 - qn : qn);
#pragma unroll
                for (int j = 0; j < 8; ++j) { const int idx4 = F.tid + 512 * j; dnx[j] = HDEC[(size_t)sl * 128 + (idx4 >> 5)]; nxt[j] = *(const f32x4*)(HSL + (size_t)sl * 16384 + 4 * idx4); }
#pragma unroll
                for (int j = 0; j < 8; ++j) { S[j] = S[j] * dcur[j] + cur[j]; cur[j] = nxt[j]; dcur[j] = dnx[j]; }
            }
        }
        if (s < 16 && (dir ? c == 0 : c == nC - 1)) {
            const int sl = hg_slot(s, h, dir, c); float* so = A.out + OUT_SH + ((size_t)((s * 2 + layer) * 2 + dir) * 4 + h) * 16384;
#pragma unroll
            for (int j = 0; j < 8; ++j) { const int idx4 = F.tid + 512 * j; const float dc = HDEC[(size_t)sl * 128 + (idx4 >> 5)];
                *(f32x4*)(so + 4 * idx4) = S[j] * dc + *(const f32x4*)(HSL + (size_t)sl * 16384 + 4 * idx4); } }
        if (dir) __syncthreads();
#pragma unroll
        for (int j = 0; j < 8; ++j) { const int idx4 = F.tid + 512 * j; *(LAS f32x4*)(Ss + (idx4 >> 5) * LS + 4 * (idx4 & 31)) = S[j]; }
#pragma unroll
        for (int j = 0; j < 4; ++j) { const int idx4 = F.tid + 512 * j, i = idx4 >> 5;
            *(LAS f32x4*)(Qd + i * LS + 4 * (idx4 & 31)) = *(const f32x4*)(QD + ((size_t)(tokbase + 64 * c + i) * 2 + dir) * 512 + h * 128 + 4 * (idx4 & 31)); }
        __syncthreads();
        for (int ks = 0; ks < 32; ++ks) { const float bv = Ss[(4 * ks + g) * LS + 16 * w + c15];
#pragma unroll
            for (int tt = 0; tt < 4; ++tt) acc[tt] = __builtin_amdgcn_mfma_f32_16x16x4f32(Qd[(16 * tt + c15) * LS + 4 * ks + g], bv, acc[tt], 0, 0, 0); }
    }
    const float* OL = (const float*)(A.ws + WS_HOL);
#pragma unroll
    for (int tt = 0; tt < 4; ++tt)
#pragma unroll
        for (int r = 0; r < 4; ++r) { const int t = 16 * tt + 4 * g + r; const float* ol = OL + (size_t)(tokbase + 64 * c + t) * 1024 + h * 128 + 16 * w + c15;
            Os[t * LS + 16 * w + c15] = acc[tt][r] + ol[0] + ol[512]; }
    __syncthreads();
    {
        const int t = F.tid >> 3, seg = F.tid & 7; const size_t row = (size_t)(tokbase + 64 * c + t);
        f32x4 o[4]; float ss = 0.f;
#pragma unroll
        for (int j = 0; j < 4; ++j) { o[j] = *(const LAS f32x4*)(Os + t * LS + 16 * seg + 4 * j); ss += (o[j].x * o[j].x + o[j].y * o[j].y) + (o[j].z * o[j].z + o[j].w * o[j].w); }
        ss += __shfl_xor(ss, 1); ss += __shfl_xor(ss, 2); ss += __shfl_xor(ss, 4);
        const float rstd = 1.0f / sqrtf(ss * (1.0f / 128.f) + 1e-6f);
        const float* gn = A.in[I_HGN] + (size_t)(layer * 4 + h) * 128 + 16 * seg; const float* zo = (const float*)(A.ws + WS_ZF) + row * ZFW + ZO + h * 128 + 16 * seg;
        unsigned pk[8];
#pragma unroll
        for (int j = 0; j < 4; ++j) { const f32x4 gg = *(const f32x4*)(gn + 4 * j), zz = *(const f32x4*)(zo + 4 * j);
            pk[2 * j] = pk2(o[j].x * rstd * gg.x * silu_f(zz.x), o[j].y * rstd * gg.y * silu_f(zz.y)); pk[2 * j + 1] = pk2(o[j].z * rstd * gg.z * silu_f(zz.z), o[j].w * rstd * gg.w * silu_f(zz.w)); }
        bf16* oa = (bf16*)(A.ws + WS_OA) + row * 512 + h * 128 + 16 * seg;
        *(v4u*)oa = (v4u){pk[0], pk[1], pk[2], pk[3]}; *(v4u*)(oa + 8) = (v4u){pk[4], pk[5], pk[6], pk[7]};
    }
}

__device__ __forceinline__ float neg_expm1(float x) {
    return x > -0.03f ? -x * (1.f + x * (0.5f + x * (0.16666667f + x * 0.041666668f))) : 1.f - __expf(x);
}
__device__ __forceinline__ void lru_gate_unit(const Frame& F_, const Args& A, int u, int layer) {
    Frame F = F_; F.tid = opq(F_.tid); F.lane = F.tid & 63;
    const int k = u & 7, tt = (u >> 3) * 8 + F.wave, lane = F.lane, g = lane >> 4, c15 = lane & 15, r0 = 16 * tt;
    const int sstart = r0 < NCTX ? (r0 & ~255) : NCTX + ((r0 - NCTX) & ~1023), send = sstart + (r0 < NCTX ? SEQ : DSEQ);
    const float* Z = (const float*)(A.ws + WS_ZF);
    constexpr int WS_ = 68;
    LAS float* xs = (LAS float*)(F.lds + F.wave * 12544); LAS float* au = xs + 1088;
    LAS float* Wa = (LAS float*)(F.lds + 8 * 12544); LAS float* Wx = Wa + 64 * WS_;
    {   const int ch = 64 * k + lane; const float* cw = A.in[I_CONVW] + (size_t)layer * 4 * 512 + ch; const float w0 = cw[0], w1 = cw[512], w2 = cw[1024], w3 = cw[1536], cb = A.in[I_CONVB][layer * 512 + ch];
        float lx[19];
#pragma unroll
        for (int j = 0; j < 19; ++j) { const int row = r0 - 2 + j; lx[j] = (row >= sstart && row < send) ? Z[(size_t)row * ZFW + ZLX + ch] : 0.f; }
#pragma unroll
        for (int j = 0; j < 16; ++j) xs[j * 65 + lane] = cb + w0 * lx[j] + w1 * lx[j + 1] + w2 * lx[j + 2] + w3 * lx[j + 3]; }
    float* LHL = (float*)(A.ws + WS_LHL); float* LPP = (float*)(A.ws + WS_LPP);
    for (int dir = 0; dir < 2; ++dir) {
        if (dir) __syncthreads();
        {   const float* wsa = A.in[I_LWA] + (size_t)((layer * 2 + dir) * 8 + k) * 4096; const float* wsx = A.in[I_LWX] + (size_t)((layer * 2 + dir) * 8 + k) * 4096;
#pragma unroll
            for (int j = 0; j < 2; ++j) { const int r4 = F.tid + 512 * j;
                *(LAS f32x4*)(Wa + (r4 >> 4) * WS_ + 4 * (r4 & 15)) = *(const f32x4*)(wsa + 4 * r4); *(LAS f32x4*)(Wx + (r4 >> 4) * WS_ + 4 * (r4 & 15)) = *(const f32x4*)(wsx + 4 * r4); } }
        __syncthreads();
        f32x4 aa[4], ax[4];
#pragma unroll
        for (int jt = 0; jt < 4; ++jt) { aa[jt] = (f32x4){0.f, 0.f, 0.f, 0.f}; ax[jt] = aa[jt]; }
#pragma unroll 4
        for (int ks = 0; ks < 16; ++ks) { const float a = xs[c15 * 65 + 4 * ks + g];
#pragma unroll
            for (int jt = 0; jt < 4; ++jt) { const int wi = (4 * ks + g) * WS_ + 16 * jt + c15;
                aa[jt] = __builtin_amdgcn_mfma_f32_16x16x4f32(a, Wa[wi], aa[jt], 0, 0, 0); ax[jt] = __builtin_amdgcn_mfma_f32_16x16x4f32(a, Wx[wi], ax[jt], 0, 0, 0); } }
        const int pb = (layer * 2 + dir) * 512 + 64 * k;
#pragma unroll
        for (int jt = 0; jt < 4; ++jt) { const int chl = 16 * jt + c15; const float ba = A.in[I_LBA][pb + chl], bx = A.in[I_LBX][pb + chl], sp = log1pf(__expf(-A.in[I_LAM][pb + chl]));
#pragma unroll
            for (int r = 0; r < 4; ++r) { const int j = 4 * g + r; const float rg = sigmoid_f(aa[jt][r] + ba), ig = sigmoid_f(ax[jt][r] + bx);
                const float la = -8.0f * rg * sp, av = __expf(la), mult = __builtin_amdgcn_sqrtf(neg_expm1(2.0f * la)), uv = mult * ig * xs[j * 65 + chl];
                au[(j * 64 + chl) * 2] = av; au[(j * 64 + chl) * 2 + 1] = uv; } }
        LDS_WAIT(); asm volatile("" ::: "memory");
        float hh = 0.f, P = 1.f;
#pragma unroll
        for (int jj = 0; jj < 16; ++jj) { const int j = dir ? 15 - jj : jj; const float av = au[(j * 64 + lane) * 2], uv = au[(j * 64 + lane) * 2 + 1];
            hh = av * hh + uv; P *= av; const size_t o = ((size_t)(r0 + j) * 2 + dir) * 512 + 64 * k + lane; LHL[o] = hh; LPP[o] = P; }
        LDS_WAIT(); asm volatile("" ::: "memory");
    }
}
__device__ __forceinline__ float gelu_tanh(float x) { const float t = 0.7978845608028654f * (x + 0.044715f * x * x * x); return 0.5f * x * (1.0f + tanhf(t)); }
__device__ __forceinline__ void lru_final_unit(const Frame& F_, const Args& A, int tt, int layer) {
    Frame F = F_; F.tid = opq(F_.tid); F.lane = F.tid & 63;
    const int ch = F.tid, r0 = 16 * tt;
    const int s = r0 < NCTX ? r0 >> 8 : 16 + ((r0 - NCTX) >> 10), f0 = (r0 < NCTX ? (r0 & ~255) : NCTX + ((r0 - NCTX) & ~1023)) >> 4, nt = r0 < NCTX ? 16 : 64;
    const float* LHL = (const float*)(A.ws + WS_LHL); const float* LPP = (const float*)(A.ws + WS_LPP); const float* Z = (const float*)(A.ws + WS_ZF);
    float cf = 0.f, cb = 0.f;
    if (s >= 16) { const float* h0 = A.in[I_SLRU] + (size_t)((s - 16) * 2 + layer) * 1024; cf = h0[ch]; cb = h0[512 + ch]; }
    {   int j = f0;
        for (; j + 8 <= tt; j += 8) { float hv[8], pv[8];
#pragma unroll
            for (int q = 0; q < 8; ++q) { const size_t o = ((size_t)(16 * (j + q) + 15) * 2 + 0) * 512 + ch; hv[q] = LHL[o]; pv[q] = LPP[o]; }
#pragma unroll
            for (int q = 0; q < 8; ++q) cf = hv[q] + pv[q] * cf; }
        for (; j < tt; ++j) { const size_t o = ((size_t)(16 * j + 15) * 2 + 0) * 512 + ch; cf = LHL[o] + LPP[o] * cf; } }
    {   int j = f0 + nt - 1;
        for (; j - 8 >= tt; j -= 8) { float hv[8], pv[8];
#pragma unroll
            for (int q = 0; q < 8; ++q) { const size_t o = ((size_t)(16 * (j - q)) * 2 + 1) * 512 + ch; hv[q] = LHL[o]; pv[q] = LPP[o]; }
#pragma unroll
            for (int q = 0; q < 8; ++q) cb = hv[q] + pv[q] * cb; }
        for (; j > tt; --j) { const size_t o = ((size_t)(16 * j) * 2 + 1) * 512 + ch; cb = LHL[o] + LPP[o] * cb; } }
    bf16* OC = (bf16*)(A.ws + WS_OC);
#pragma unroll 4
    for (int i = 0; i < 16; ++i) { const size_t row = (size_t)(r0 + i), o0 = (row * 2) * 512 + ch, o1 = o0 + 512;
        const float hf = LHL[o0] + LPP[o0] * cf, hb = LHL[o1] + LPP[o1] * cb, y = (hf + hb) * gelu_tanh(Z[row * ZFW + ZLG + ch]);
        OC[row * 512 + ch] = (bf16)f2bf(y);
        if (s < 16) { if (i == 15 && tt == f0 + nt - 1) A.out[OUT_SL + (size_t)((s * 2 + layer) * 2 + 0) * 512 + ch] = hf;
                      if (i == 0 && tt == f0) A.out[OUT_SL + (size_t)((s * 2 + layer) * 2 + 1) * 512 + ch] = hb; } }
}

#ifndef DUP_P0C
#define DUP_P0C 0
#endif
#ifndef DUP_P0M
#define DUP_P0M 0
#endif
#ifndef DUP_H1
#define DUP_H1 0
#endif
#ifndef DUP_UP1
#define DUP_UP1 0
#endif
#ifndef DUP_NA
#define DUP_NA 0
#endif
#ifndef DUP_CA
#define DUP_CA 0
#endif
#ifndef DUP_L1
#define DUP_L1 0
#endif
#ifndef DUP_H3
#define DUP_H3 0
#endif
#ifndef DUP_L2
#define DUP_L2 0
#endif
#ifndef DUP_NORM
#define DUP_NORM 0
#endif
#ifndef PROBE_NOCACHE
#define PROBE_NOCACHE 0
#endif
#ifndef PROBE_MEMSET
#define PROBE_MEMSET 0
#endif
#ifndef MK_N_LAUNCHES
#define MK_N_LAUNCHES 1
#endif
constexpr int N_PHASES = 3 + 12 * DEPTH;
__global__ void __launch_bounds__(NTHREADS, 2) trunk_fwd(Args A) {
    extern __shared__ __attribute__((aligned(16))) unsigned char lds_raw[];
    Frame F; F.lds = (LAS unsigned char*)lds_raw; F.tid = threadIdx.x; F.lane = F.tid & 63; F.wave = __builtin_amdgcn_readfirstlane(F.tid >> 6);
    F.G = gridDim.x; F.gw = blockIdx.x * NWAVES + F.wave; F.NGW = F.G * NWAVES;
    volatile LAS unsigned* MISC = (volatile LAS unsigned*)(F.lds + LDSCTL_OFF);
    for (int u = F.tid; u < (LDS_BYTES - LDSCTL_OFF) / 4; u += NTHREADS) MISC[u] = 0u;
    __syncthreads();
    gu32* ctl = (gu32*)(A.ws + WS_CTL);
    XcdBarrier bar; bar.bar = (unsigned*)(ctl + CW_BAR); bar.x = 0; bar.st = nullptr;
    if (MK_N_LAUNCHES == 1) bar = xcd_barrier_post((unsigned*)(ctl + CW_BAR), MISC + 8);
    const int lo = A.ph_lo, hi = A.ph_hi;
#define IN(k) (lo <= (k) && (k) < hi)
#define SEAM(k) do { if (IN(k) && IN((k) + 1)) { XcdBarrier b2_ = bar; asm volatile("" : "+s"(b2_.bar)); xcd_barrier(b2_); } } while (0)
    gu32* cvq = ctl + CW_Q + 30 * 64;
#define CV_END(l_, j_, gemm_) do { if (IN(3 + 12 * (l_) + (j_))) cv_until(F, A, cvq, cv_need((l_), (j_)), (gemm_) ? ctl + CW_Q + (32 + 12 * (l_) + (j_)) * 64 : (gu32*)nullptr, MISC + 20); } while (0)
    unsigned char* ws = A.ws;
    float* X = (float*)(ws + WS_X); bf16* H = (bf16*)(ws + WS_H); bf16* HID = (bf16*)(ws + WS_HID);
    float* MODS = (float*)(ws + WS_MODS);
    LAS unsigned char* ring = F.lds;

#ifndef NO_P0
    if (IN(0)) { p0_convert(F, A); p0_mods_partial(F, A);
#if !PROBE_NOCACHE
        p0_cache(F, A);
#endif
    }
#if DUP_P0C
    if (IN(0)) { __syncthreads(); p0_convert(F, A); }
#endif
#if DUP_P0M
    if (IN(0)) { __syncthreads(); p0_mods_partial(F, A); }
#endif
    #endif
        SEAM(0);
#ifndef NO_P1
    if (IN(1)) p0_mods_reduce(F, A);
    #endif
        SEAM(1);
#ifndef NO_P2
    if (IN(2)) norm_rows<0>(F, A.in[I_XP], A.in[I_XS], X, A.in[I_NORMG], MODS, 0, H, nullptr);
    #endif
        SEAM(2);

    for (int l = 0; l < DEPTH; ++l) {
        const int pb = 3 + 12 * l;
        unsigned char* wl = ws + WS_W + (size_t)l * W_LAYER;
        const float* mods_l = MODS + (size_t)l * 3 * 9 * DM;
        const float* ng = A.in[I_NORMG] + (size_t)l * 3 * DM;
#ifndef NO_G0
        if (IN(pb + 0)) { pg8::Gemm g{H, (const bf16*)(wl + WO_UP1), MTOK, 2 * DFF, DM}; pg8::StaticOrder S; S.init(MTOK, 2 * DFF, F.G, (int)blockIdx.x);
            pg8::EpiSwiglu E{HID, DFF}; pg8::gemm_phase<pg8::EpiSwiglu, pg8::StaticOrder, true, true>(ring, g, S, E);
#if DUP_UP1
            __syncthreads(); pg8::gemm_phase<pg8::EpiSwiglu, pg8::StaticOrder, true, true>(ring, g, S, E);
#endif
        }
        #endif
        CV_END(l, 0, 1);
        SEAM(pb + 0);
#ifndef NO_G1
        if (IN(pb + 1)) { pg8::Gemm g{HID, (const bf16*)(wl + WO_DN1), MTOK, DM, DFF}; pg8::StaticOrder S; S.init(MTOK, DM, F.G, (int)blockIdx.x);
            pg8::EpiResid E{X, DM, mods_l, 0, 0.5f}; pg8::gemm_phase<pg8::EpiResid, pg8::StaticOrder, true, true>(ring, g, S, E); }
        #endif
        CV_END(l, 1, 1);
        SEAM(pb + 1);
#ifndef NO_N2
        if (IN(pb + 2)) norm_rows<0>(F, X, X + (size_t)NCTX * DM, nullptr, ng + DM, mods_l, 1, H, nullptr);
#if DUP_NORM
        if (IN(pb + 2)) norm_rows<0>(F, X, X + (size_t)NCTX * DM, nullptr, ng + DM, mods_l, 1, H, nullptr);
#endif
        #endif
        CV_END(l, 2, 0);
        SEAM(pb + 2);
#ifndef NO_G3
        if (IN(pb + 3)) { pg8::Gemm g{H, (const bf16*)(wl + WO_IN), MTOK, DIN, DM}; pg8::StaticOrder S; S.init(MTOK, DIN, F.G, (int)blockIdx.x);
            pg8::EpiZ E{(float*)(ws + WS_ZF), (bf16*)(ws + WS_QB), (bf16*)(ws + WS_KB), (bf16*)(ws + WS_VT), (bf16*)(ws + WS_GB), A.out + OUT_K, A.out + OUT_V, l, (float*)(ws + 736 * MiB)}; pg8::gemm_phase<pg8::EpiZ, pg8::StaticOrder, true, true>(ring, g, S, E); }
        #endif
        CV_END(l, 3, 1);
        SEAM(pb + 3);
        if (IN(pb + 4)) {
            gu32* q = ctl + CW_Q + (l * 8) * 64;
            #ifndef NO_H1
            for (int u; (u = next_unit(q + 0 * 64, MISC + 16)) < 768;) hgrn_local_unit(F, A, u, l);
#endif
#if DUP_H1
            for (int u; (u = next_unit(q + 6 * 64, MISC + 16)) < 768;) hgrn_local_unit(F, A, u, l);
#endif
            #ifndef NO_NA
            for (int u; (u = next_unit(q + 1 * 64, MISC + 16)) < 256;) attn_na_unit(F, A, u, l);
#endif
#if DUP_NA
            for (int u; (u = next_unit(q + 6 * 64, MISC + 16)) < 256;) attn_na_unit(F, A, u, l);
#endif
            #ifndef NO_CA
            for (int u; (u = next_unit(q + 2 * 64, MISC + 16)) < 256;) attn_ctx_unit(F, A, u);
#endif
#if DUP_CA
            for (int u; (u = next_unit(q + 6 * 64, MISC + 16)) < 256;) attn_ctx_unit(F, A, u);
#endif
            #ifndef NO_L1
            for (int u; (u = next_unit(q + 3 * 64, MISC + 16)) < 384;) lru_gate_unit(F, A, u, l);
#endif
#if DUP_L1
            for (int u; (u = next_unit(q + 6 * 64, MISC + 16)) < 384;) lru_gate_unit(F, A, u, l);
#endif
        }
        CV_END(l, 4, 0);
        SEAM(pb + 4);
        if (IN(pb + 5)) {
            gu32* q = ctl + CW_Q + (l * 8) * 64;
            #ifndef NO_H3
            for (int u; (u = next_unit(q + 4 * 64, MISC + 16)) < 384;) hgrn_final_unit(F, A, u, l);
#endif
#if DUP_H3
            for (int u; (u = next_unit(q + 7 * 64, MISC + 16)) < 384;) hgrn_final_unit(F, A, u, l);
#endif
            #ifndef NO_L2
            for (int u; (u = next_unit(q + 5 * 64, MISC + 16)) < 384;) lru_final_unit(F, A, u, l);
#endif
#if DUP_L2
            for (int u; (u = next_unit(q + 7 * 64, MISC + 16)) < 384;) lru_final_unit(F, A, u, l);
#endif
        }
        CV_END(l, 5, 0);
        SEAM(pb + 5);
#ifndef NO_G6
        if (IN(pb + 6)) {
            __syncthreads();
            float* MACC = (float*)(ws + WS_MACC); bf16* MB = (bf16*)(ws + WS_MB);
            { pg8::Gemm g{(const bf16*)(ws + WS_OA), (const bf16*)(wl + WO_PA), MTOK, DM, 512}; pg8::StaticOrder S; S.init(MTOK, DM, F.G, (int)blockIdx.x);
              pg8::EpiMerge E{(const bf16*)(ws + WS_GB), MACC, MB, 0}; pg8::gemm_phase<pg8::EpiMerge, pg8::StaticOrder, true, true>(ring, g, S, E); }
            { pg8::Gemm g{(const bf16*)(ws + WS_OB), (const bf16*)(wl + WO_PB), MTOK, DM, 1024}; pg8::StaticOrder S; S.init(MTOK, DM, F.G, (int)blockIdx.x);
              pg8::EpiMerge E{(const bf16*)(ws + WS_GB) + DM, MACC, MB, 1}; pg8::gemm_phase<pg8::EpiMerge, pg8::StaticOrder, true, true>(ring, g, S, E); }
            { pg8::Gemm g{(const bf16*)(ws + WS_OC), (const bf16*)(wl + WO_PC), MTOK, DM, 512}; pg8::StaticOrder S; S.init(MTOK, DM, F.G, (int)blockIdx.x);
              pg8::EpiMerge E{(const bf16*)(ws + WS_GB) + 2 * DM, MACC, MB, 2}; pg8::gemm_phase<pg8::EpiMerge, pg8::StaticOrder, true, true>(ring, g, S, E); }
        }
        #endif
        CV_END(l, 6, 1);
        SEAM(pb + 6);
#ifndef NO_G7
        if (IN(pb + 7)) { pg8::Gemm g{(const bf16*)(ws + WS_MB), (const bf16*)(wl + WO_OUT), MTOK, DM, DM}; pg8::StaticOrder S; S.init(MTOK, DM, F.G, (int)blockIdx.x);
            pg8::EpiResid E{X, DM, mods_l, 1, 1.0f}; pg8::gemm_phase<pg8::EpiResid, pg8::StaticOrder, true, true>(ring, g, S, E); }
        #endif
        CV_END(l, 7, 1);
        SEAM(pb + 7);
#ifndef NO_N8
        if (IN(pb + 8)) norm_rows<0>(F, X, X + (size_t)NCTX * DM, nullptr, ng + 2 * DM, mods_l, 2, H, nullptr);
        #endif
        CV_END(l, 8, 0);
        SEAM(pb + 8);
#ifndef NO_G9
        if (IN(pb + 9)) { pg8::Gemm g{H, (const bf16*)(wl + WO_UP2), MTOK, 2 * DFF, DM}; pg8::StaticOrder S; S.init(MTOK, 2 * DFF, F.G, (int)blockIdx.x);
            pg8::EpiSwiglu E{HID, DFF}; pg8::gemm_phase<pg8::EpiSwiglu, pg8::StaticOrder, true, true>(ring, g, S, E); }
        #endif
        CV_END(l, 9, 1);
        SEAM(pb + 9);
#ifndef NO_G10
        if (IN(pb + 10)) { pg8::Gemm g{HID, (const bf16*)(wl + WO_DN2), MTOK, DM, DFF}; pg8::StaticOrder S; S.init(MTOK, DM, F.G, (int)blockIdx.x);
            pg8::EpiResid E{X, DM, mods_l, 2, 0.5f}; pg8::gemm_phase<pg8::EpiResid, pg8::StaticOrder, true, true>(ring, g, S, E); }
        #endif
        CV_END(l, 10, 1);
        SEAM(pb + 10);
#ifndef NO_N11
        if (IN(pb + 11)) {
            if (l + 1 < DEPTH) norm_rows<0>(F, X, X + (size_t)NCTX * DM, nullptr, ng + 3 * DM, mods_l + 3 * 9 * DM, 0, H, nullptr);
            else norm_rows<1>(F, X, X + (size_t)NCTX * DM, nullptr, A.in[I_FNG], nullptr, 0, nullptr, A.out + OUT_Y);
        }
        #endif
        CV_END(l, 11, 0);
        SEAM(pb + 11);
    }
#undef IN
#undef SEAM
}

extern "C" void kernel_launch(void* const* d_in, const int* in_sizes, int n_in, void* d_out, int out_size, void* d_ws, size_t ws_size, hipStream_t stream) {
    static int grid = 0;
    if (grid == 0) {
        if (n_in != 31 || out_size != 33587200 || ws_size < WS_END) { fprintf(stderr, "kernel_launch: unexpected shapes (n_in %d, out %d, ws %zu); nothing launched\n", n_in, out_size, ws_size); grid = -1; return; }
        int dev = 0, cus = 0, per_cu = 0;
        if (hipGetDevice(&dev) != hipSuccess || hipDeviceGetAttribute(&cus, hipDeviceAttributeMultiprocessorCount, dev) != hipSuccess) { grid = -1; return; }
        if (hipFuncSetAttribute((const void*)trunk_fwd, hipFuncAttributeMaxDynamicSharedMemorySize, LDS_BYTES) != hipSuccess) { fprintf(stderr, "kernel_launch: hipFuncSetAttribute failed\n"); grid = -1; return; }
        if (hipOccupancyMaxActiveBlocksPerMultiprocessor(&per_cu, (const void*)trunk_fwd, NTHREADS, LDS_BYTES) != hipSuccess || per_cu < 1) { fprintf(stderr, "kernel_launch: occupancy query says %d blocks per CU\n", per_cu); (void)hipGetLastError(); grid = -1; return; }
        grid = cus;
    }
    if (grid < 0) return;
    if (hipMemsetAsync((char*)d_ws + WS_CTL, 0, CTL_ZERO_BYTES, stream) != hipSuccess) return;
#if PROBE_MEMSET
    (void)hipMemsetAsync((char*)d_ws + PROBE_MS_LO * MiB, 0, (PROBE_MS_HI - PROBE_MS_LO) * MiB, stream);
#endif
    Args a{};
    for (int i = 0; i < 31; ++i) a.in[i] = (const float*)d_in[i];
    a.out = (float*)d_out; a.ws = (unsigned char*)d_ws;
#if MK_N_LAUNCHES == 1
    a.ph_lo = 0; a.ph_hi = N_PHASES;
    hipLaunchKernelGGL(trunk_fwd, dim3(grid), dim3(NTHREADS), LDS_BYTES, stream, a);
#else
    for (int p = 0; p < N_PHASES; ++p) { a.ph_lo = p; a.ph_hi = p + 1; hipLaunchKernelGGL(trunk_fwd, dim3(grid), dim3(NTHREADS), LDS_BYTES, stream, a); }
#endif
}
```

```cpp
#include <hip/hip_runtime.h>
#include <cstdio>
#include <cstdint>
namespace pg8 {
#define PG8_LAS __attribute__((address_space(3)))
typedef unsigned short bf16_t;
typedef short bf16x8 __attribute__((ext_vector_type(8)));
typedef float f32x4 __attribute__((ext_vector_type(4)));
typedef unsigned u32x4 __attribute__((ext_vector_type(4)));
constexpr int BM = 256, BK = 64, HALF = 128, HTB = HALF * BK * 2  , STAGE_BYTES = 8 * HTB, NXCD = 8, WGM = 8;

__host__ __device__ __forceinline__ int lds_byte(int r, int c) { const int st = (r >> 4) * 2 + (c >> 5), rr = r & 15, cc = c & 31, ob = rr * 64 + cc * 2; return st * 1024 + (ob ^ (((ob >> 9) & 1) << 5)); }
__host__ __device__ __forceinline__ void stage_rc(int b, int& R, int& C) { const int st = b / 1024, sb = b % 1024, swz = sb ^ (((sb >> 9) & 1) << 5); R = (st >> 1) * 16 + swz / 64; C = (st & 1) * 32 + (swz % 64) / 2; }
__host__ __device__ __forceinline__ int perm32(int rho) { const int n = rho >> 4, i = rho & 15; return 8 * (i >> 2) + 4 * n + (i & 3); }

struct Unit { int pm, pn; };
struct Gemm { const bf16_t* A; const bf16_t* Bt; int M, N, K; };

struct StaticOrder {
    int nM, nN, nwg, G, c;
    __host__ __device__ void init(int M, int N, int G_, int c_) { nM = M / BM; nN = N / BM; nwg = nM * nN; G = G_; c = c_; }
    __host__ __device__ bool next(int i, Unit& u) const {
        const long L = (long)i * G + c; if (L >= nwg) return false;
        int wgid = (int)L; { const int q = nwg / NXCD, r = nwg % NXCD, xcd = wgid % NXCD, off = wgid / NXCD; wgid = (xcd < r ? xcd * (q + 1) : r * (q + 1) + (xcd - r) * q) + off; }
        const int nig = WGM * nN, gid = wgid / nig, fm = gid * WGM, gsz = (nM - fm) < WGM ? (nM - fm) : WGM;
        u.pm = fm + ((wgid % nig) % gsz); u.pn = (wgid % nig) / gsz; return true;
    }
    __device__ __forceinline__ void a_ready(const Unit&) const {}
    __device__ __forceinline__ void done(const Unit&) const {}
};
typedef float f32x2_cv __attribute__((ext_vector_type(2)));
typedef __bf16 bf16x2_cv __attribute__((ext_vector_type(2)));
__device__ __forceinline__ unsigned cvt_pk_bf16(float lo, float hi) { const f32x2_cv v = {lo, hi}; return __builtin_bit_cast(unsigned, __builtin_convertvector(v, bf16x2_cv)); }
typedef float f32x2 __attribute__((ext_vector_type(2)));

typedef unsigned u32x2 __attribute__((ext_vector_type(2)));
#ifndef PROBE_NOGATE
#define PROBE_NOGATE 0
#endif
#ifndef PROBE_GCONST
#define PROBE_GCONST 0
#endif
#ifndef PROBE_GRAW
#define PROBE_GRAW 0
#endif
#ifndef PROBE_QKV32
#define PROBE_QKV32 0
#endif
__device__ __forceinline__ float silu_f(float a) { return a * __builtin_amdgcn_rcpf(1.0f + __expf(-a)); }
__device__ __forceinline__ float sigmoid_f(float a) { return __builtin_amdgcn_rcpf(1.0f + __expf(-a)); }
__device__ __forceinline__ int opq_(int v) { asm volatile("" : "+v"(v)); return v; }

struct EpiSwiglu {
    static constexpr bool PERM = true, AFTER_DRAIN = false;
    bf16_t* O; int ldo;
    __device__ __forceinline__ void operator()(const f32x4 (&acc)[2][2][4][2], const Unit& u, int wr, int wc, int fr_, int fq_) const {
        const int fr = opq_(fr_), fq = opq_(fq_);
        const int row0 = u.pm * BM + wr * 64 + fr, col0 = u.pn * HALF + wc * 32 + 8 * fq;
#pragma unroll
        for (int ai = 0; ai < 2; ++ai)
#pragma unroll
            for (int m = 0; m < 4; ++m) { bf16_t* rowp = O + (size_t)(row0 + ai * HALF + m * 16) * ldo + col0;
                const f32x4 a0 = acc[ai][0][m][0], a1 = acc[ai][0][m][1], u0 = acc[ai][1][m][0], u1 = acc[ai][1][m][1];
                f32x4 v0, v1;
#pragma unroll
                for (int j = 0; j < 4; ++j) { v0[j] = silu_f(a0[j]) * u0[j]; v1[j] = silu_f(a1[j]) * u1[j]; }
                u32x4 w; w.x = cvt_pk_bf16(v0[0], v0[1]); w.y = cvt_pk_bf16(v0[2], v0[3]); w.z = cvt_pk_bf16(v1[0], v1[1]); w.w = cvt_pk_bf16(v1[2], v1[3]);
                *(u32x4*)rowp = w; }
    }
};
struct EpiResid {
    static constexpr bool PERM = false, AFTER_DRAIN = false;
    float* X; int ldx; const float* mods_l; int slot; float coef;
    __device__ __forceinline__ void operator()(const f32x4 (&acc)[2][2][4][2], const Unit& u, int wr, int wc, int fr_, int fq_) const {
        const int fr = opq_(fr_), fq = opq_(fq_);
        const int row0 = u.pm * BM + wr * 64 + fr, col0 = u.pn * BM + wc * 32 + 4 * fq;
        const int cidx = u.pm < 16 ? 0 : 1 + ((u.pm - 16) >> 2);
        const float* g = mods_l + (size_t)(cidx * 9 + 3 * slot + 2) * 2048 + col0;
        f32x4 gv[2][2];
#pragma unroll
        for (int bj = 0; bj < 2; ++bj)
#pragma unroll
            for (int n = 0; n < 2; ++n) gv[bj][n] = *(const f32x4*)(g + bj * HALF + n * 16) * coef;
#pragma unroll
        for (int ai = 0; ai < 2; ++ai)
#pragma unroll
            for (int m = 0; m < 4; ++m) { float* rowp = X + (size_t)(row0 + ai * HALF + m * 16) * ldx + col0;
#pragma unroll
                for (int bj = 0; bj < 2; ++bj)
#pragma unroll
                    for (int n = 0; n < 2; ++n) { f32x4* p = (f32x4*)(rowp + bj * HALF + n * 16); *p = *p + gv[bj][n] * acc[ai][bj][m][n]; } }
    }
};
struct EpiZ {
    static constexpr bool PERM = false, AFTER_DRAIN = false;
    float* ZF; bf16_t* QB; bf16_t* KB; bf16_t* VT; bf16_t* GB; float* outk; float* outv; int layer; float* Q32;
    __device__ __forceinline__ void operator()(const f32x4 (&acc)[2][2][4][2], const Unit& u, int wr, int wc, int fr_, int fq_) const {
        const int fr = opq_(fr_), fq = opq_(fq_);
        const int rl0 = wr * 64 + fr, ct0 = wc * 32 + 4 * fq, pn = u.pn;
#if PROBE_QKV32
        if (pn >= 10 && pn < 22) { float* base = Q32 + (size_t)(u.pm * BM + rl0) * 3072 + (pn - 10) * 256 + ct0;
#pragma unroll
            for (int ai = 0; ai < 2; ++ai)
#pragma unroll
                for (int m = 0; m < 4; ++m) { float* rowp = base + (size_t)(ai * HALF + m * 16) * 3072;
#pragma unroll
                    for (int bj = 0; bj < 2; ++bj)
#pragma unroll
                        for (int n = 0; n < 2; ++n) *(f32x4*)(rowp + bj * HALF + n * 16) = acc[ai][bj][m][n]; } }
#endif
        if (pn < 10 || (pn >= 22 && pn < 26)) {
            float* base = ZF + (size_t)(u.pm * BM + rl0) * 3584 + (pn < 10 ? pn * 256 : 2560 + (pn - 22) * 256) + ct0;
#pragma unroll
            for (int ai = 0; ai < 2; ++ai)
#pragma unroll
                for (int m = 0; m < 4; ++m) { float* rowp = base + (size_t)(ai * HALF + m * 16) * 3584;
#pragma unroll
                    for (int bj = 0; bj < 2; ++bj)
#pragma unroll
                        for (int n = 0; n < 2; ++n) *(f32x4*)(rowp + bj * HALF + n * 16) = acc[ai][bj][m][n]; }
        } else if (pn < 18) {
            bf16_t* dst = (pn < 14 ? QB + (pn - 10) * 256 : KB + (pn - 14) * 256) + (size_t)(u.pm * BM + rl0) * 1024 + ct0;
            float* ko = (pn >= 14 && u.pm < 16) ? outk + ((size_t)(u.pm * 2 + layer) * 256 + rl0) * 1024 + (pn - 14) * 256 + ct0 : nullptr;
#pragma unroll
            for (int ai = 0; ai < 2; ++ai)
#pragma unroll
                for (int m = 0; m < 4; ++m) { const size_t ro = (size_t)(ai * HALF + m * 16) * 1024;
#pragma unroll
                    for (int bj = 0; bj < 2; ++bj)
#pragma unroll
                        for (int n = 0; n < 2; ++n) { const f32x4 v = acc[ai][bj][m][n]; u32x2 w; w.x = cvt_pk_bf16(v[0], v[1]); w.y = cvt_pk_bf16(v[2], v[3]);
                            *(u32x2*)(dst + ro + bj * HALF + n * 16) = w; if (ko) *(f32x4*)(ko + ro + bj * HALF + n * 16) = v; } }
        } else if (pn < 22) {
            const bool ctx = u.pm < 16; const int L = ctx ? 256 : 1024, t0 = (ctx ? 0 : ((u.pm - 16) & 3) * 256) + rl0;
            bf16_t* vb = ctx ? VT + (size_t)u.pm * 8 * 128 * 256 : VT + (size_t)4096 * 1024 + (size_t)((u.pm - 16) >> 2) * 8 * 128 * 1024;
            vb += (size_t)(2 * (pn - 18)) * 128 * L + (size_t)ct0 * L + t0;
            float* vo = ctx ? outv + ((size_t)(u.pm * 2 + layer) * 256 + rl0) * 1024 + (pn - 18) * 256 + ct0 : nullptr;
#pragma unroll
            for (int ai = 0; ai < 2; ++ai)
#pragma unroll
                for (int m = 0; m < 4; ++m) { const int tr = ai * HALF + m * 16;
#pragma unroll
                    for (int bj = 0; bj < 2; ++bj)
#pragma unroll
                        for (int n = 0; n < 2; ++n) { const f32x4 v = acc[ai][bj][m][n]; bf16_t* p = vb + (size_t)(bj * 128 + n * 16) * L + tr;
                            const unsigned w0 = cvt_pk_bf16(v[0], v[1]), w1 = cvt_pk_bf16(v[2], v[3]);
                            p[0] = (bf16_t)(w0 & 0xffffu); p[L] = (bf16_t)(w0 >> 16); p[2 * L] = (bf16_t)(w1 & 0xffffu); p[3 * L] = (bf16_t)(w1 >> 16);
                            if (vo) *(f32x4*)(vo + (size_t)tr * 1024 + bj * HALF + n * 16) = v; } }
        } else {
            bf16_t* dst = GB + (size_t)(u.pm * BM + rl0) * 6144 + (pn - 26) * 256 + ct0;
#pragma unroll
            for (int ai = 0; ai < 2; ++ai)
#pragma unroll
                for (int m = 0; m < 4; ++m) { const size_t ro = (size_t)(ai * HALF + m * 16) * 6144;
#pragma unroll
                    for (int bj = 0; bj < 2; ++bj)
#pragma unroll
                        for (int n = 0; n < 2; ++n) { const f32x4 v = acc[ai][bj][m][n]; u32x2 w; w.x = cvt_pk_bf16(sigmoid_f(v[0]), sigmoid_f(v[1])); w.y = cvt_pk_bf16(sigmoid_f(v[2]), sigmoid_f(v[3]));
#if PROBE_GCONST
                            w.x = 0x3f003f00u; w.y = 0x3f003f00u;
#endif
#if PROBE_GRAW
                            w.x = cvt_pk_bf16(v[0] * 0.01f, v[1] * 0.01f); w.y = cvt_pk_bf16(v[2] * 0.01f, v[3] * 0.01f);
#endif
                            *(u32x2*)(dst + ro + bj * HALF + n * 16) = w; } }
        }
    }
};
struct EpiMerge {
    static constexpr bool PERM = false, AFTER_DRAIN = false;
    const bf16_t* Gg; float* MACC; bf16_t* MB; int mode;
    __device__ __forceinline__ void operator()(const f32x4 (&acc)[2][2][4][2], const Unit& u, int wr, int wc, int fr_, int fq_) const {
        const int fr = opq_(fr_), fq = opq_(fq_);
        const int row0 = u.pm * BM + wr * 64 + fr, col0 = u.pn * BM + wc * 32 + 4 * fq;
#pragma unroll
        for (int ai = 0; ai < 2; ++ai)
#pragma unroll
            for (int m = 0; m < 4; ++m) { const size_t row = (size_t)(row0 + ai * HALF + m * 16);
#pragma unroll
                for (int bj = 0; bj < 2; ++bj)
#pragma unroll
                    for (int n = 0; n < 2; ++n) { const int c = col0 + bj * HALF + n * 16;
#if PROBE_NOGATE
                        const u32x2 gw = {0x3f003f00u, 0x3f003f00u}; f32x4 v = acc[ai][bj][m][n];
#else
                        const u32x2 gw = *(const u32x2*)(Gg + row * 6144 + c); f32x4 v = acc[ai][bj][m][n];
#endif
                        v[0] *= __uint_as_float(gw.x << 16); v[1] *= __uint_as_float(gw.x & 0xffff0000u); v[2] *= __uint_as_float(gw.y << 16); v[3] *= __uint_as_float(gw.y & 0xffff0000u);
                        f32x4* mp = (f32x4*)(MACC + row * 2048 + c);
                        if (mode == 0) *mp = v;
                        else if (mode == 1) *mp = *mp + v;
                        else { v = *mp + v; u32x2 w; w.x = cvt_pk_bf16(v[0], v[1]); w.y = cvt_pk_bf16(v[2], v[3]); *(u32x2*)(MB + row * 2048 + c) = w; } } }
    }
};
template <class Epi, class Sched, bool ALIGN_EPI = false, bool SP2 = false>
__device__ __forceinline__ void gemm_phase(PG8_LAS unsigned char* lds, const Gemm g, const Sched& S, const Epi& E) {
    int tid_ = threadIdx.x; asm volatile("" : "+v"(tid_));
    const int tid = tid_, wid = __builtin_amdgcn_readfirstlane(tid >> 6), lane = tid & 63, wr = wid >> 2, wc = wid & 3, fr = lane & 15, fq = lane >> 4;
    const int K = g.K, nt = K / BK;
    unsigned voffA[2], voffB[2];
#pragma unroll
    for (int i = 0; i < 2; ++i) { int R, C; stage_rc(tid * 16 + i * 8192, R, C); const int Rb = Epi::PERM ? ((R & ~31) + perm32(R & 31)) : R;
        voffA[i] = (unsigned)(R * K + C) * 2u; voffB[i] = (unsigned)(Rb * K + C) * 2u; }
    const size_t kstep = (size_t)(BK * 2);
    const size_t hstep = (size_t)HALF * K * 2;
    const size_t tstep = 2 * hstep;
    const unsigned ldsw = (unsigned)wid * 1024u;
    const int aoff = lds_byte(wr * 64 + fr, fq * 8), boff = lds_byte(wc * 32 + fr, fq * 8);
#define PG8_SA(b, h) (((b) * 2 + (h)) * HTB)
#define PG8_SB(b, h) ((4 + (b) * 2 + (h)) * HTB)
#define PG8_STAGE(bufoff, gbase, voff) do { _Pragma("unroll") for (int _i = 0; _i < 2; ++_i) \
        __builtin_amdgcn_global_load_lds((const unsigned*)((const char*)(gbase) + (voff)[_i]), (PG8_LAS unsigned*)(lds + (bufoff) + ldsw + _i * 8192), 16, 0, 0); } while (0)
#define PG8_LDA(dst, b, h) do { _Pragma("unroll") for (int m = 0; m < 4; ++m) _Pragma("unroll") for (int k = 0; k < 2; ++k) dst[m][k] = *(const PG8_LAS bf16x8*)(lds + PG8_SA(b, h) + aoff + m * 2048 + k * 1024); } while (0)
#define PG8_LDB(dst, b, h) do { _Pragma("unroll") for (int n = 0; n < 2; ++n) _Pragma("unroll") for (int k = 0; k < 2; ++k) dst[n][k] = *(const PG8_LAS bf16x8*)(lds + PG8_SB(b, h) + boff + n * 2048 + k * 1024); } while (0)
#define PG8_MMA(ai, bj, At, Bt) do { __builtin_amdgcn_s_setprio(1); _Pragma("unroll") for (int m = 0; m < 4; ++m) _Pragma("unroll") for (int n = 0; n < 2; ++n) _Pragma("unroll") for (int k = 0; k < 2; ++k) \
        acc[ai][bj][m][n] = __builtin_amdgcn_mfma_f32_16x16x32_bf16(Bt[n][k], At[m][k], acc[ai][bj][m][n], 0, 0, 0); __builtin_amdgcn_s_setprio(0); } while (0)
#define PG8_WAIT_V(n) asm volatile("s_waitcnt vmcnt(" #n ")" ::: "memory")
#define PG8_WAIT_L(n) asm volatile("s_waitcnt lgkmcnt(" #n ")" ::: "memory")
#define PG8_BAR __builtin_amdgcn_s_barrier()
#define PG8_SCHED __builtin_amdgcn_sched_barrier(0)
    Unit cur, nxt; int ui = 0;
    if (!S.next(0, cur)) return;
    f32x4 acc[2][2][4][2];
#pragma unroll
    for (int a = 0; a < 2; ++a)
#pragma unroll
        for (int b = 0; b < 2; ++b)
#pragma unroll
            for (int m = 0; m < 4; ++m)
#pragma unroll
                for (int n = 0; n < 2; ++n) acc[a][b][m][n] = (f32x4){0.f, 0.f, 0.f, 0.f};
    bf16x8 At[4][2], B0[2][2], B1[2][2];
    const char* cA = (const char*)g.A + (size_t)cur.pm * tstep; const char* cB = (const char*)g.Bt + (size_t)cur.pn * tstep;
    S.a_ready(cur);
    if constexpr (SP2) {
        PG8_STAGE(PG8_SB(0, 0), cB, voffB); PG8_STAGE(PG8_SB(0, 1), cB + hstep, voffB); PG8_STAGE(PG8_SA(0, 0), cA, voffA); PG8_STAGE(PG8_SA(0, 1), cA + hstep, voffA);
        if (wr == 1) PG8_BAR;
        PG8_WAIT_V(2); PG8_BAR;
        PG8_STAGE(PG8_SB(1, 0), cB + kstep, voffB); PG8_STAGE(PG8_SA(1, 0), cA + kstep, voffA); PG8_STAGE(PG8_SB(1, 1), cB + hstep + kstep, voffB);
        PG8_WAIT_V(6); PG8_BAR;
    } else {
        PG8_STAGE(PG8_SB(0, 0), cB, voffB); PG8_STAGE(PG8_SA(0, 0), cA, voffA); PG8_STAGE(PG8_SB(0, 1), cB + hstep, voffB); PG8_STAGE(PG8_SA(0, 1), cA + hstep, voffA);
        if (wr == 1) PG8_BAR;
        PG8_WAIT_V(4); PG8_BAR;
        PG8_STAGE(PG8_SB(1, 0), cB + kstep, voffB); PG8_STAGE(PG8_SA(1, 0), cA + kstep, voffA); PG8_STAGE(PG8_SB(1, 1), cB + hstep + kstep, voffB);
        PG8_WAIT_V(6); PG8_BAR;
    }
    for (;;) {
        const bool has_next = S.next(ui + 1, nxt);
        const char* nA = has_next ? (const char*)g.A + (size_t)nxt.pm * tstep : cA; const char* nB = has_next ? (const char*)g.Bt + (size_t)nxt.pn * tstep : cB;
        for (int t = 0; t < nt; t += 2) {
            const bool last = (t == nt - 2);
            const char* a1 = cA + (size_t)(t + 1) * kstep;
            const char* a2 = last ? nA : cA + (size_t)(t + 2) * kstep; const char* b2 = last ? nB : cB + (size_t)(t + 2) * kstep;
            const char* a3 = a2 + kstep; const char* b3 = b2 + kstep;
            if (last && has_next) S.a_ready(nxt);
            if constexpr (SP2) {
            PG8_LDB(B0, 0, 0); PG8_LDB(B1, 0, 1); PG8_SCHED; PG8_LDA(At, 0, 0); PG8_STAGE(PG8_SA(1, 1), a1 + hstep, voffA);
            PG8_WAIT_V(8); PG8_WAIT_L(0); PG8_BAR; PG8_MMA(0, 0, At, B0); PG8_MMA(0, 1, At, B1); PG8_BAR; PG8_SCHED;
            PG8_LDA(At, 0, 1); PG8_STAGE(PG8_SB(0, 0), b2, voffB); PG8_STAGE(PG8_SB(0, 1), b2 + hstep, voffB); PG8_STAGE(PG8_SA(0, 0), a2, voffA);
            PG8_WAIT_V(8); PG8_WAIT_L(0); PG8_BAR; PG8_MMA(1, 0, At, B0); PG8_MMA(1, 1, At, B1); PG8_BAR; PG8_SCHED;
            PG8_LDB(B0, 1, 0); PG8_LDB(B1, 1, 1); PG8_SCHED; PG8_LDA(At, 1, 0); PG8_STAGE(PG8_SA(0, 1), a2 + hstep, voffA);
            PG8_WAIT_V(8); PG8_WAIT_L(0); PG8_BAR; PG8_MMA(0, 0, At, B0); PG8_MMA(0, 1, At, B1); PG8_BAR; PG8_SCHED;
            PG8_LDA(At, 1, 1); PG8_STAGE(PG8_SB(1, 0), b3, voffB); PG8_STAGE(PG8_SB(1, 1), b3 + hstep, voffB); PG8_STAGE(PG8_SA(1, 0), a3, voffA);
            PG8_WAIT_V(8); PG8_WAIT_L(0); PG8_BAR; PG8_MMA(1, 0, At, B0); PG8_MMA(1, 1, At, B1); PG8_BAR; PG8_SCHED;
            } else {
            PG8_LDB(B0, 0, 0); PG8_SCHED; PG8_LDA(At, 0, 0); PG8_STAGE(PG8_SA(1, 1), a1 + hstep, voffA);
            PG8_WAIT_L(8); PG8_BAR; PG8_WAIT_L(0); PG8_MMA(0, 0, At, B0); PG8_BAR; PG8_SCHED;
            PG8_LDB(B1, 0, 1); PG8_STAGE(PG8_SB(0, 0), b2, voffB);
            PG8_BAR; PG8_WAIT_L(0); PG8_MMA(0, 1, At, B1); PG8_BAR;
            PG8_LDA(At, 0, 1); PG8_STAGE(PG8_SA(0, 0), a2, voffA);
            PG8_BAR; PG8_WAIT_L(0); PG8_MMA(1, 0, At, B0); PG8_BAR; PG8_SCHED;
            PG8_STAGE(PG8_SB(0, 1), b2 + hstep, voffB);
            PG8_WAIT_V(6); PG8_BAR; PG8_MMA(1, 1, At, B1); PG8_BAR;
            PG8_LDB(B0, 1, 0); PG8_SCHED; PG8_LDA(At, 1, 0); PG8_STAGE(PG8_SA(0, 1), a2 + hstep, voffA);
            PG8_WAIT_L(8); PG8_BAR; PG8_WAIT_L(0); PG8_MMA(0, 0, At, B0); PG8_BAR; PG8_SCHED;
            PG8_LDB(B1, 1, 1); PG8_STAGE(PG8_SB(1, 0), b3, voffB);
            PG8_BAR; PG8_WAIT_L(0); PG8_MMA(0, 1, At, B1); PG8_BAR;
            PG8_LDA(At, 1, 1); PG8_STAGE(PG8_SA(1, 0), a3, voffA);
            PG8_BAR; PG8_WAIT_L(0); PG8_MMA(1, 0, At, B0); PG8_BAR; PG8_SCHED;
            PG8_STAGE(PG8_SB(1, 1), b3 + hstep, voffB);
            PG8_WAIT_V(6); PG8_BAR; PG8_MMA(1, 1, At, B1); PG8_BAR;
            }
        }
        if constexpr (ALIGN_EPI) { if (wr == 0) PG8_BAR; }
        if constexpr (!Epi::AFTER_DRAIN) { E(acc, cur, wr, wc, fr, fq); S.done(cur); }
        if (!has_next) break;
#pragma unroll
        for (int a = 0; a < 2; ++a)
#pragma unroll
            for (int b = 0; b < 2; ++b)
#pragma unroll
                for (int m = 0; m < 4; ++m)
#pragma unroll
                    for (int n = 0; n < 2; ++n) acc[a][b][m][n] = (f32x4){0.f, 0.f, 0.f, 0.f};
        cur = nxt; cA = nA; cB = nB; ++ui;
        if constexpr (ALIGN_EPI) { if (wr == 1) PG8_BAR; }
    }
    PG8_WAIT_V(0);
    if constexpr (!ALIGN_EPI) { if (wr == 0) PG8_BAR; }
    PG8_BAR;
    if constexpr (Epi::AFTER_DRAIN) { E.fused(acc, cur, wr, wc, fr, fq, lds, wid, lane); S.done(cur); }
#undef PG8_SA
#undef PG8_SB
#undef PG8_STAGE
#undef PG8_LDA
#undef PG8_LDB
#undef PG8_MMA
#undef PG8_WAIT_V
#undef PG8_WAIT_L
#undef PG8_BAR
#undef PG8_SCHED
}
}

constexpr int DM = 2048, DFF = 5632, DIN = 12800, NCTX = 4096, NLAT = 2048, MTOK = 6144, DEPTH = 2;
constexpr int SEQ = 256, DSEQ = 1024, NSEQ = 18;
constexpr int ZQ = 0, ZFF = 512, ZFB = 1024, ZI = 1536, ZO = 2048, ZLX = 2560, ZLG = 3072, ZFW = 3584;
constexpr int NWAVES = 8, NTHREADS = 512;
constexpr size_t MiB = 1u << 20;
constexpr size_t WS_CTL = 0, CTL_ZERO_BYTES = 1 * MiB;
constexpr size_t WS_W = 2 * MiB, W_LAYER = 198 * MiB;
constexpr size_t WO_UP1 = 0, WO_DN1 = 44 * MiB, WO_UP2 = 66 * MiB, WO_DN2 = 110 * MiB, WO_IN = 132 * MiB, WO_PA = 182 * MiB, WO_PB = 184 * MiB, WO_PC = 188 * MiB, WO_OUT = 190 * MiB;
constexpr size_t WS_X = 398 * MiB;
constexpr size_t WS_H = 446 * MiB;
constexpr size_t WS_HID = 470 * MiB;
constexpr size_t WS_ZF = 536 * MiB;
constexpr size_t WS_QB = 620 * MiB;
constexpr size_t WS_KB = 632 * MiB;
constexpr size_t WS_VT = 644 * MiB;
constexpr size_t WS_GB = 656 * MiB;
constexpr size_t WS_CKB = 728 * MiB;
constexpr size_t WS_CVT = 732 * MiB;
constexpr size_t WS_OA = 836 * MiB, WS_OB = 842 * MiB, WS_OC = 854 * MiB;
constexpr size_t WS_MACC = 860 * MiB;
constexpr size_t WS_MB = 908 * MiB;
constexpr size_t WS_MODP = 932 * MiB;
constexpr size_t WS_MODS = 946 * MiB;
constexpr size_t WS_HOL = 947 * MiB;
constexpr size_t WS_HQD = 971 * MiB;
constexpr size_t WS_HSL = 995 * MiB;
constexpr size_t WS_HDEC = 1043 * MiB;
constexpr size_t WS_LHL = 1044 * MiB;
constexpr size_t WS_LPP = 1068 * MiB;
constexpr size_t WS_END = 1092 * MiB;
constexpr int CW_BAR = 4096;
constexpr int CW_Q = 16384;
constexpr int RING_BYTES = 131072, LDSCTL_OFF = 143360, LDS_BYTES = 147456;

#define GAS __attribute__((address_space(1)))
#define LAS __attribute__((address_space(3)))
typedef unsigned short bf16;
typedef unsigned v4u __attribute__((ext_vector_type(4)));
typedef unsigned v2u __attribute__((ext_vector_type(2)));
typedef float f32x4 __attribute__((ext_vector_type(4)));
typedef short bf16x8 __attribute__((ext_vector_type(8)));
typedef GAS unsigned gu32;
#define RLX_AGENT __ATOMIC_RELAXED, __HIP_MEMORY_SCOPE_AGENT
#define LDS_WAIT() asm volatile("s_waitcnt lgkmcnt(0)" ::: "memory")
#define VM_WAIT() asm volatile("s_waitcnt vmcnt(0)" ::: "memory")
__device__ __forceinline__ unsigned f2bf(float f) { unsigned u = __builtin_bit_cast(unsigned, f); return (u + 0x7fffu + ((u >> 16) & 1u)) >> 16; }
__device__ __forceinline__ unsigned pk2(float lo, float hi) { return pg8::cvt_pk_bf16(lo, hi); }
__device__ __forceinline__ float wave_sum(float v) {
#pragma unroll
    for (int o = 1; o < 64; o <<= 1) v += __shfl_xor(v, o);
    return v;
}
using pg8::silu_f; using pg8::sigmoid_f;
#define XB_TMO      128
#define XB_XCNT(j)  (256  + 64 * (j))
#define XB_XSUB(j)  (1280 + 64 * (j))
#define XB_XGEN(j)  (2304 + 64 * (j))
#define XB_TOP      3328
#define XB_TOPGEN   3392
#define XCD_BAR_WORDS 3456
#define XB_SPIN_CAP (1u << 18)

__device__ __forceinline__ unsigned xb_ld(unsigned* p)              { return __hip_atomic_load(p, __ATOMIC_RELAXED, __HIP_MEMORY_SCOPE_AGENT); }
__device__ __forceinline__ unsigned xb_add(unsigned* p, unsigned v) { return __hip_atomic_fetch_add(p, v, __ATOMIC_RELAXED, __HIP_MEMORY_SCOPE_AGENT); }
__device__ __forceinline__ unsigned xb_xcc_id() { return (unsigned)__builtin_amdgcn_s_getreg((3 << 11) | 20) & 0xFu; }
#define XB_SPIN(cond, bar) do { unsigned _sp = 0; while (cond) { __builtin_amdgcn_s_sleep(1); \
    if ((++_sp & 255u) == 0u) { if (xb_ld(&(bar)[XB_TMO])) break; if (_sp > XB_SPIN_CAP) { atomicAdd(&(bar)[XB_TMO], 1u); break; } } } } while (0)

struct XcdBarrier {
    unsigned* bar; unsigned x;
    volatile LAS unsigned* st;
};

__device__ __forceinline__ XcdBarrier xcd_barrier_post(unsigned* bar, volatile LAS unsigned* st) {
    XcdBarrier b; b.bar = bar; b.x = xb_xcc_id(); b.st = st;
    if (threadIdx.x == 0) (void)xb_add(&bar[XB_XCNT(b.x)], 1u);
    return b;
}
__device__ __forceinline__ void xcd_barrier_complete(unsigned* bar, unsigned x, unsigned& nloc, unsigned& nx) {
    const unsigned G = gridDim.x * gridDim.y * gridDim.z;
    unsigned sum, cnt, mine, sp = 0u;
    for (;;) {
        sum = 0u; cnt = 0u; mine = 0u;
#pragma unroll
        for (unsigned j = 0; j < 16; ++j) { const unsigned c = xb_ld(&bar[XB_XCNT(j)]); sum += c; cnt += (c > 0u) ? 1u : 0u; mine = (j == x) ? c : mine; }
        if (sum == G) break;
        __builtin_amdgcn_s_sleep(1);
        if ((++sp & 255u) == 0u) { if (xb_ld(&bar[XB_TMO])) break; if (sp > XB_SPIN_CAP) { atomicAdd(&bar[XB_TMO], 1u); break; } }
    }
    nloc = mine > 0u ? mine : 1u; nx = cnt > 0u ? cnt : 1u;
}

__device__ __forceinline__ void xcd_barrier(const XcdBarrier& b) {
    asm volatile("s_waitcnt vmcnt(0)" ::: "memory");
    __syncthreads();
    if (threadIdx.x == 0) {
        unsigned* bar = b.bar;
        __builtin_amdgcn_s_waitcnt(0);
        unsigned nloc = b.st[0], nx = b.st[1];
        if (nloc == 0u) { xcd_barrier_complete(bar, b.x, nloc, nx); b.st[0] = nloc; b.st[1] = nx; }
        const unsigned old = xb_add(&bar[XB_XSUB(b.x)], 1u);
        const unsigned gen = old / nloc;
        if (old + 1u == (gen + 1u) * nloc) {
            __builtin_amdgcn_fence(__ATOMIC_RELEASE, "agent");
            asm volatile("s_waitcnt vmcnt(0)" ::: "memory");
            const unsigned og = xb_add(&bar[XB_TOP], 1u);
            const unsigned tg = og / nx;
            if (og + 1u == (tg + 1u) * nx) xb_add(&bar[XB_TOPGEN], 1u);
            else XB_SPIN(xb_ld(&bar[XB_TOPGEN]) == tg, bar);
            __builtin_amdgcn_fence(__ATOMIC_ACQUIRE, "agent");
            xb_add(&bar[XB_XGEN(b.x)], 1u);
            asm volatile("s_waitcnt vmcnt(0)" ::: "memory");
        } else {
            XB_SPIN(xb_ld(&bar[XB_XGEN(b.x)]) == gen, bar);
            __builtin_amdgcn_fence(__ATOMIC_ACQUIRE, "agent");
            asm volatile("s_waitcnt vmcnt(0)" ::: "memory");
        }
    }
    __syncthreads();
}

struct Args { const float* in[31]; float* out; unsigned char* ws; int ph_lo, ph_hi; };
enum { I_XP = 0, I_XS, I_CK, I_CV, I_SHG, I_SLRU, I_C, I_CCTX, I_MODW, I_MODB, I_NORMG, I_F1UP, I_F1DN, I_F2UP, I_F2DN, I_WIN, I_LBL, I_HGN, I_RPB, I_CONVW, I_CONVB,
       I_LWA, I_LBA, I_LWX, I_LBX, I_LAM, I_PA, I_PB, I_PC, I_WOUT, I_FNG };
constexpr size_t OUT_Y = 0, OUT_K = 12582912, OUT_V = 20971520, OUT_SH = 29360128, OUT_SL = 33554432;

#ifndef PROBE_ZERO_YS
#define PROBE_ZERO_YS 0
#endif
#ifndef PROBE_ZERO_YP
#define PROBE_ZERO_YP 0
#endif
#ifndef CV_BACKGROUND
#define CV_BACKGROUND 0
#endif
struct Frame { LAS unsigned char* lds; int tid, lane, wave, G, gw, NGW; };
__device__ __forceinline__ int opq(int v) { asm volatile("" : "+v"(v)); return v; }

__device__ __forceinline__ int next_unit(gu32* head, volatile LAS unsigned* slot) {
    __syncthreads();
    if (threadIdx.x == 0) *slot = __hip_atomic_fetch_add(head, 1u, RLX_AGENT);
    __syncthreads();
    return (int)*slot;
}

__device__ __forceinline__ void cv_load(const float* W, int N, int k0, int n0, int lane, float (&v)[32]) {
#pragma unroll
    for (int i = 0; i < 32; ++i) v[i] = __builtin_nontemporal_load(W + (size_t)(k0 + 2 * i + (lane >> 5)) * N + n0 + (lane & 31));
}
__device__ __forceinline__ void cv_store(const float (&v)[32], int K, bf16* WT, int dst_row0, LAS float* scr, int k0, int lane) {
#pragma unroll
    for (int i = 0; i < 32; ++i) scr[(2 * i + (lane >> 5)) * 33 + (lane & 31)] = v[i];
    LDS_WAIT(); asm volatile("" ::: "memory");
    const int c = lane & 7;
#pragma unroll
    for (int j = 0; j < 4; ++j) { const int n = (lane >> 3) + 8 * j; const LAS float* s = scr + (8 * c) * 33 + n;
        v4u o; o.x = pk2(s[0 * 33], s[1 * 33]); o.y = pk2(s[2 * 33], s[3 * 33]); o.z = pk2(s[4 * 33], s[5 * 33]); o.w = pk2(s[6 * 33], s[7 * 33]);
        *(v4u*)(WT + (size_t)(dst_row0 + n) * K + k0 + 8 * c) = o; }
    LDS_WAIT(); asm volatile("" ::: "memory");
}
constexpr int CV_UP = 32 * 352, CV_DN = 88 * 64, CV_IN = 32 * 400, CV_A = 8 * 64, CV_B = 16 * 64, CV_O = 32 * 64, CV_PER_LAYER = 2 * CV_UP + 2 * CV_DN + CV_IN + 2 * CV_A + CV_B + CV_O;
constexpr int CV_CLAIM = 16, CV_CPL = CV_PER_LAYER / CV_CLAIM, CV_NCLAIM = DEPTH * CV_CPL, CV_STATIC = CV_UP / CV_CLAIM;
static_assert(CV_PER_LAYER % CV_CLAIM == 0 && CV_UP % CV_CLAIM == 0, "claims");
__device__ __forceinline__ int cv_need(int l, int j) {
    constexpr int T_DN1 = (CV_UP + CV_DN) / CV_CLAIM, T_IN = T_DN1 + CV_IN / CV_CLAIM, T_MRG = T_IN + (2 * CV_A + CV_B) / CV_CLAIM, T_OUT = T_MRG + CV_O / CV_CLAIM, T_UP2 = T_OUT + CV_UP / CV_CLAIM, T_DN2 = T_UP2 + CV_DN / CV_CLAIM;
    const int r = j == 0 ? T_DN1 : j <= 2 ? T_IN : j <= 5 ? T_MRG : j == 6 ? T_OUT : j <= 8 ? T_UP2 : j == 9 ? T_DN2 : T_DN2 + CV_STATIC;
    const int n = l * CV_CPL + r; return n < CV_NCLAIM ? n : CV_NCLAIM;
}
struct CvItem { const float* W; bf16* WT; int K, N, k0, n0, drow; };
__device__ __forceinline__ CvItem cv_decode(const Args& A, int it) {
    const int l = it / CV_PER_LAYER; int r = it % CV_PER_LAYER;
    unsigned char* wl = A.ws + WS_W + (size_t)l * W_LAYER;
    const float* W; int K, N; bf16* WT; int up = 0;
    if (r < CV_UP) { W = A.in[I_F1UP] + (size_t)l * DM * 2 * DFF; K = DM; N = 2 * DFF; WT = (bf16*)(wl + WO_UP1); up = 1; }
    else if ((r -= CV_UP) < CV_DN) { W = A.in[I_F1DN] + (size_t)l * DFF * DM; K = DFF; N = DM; WT = (bf16*)(wl + WO_DN1); }
    else if ((r -= CV_DN) < CV_IN) { W = A.in[I_WIN] + (size_t)l * DM * DIN; K = DM; N = DIN; WT = (bf16*)(wl + WO_IN); }
    else if ((r -= CV_IN) < CV_A) { W = A.in[I_PA] + (size_t)l * 512 * DM; K = 512; N = DM; WT = (bf16*)(wl + WO_PA); }
    else if ((r -= CV_A) < CV_B) { W = A.in[I_PB] + (size_t)l * 1024 * DM; K = 1024; N = DM; WT = (bf16*)(wl + WO_PB); }
    else if ((r -= CV_B) < CV_A) { W = A.in[I_PC] + (size_t)l * 512 * DM; K = 512; N = DM; WT = (bf16*)(wl + WO_PC); }
    else if ((r -= CV_A) < CV_O) { W = A.in[I_WOUT] + (size_t)l * DM * DM; K = DM; N = DM; WT = (bf16*)(wl + WO_OUT); }
    else if ((r -= CV_O) < CV_UP) { W = A.in[I_F2UP] + (size_t)l * DM * 2 * DFF; K = DM; N = 2 * DFF; WT = (bf16*)(wl + WO_UP2); up = 1; }
    else { r -= CV_UP; W = A.in[I_F2DN] + (size_t)l * DFF * DM; K = DFF; N = DM; WT = (bf16*)(wl + WO_DN2); }
    const int nblk = N / 32, kb = r / nblk, nb = r % nblk, n0 = 32 * nb;
    int drow = n0;
    if (up) { const int j0 = n0 < DFF ? n0 : n0 - DFF; drow = 256 * (j0 >> 7) + (j0 & 127) + (n0 < DFF ? 0 : 128); }
    CvItem c; c.W = W; c.WT = WT; c.K = K; c.N = N; c.k0 = 64 * kb; c.n0 = n0; c.drow = drow; return c;
}
__device__ __forceinline__ void p0_convert(const Frame& F_, const Args& A) {
    Frame F = F_; F.tid = opq(F_.tid); F.lane = F.tid & 63;
    LAS float* scr = (LAS float*)(F.lds + F.wave * 16384);
    for (int it = F.gw; it < (CV_BACKGROUND ? CV_UP : DEPTH * CV_PER_LAYER); it += F.NGW) { const CvItem c = cv_decode(A, it); float v[32]; cv_load(c.W, c.N, c.k0, c.n0, F.lane, v); cv_store(v, c.K, c.WT, c.drow, scr, c.k0, F.lane); }
}
__device__ __forceinline__ void cv_until(const Frame& F_, const Args& A, gu32* head, int need, gu32* fin, volatile LAS unsigned* slot) {
    Frame F = F_; F.tid = opq(F_.tid); F.lane = F.tid & 63;
    LAS float* scr = (LAS float*)(F.lds + F.wave * 16384);
    if (fin) { __syncthreads(); if (F.tid == 0) __hip_atomic_fetch_add(fin, 1u, RLX_AGENT); }
    for (;;) {
        __syncthreads();
        if (F.tid == 0) { const unsigned f = fin ? __hip_atomic_load(fin, RLX_AGENT) : 0xffffffffu, h = CV_STATIC + __hip_atomic_load(head, RLX_AGENT);
            slot[1] = f; slot[0] = (h >= (unsigned)need && f >= (unsigned)F.G) ? 0x7fffffffu : CV_STATIC + __hip_atomic_fetch_add(head, 1u, RLX_AGENT); }
        __syncthreads();
        const int c = (int)slot[0]; const bool others_done = slot[1] >= (unsigned)F.G;
        if (c >= CV_NCLAIM) break;
        { const CvItem c0 = cv_decode(A, c * CV_CLAIM + 2 * F.wave), c1 = cv_decode(A, c * CV_CLAIM + 2 * F.wave + 1); float v0[32], v1[32];
          cv_load(c0.W, c0.N, c0.k0, c0.n0, F.lane, v0); cv_load(c1.W, c1.N, c1.k0, c1.n0, F.lane, v1);
          cv_store(v0, c0.K, c0.WT, c0.drow, scr, c0.k0, F.lane); cv_store(v1, c1.K, c1.WT, c1.drow, scr, c1.k0, F.lane); }
        if (c >= need && others_done) break;
    }
}
__device__ __forceinline__ void p0_cache(const Frame& F_, const Args& A) {
    Frame F = F_; F.tid = opq(F_.tid); F.lane = F.tid & 63;
    const int gt = blockIdx.x * NTHREADS + F.tid, NT = F.G * NTHREADS;
    bf16* CKB = (bf16*)(A.ws + WS_CKB); bf16* CVT = (bf16*)(A.ws + WS_CVT);
    for (int i = gt; i < 2 * 2 * 512 * 1024 / 8; i += NT) { const float* p = A.in[I_CK] + (size_t)i * 8; const f32x4 a = *(const f32x4*)p, b = *(const f32x4*)(p + 4);
        v4u o; o.x = pk2(a.x, a.y); o.y = pk2(a.z, a.w); o.z = pk2(b.x, b.y); o.w = pk2(b.z, b.w); *(v4u*)(CKB + (size_t)i * 8) = o; }
    for (int i = gt; i < 2 * 2 * 64 * 1024; i += NT) {
        const int hd = i & 1023, jb = (i >> 10) & 63, bl = i >> 16; const float* p = A.in[I_CV] + ((size_t)(bl * 512 + jb * 8)) * 1024 + hd;
        v4u o; o.x = pk2(p[0], p[1024]); o.y = pk2(p[2048], p[3072]); o.z = pk2(p[4096], p[5120]); o.w = pk2(p[6144], p[7168]);
        *(v4u*)(CVT + ((size_t)(bl * 8 + (hd >> 7)) * 128 + (hd & 127)) * 512 + jb * 8) = o; }
}
__device__ __forceinline__ void p0_mods_partial(const Frame& F_, const Args& A) {
    Frame F = F_; F.tid = opq(F_.tid); F.lane = F.tid & 63;
    float* MODP = (float*)(A.ws + WS_MODP);
    const float* cc = A.in[I_CCTX]; const float* c1 = A.in[I_C];
    for (int task = F.gw; task < 2 * 32 * 72; task += F.NGW) {
        const int l = task / 2304, r = task % 2304, kc = r / 72, nb = r % 72, n = nb * 256 + F.lane * 4;
        const float* w = A.in[I_MODW] + ((size_t)l * DM + kc * 64) * 18432 + n;
        f32x4 a0 = {0.f, 0.f, 0.f, 0.f}, a1 = a0, a2 = a0;
#pragma unroll 4
        for (int k = 0; k < 64; ++k) { const f32x4 wv = *(const f32x4*)(w + (size_t)k * 18432); const int kk = kc * 64 + k;
            const float s0 = silu_f(cc[kk]), s1 = silu_f(c1[kk]), s2 = silu_f(c1[DM + kk]);
            a0 += wv * s0; a1 += wv * s1; a2 += wv * s2; }
        float* o = MODP + (size_t)kc * 110592 + (size_t)l * 55296 + n;
        *(f32x4*)(o) = a0; *(f32x4*)(o + 18432) = a1; *(f32x4*)(o + 2 * 18432) = a2;
    }
}
__device__ __forceinline__ void p0_mods_reduce(const Frame& F_, const Args& A) {
    Frame F = F_; F.tid = opq(F_.tid); F.lane = F.tid & 63;
    const float* MODP = (const float*)(A.ws + WS_MODP); float* MODS = (float*)(A.ws + WS_MODS);
    for (int idx = blockIdx.x * NTHREADS + F.tid; idx < 110592; idx += F.G * NTHREADS) {
        const int l = idx / 55296, n = idx % 18432; float s = A.in[I_MODB][l * 18432 + n];
#pragma unroll 8
        for (int kc = 0; kc < 32; ++kc) s += MODP[(size_t)kc * 110592 + idx];
        MODS[idx] = s;
    }
}
template <int MODE>
__device__ __forceinline__ void norm_rows(const Frame& F_, const float* x0, const float* x1, float* xcopy, const float* g, const float* mods_l, int slot, bf16* H, float* outf) {
    Frame F = F_; F.tid = opq(F_.tid); F.lane = F.tid & 63;
    for (int row = F.gw; row < MTOK; row += F.NGW) {
        const float* xr = row < NCTX ? x0 + (size_t)row * DM : x1 + (size_t)(row - NCTX) * DM;
        const int cidx = row < NCTX ? 0 : 1 + ((row - NCTX) >> 10);
        f32x4 v[8]; float ss = 0.f;
#pragma unroll
        for (int j = 0; j < 8; ++j) { v[j] = *(const f32x4*)(xr + 4 * F.lane + 256 * j); ss += (v[j].x * v[j].x + v[j].y * v[j].y) + (v[j].z * v[j].z + v[j].w * v[j].w); }
        const float rstd = 1.0f / sqrtf(wave_sum(ss) * (1.0f / DM) + 1e-6f);
        if (MODE == 0) {
            const float* sh = mods_l + (size_t)(cidx * 9 + 3 * slot) * DM; const float* sc = sh + DM;
#pragma unroll
            for (int j = 0; j < 8; ++j) { const int c = 4 * F.lane + 256 * j; const f32x4 gg = *(const f32x4*)(g + c), s1 = *(const f32x4*)(sc + c), s0 = *(const f32x4*)(sh + c);
                const f32x4 y = v[j] * rstd * gg * (s1 + 1.0f) + s0; v2u o; o.x = pk2(y.x, y.y); o.y = pk2(y.z, y.w);
                *(v2u*)(H + (size_t)row * DM + c) = o;
                if (xcopy) *(f32x4*)(xcopy + (size_t)row * DM + c) = v[j]; }
        } else {
#pragma unroll
            for (int j = 0; j < 8; ++j) { const int c = 4 * F.lane + 256 * j; const f32x4 gg = *(const f32x4*)(g + c);
                f32x4 yv = v[j] * rstd * gg;
#if PROBE_ZERO_YS
                if (row >= NCTX) yv = (f32x4){0.f, 0.f, 0.f, 0.f};
#endif
#if PROBE_ZERO_YP
                if (row < NCTX) yv = (f32x4){0.f, 0.f, 0.f, 0.f};
#endif
                *(f32x4*)(outf + (size_t)row * DM + c) = yv; }
        }
    }
}

constexpr int AK_STRIDE = 272, AV_STRIDE = 528, A_K_OFF = 0, A_V_OFF = 69632;
constexpr float NA_SCALE = 0.08838834764831845f;
__device__ __forceinline__ void attn_stage(LAS unsigned char* lds, int tid, const bf16* kbase, size_t kstride, const bf16* vbase, size_t vstride) {
    v4u kx[8], vx[8];
#pragma unroll
    for (int i = 0; i < 8; ++i) { const int idx = tid + 512 * i; kx[i] = *(const v4u*)(kbase + (size_t)(idx >> 4) * kstride + (idx & 15) * 8); }
#pragma unroll
    for (int i = 0; i < 8; ++i) { const int idx = tid + 512 * i; vx[i] = *(const v4u*)(vbase + (size_t)(idx >> 5) * vstride + (idx & 31) * 8); }
#pragma unroll
    for (int i = 0; i < 8; ++i) { const int idx = tid + 512 * i; *(LAS v4u*)(lds + A_K_OFF + (idx >> 4) * AK_STRIDE + (idx & 15) * 16) = kx[i]; }
#pragma unroll
    for (int i = 0; i < 8; ++i) { const int idx = tid + 512 * i; *(LAS v4u*)(lds + A_V_OFF + (idx >> 5) * AV_STRIDE + (idx & 31) * 16) = vx[i]; }
}
template <class KF, class VF>
__device__ __forceinline__ void attn_stage32(LAS unsigned char* lds, int tid, KF kf, VF vf) {
    { const int key = tid >> 1, half = tid & 1; const float* p = kf(key) + 64 * half; LAS unsigned char* dst = lds + A_K_OFF + key * AK_STRIDE + half * 128;
#pragma unroll
      for (int i = 0; i < 8; ++i) { const f32x4 a = *(const f32x4*)(p + 8 * i), b = *(const f32x4*)(p + 8 * i + 4);
          v4u o; o.x = pk2(a.x, a.y); o.y = pk2(a.z, a.w); o.z = pk2(b.x, b.y); o.w = pk2(b.z, b.w); *(LAS v4u*)(dst + 16 * i) = o; } }
    { const int kp = tid >> 2, dq = tid & 3; const float* p0 = vf(2 * kp) + 32 * dq; const float* p1 = vf(2 * kp + 1) + 32 * dq;
#pragma unroll
      for (int i = 0; i < 8; ++i) { const f32x4 a = *(const f32x4*)(p0 + 4 * i), b = *(const f32x4*)(p1 + 4 * i);
#pragma unroll
          for (int j = 0; j < 4; ++j) *(LAS unsigned*)(lds + A_V_OFF + (32 * dq + 4 * i + j) * AV_STRIDE + kp * 4) = pk2(a[j], b[j]); } }
}
__device__ __forceinline__ void attn_load_q32(const float* qrow, int g, bf16x8 (&qf)[4]) {
#pragma unroll
    for (int s = 0; s < 4; ++s) { const f32x4 a = *(const f32x4*)(qrow + 32 * s + 8 * g), b = *(const f32x4*)(qrow + 32 * s + 8 * g + 4);
        v4u o; o.x = pk2(a.x, a.y); o.y = pk2(a.z, a.w); o.z = pk2(b.x, b.y); o.w = pk2(b.z, b.w); qf[s] = __builtin_bit_cast(bf16x8, o); }
}
struct AttnState { float m, l; f32x4 ot[8]; };
template <int NKS, bool LOCAL, class BF>
__device__ __forceinline__ void attn_chunk(LAS unsigned char* lds, const bf16x8 (&qf)[4], AttnState& st, int lane, int t0, BF bias) {
    const int g = lane >> 4, c = lane & 15;
    f32x4 sc[NKS][2];
#pragma unroll
    for (int i = 0; i < NKS; ++i) { const int T0 = LOCAL ? 4 * i + t0 : 2 * i;
#pragma unroll
        for (int a = 0; a < 2; ++a) { f32x4 acc = {0.f, 0.f, 0.f, 0.f};
#pragma unroll
            for (int s = 0; s < 4; ++s) { const bf16x8 kfr = *(const LAS bf16x8*)(lds + A_K_OFF + (16 * (T0 + a) + c) * AK_STRIDE + 64 * s + 16 * g);
                acc = __builtin_amdgcn_mfma_f32_16x16x32_bf16(kfr, qf[s], acc, 0, 0, 0); }
            sc[i][a] = acc; } }
    float mx = -3.0e38f;
#pragma unroll
    for (int i = 0; i < NKS; ++i) { const int T0 = LOCAL ? 4 * i + t0 : 2 * i;
#pragma unroll
        for (int a = 0; a < 2; ++a)
#pragma unroll
            for (int r = 0; r < 4; ++r) { float s = sc[i][a][r] * NA_SCALE; if (LOCAL) s = bias(16 * (T0 + a) + 4 * g + r, s); sc[i][a][r] = s; mx = fmaxf(mx, s); } }
    mx = fmaxf(mx, __shfl_xor(mx, 16)); mx = fmaxf(mx, __shfl_xor(mx, 32));
    const float mnew = fmaxf(st.m, mx), alpha = __expf(st.m - mnew); float sum = 0.f;
#pragma unroll
    for (int i = 0; i < NKS; ++i)
#pragma unroll
        for (int a = 0; a < 2; ++a)
#pragma unroll
            for (int r = 0; r < 4; ++r) { const float p = __expf(sc[i][a][r] - mnew); sc[i][a][r] = p; sum += p; }
    sum += __shfl_xor(sum, 16); sum += __shfl_xor(sum, 32);
    st.l = st.l * alpha + sum; st.m = mnew;
#pragma unroll
    for (int dt = 0; dt < 8; ++dt) st.ot[dt] = st.ot[dt] * alpha;
#pragma unroll
    for (int i = 0; i < NKS; ++i) { const int T0 = LOCAL ? 4 * i + t0 : 2 * i;
        v4u pb; pb.x = pk2(sc[i][0][0], sc[i][0][1]); pb.y = pk2(sc[i][0][2], sc[i][0][3]); pb.z = pk2(sc[i][1][0], sc[i][1][1]); pb.w = pk2(sc[i][1][2], sc[i][1][3]);
        const bf16x8 pfr = __builtin_bit_cast(bf16x8, pb);
#pragma unroll
        for (int dt = 0; dt < 8; ++dt) { const LAS unsigned char* vp = lds + A_V_OFF + (16 * dt + c) * AV_STRIDE + (16 * T0 + 4 * g) * 2;
            const v2u lo = *(const LAS v2u*)vp, hi = *(const LAS v2u*)(vp + 32); v4u av; av.x = lo.x; av.y = lo.y; av.z = hi.x; av.w = hi.y;
            st.ot[dt] = __builtin_amdgcn_mfma_f32_16x16x32_bf16(__builtin_bit_cast(bf16x8, av), pfr, st.ot[dt], 0, 0, 0); } }
}
__device__ __forceinline__ void attn_load_q(const bf16* qrow, int g, bf16x8 (&qf)[4]) {
#pragma unroll
    for (int s = 0; s < 4; ++s) qf[s] = *(const bf16x8*)(qrow + 32 * s + 8 * g);
}
__device__ __forceinline__ void attn_store(const AttnState& st, bf16* orow, int g) {
    const float inv = 1.0f / st.l;
#pragma unroll
    for (int dt = 0; dt < 8; ++dt) { v2u o; o.x = pk2(st.ot[dt][0] * inv, st.ot[dt][1] * inv); o.y = pk2(st.ot[dt][2] * inv, st.ot[dt][3] * inv); *(v2u*)(orow + 16 * dt + 4 * g) = o; }
}
__device__ __forceinline__ void attn_ctx_unit(const Frame& F_, const Args& A, int u) {
    Frame F = F_; F.tid = opq(F_.tid); F.lane = F.tid & 63;
    const int b = u >> 4, h = (u >> 1) & 7, qh = u & 1, g = F.lane >> 4, c = F.lane & 15;
    const bf16* QB = (const bf16*)(A.ws + WS_QB); const bf16* KB = (const bf16*)(A.ws + WS_KB); const bf16* VT = (const bf16*)(A.ws + WS_VT);
    const int row = b * SEQ + qh * 128 + 16 * F.wave + c;
    bf16x8 qf[4];
#if PROBE_QKV32
    { const float* Z3 = (const float*)(A.ws + 736 * MiB); const float* zb = Z3 + (size_t)(b * SEQ) * 3072 + h * 128;
      attn_stage32(F.lds, F.tid, [&](int k) { return zb + (size_t)k * 3072 + 1024; }, [&](int k) { return zb + (size_t)k * 3072 + 2048; });
      attn_load_q32(Z3 + (size_t)row * 3072 + h * 128, g, qf); }
#else
    attn_stage(F.lds, F.tid, KB + (size_t)(b * SEQ) * 1024 + h * 128, 1024, VT + (size_t)(b * 8 + h) * 128 * 256, 256);
    attn_load_q(QB + (size_t)row * 1024 + h * 128, g, qf);
#endif
    AttnState st; st.m = -3.0e38f; st.l = 0.f;
#pragma unroll
    for (int dt = 0; dt < 8; ++dt) st.ot[dt] = (f32x4){0.f, 0.f, 0.f, 0.f};
    __syncthreads();
    attn_chunk<8, false>(F.lds, qf, st, F.lane, 0, [](int, float s) { return s; });
    attn_store(st, (bf16*)(A.ws + WS_OB) + (size_t)row * 1024 + h * 128, g);
}
__device__ __forceinline__ void attn_na_unit(const Frame& F_, const Args& A, int u, int layer) {
    Frame F = F_; F.tid = opq(F_.tid); F.lane = F.tid & 63;
    const int b = u >> 7, h = (u >> 4) & 7, r = u & 15, g = F.lane >> 4, c = F.lane & 15, w = F.wave;
    const bf16* QB = (const bf16*)(A.ws + WS_QB); const bf16* KB = (const bf16*)(A.ws + WS_KB); const bf16* VT = (const bf16*)(A.ws + WS_VT);
    const int kr0 = min(max(r - 4, 0), 8);
    const int qc = 8 * w + (c & 7), row = NCTX + b * DSEQ + r * 64 + qc;
    const int wstart = min(max(qc - 8, 0), 48), t0 = min(max(8 * w - 8, 0), 40) >> 4;
    const float* rpb = A.in[I_RPB] + (size_t)(layer * 8 + h) * 15 * 31;
    bf16x8 qf[4];
#if PROBE_QKV32
    attn_load_q32((const float*)(A.ws + 736 * MiB) + (size_t)row * 3072 + h * 128, g, qf);
#else
    attn_load_q(QB + (size_t)row * 1024 + h * 128, g, qf);
#endif
    AttnState st; st.m = -3.0e38f; st.l = 0.f;
#pragma unroll
    for (int dt = 0; dt < 8; ++dt) st.ot[dt] = (f32x4){0.f, 0.f, 0.f, 0.f};
#if PROBE_QKV32
    const float* Z3 = (const float*)(A.ws + 736 * MiB); const float* zl = Z3 + (size_t)(NCTX + b * DSEQ) * 3072 + h * 128;
    for (int ci = 0; ci < 2; ++ci) {
        const int krow = kr0 + 4 * ci;
        if (ci) __syncthreads();
        attn_stage32(F.lds, F.tid, [&](int k) { return zl + (size_t)(krow * 64 + k) * 3072 + 1024; }, [&](int k) { return zl + (size_t)(krow * 64 + k) * 3072 + 2048; });
        __syncthreads();
        attn_chunk<4, true>(F.lds, qf, st, F.lane, t0, [&](int kk, float s) {
            const int ky = krow + (kk >> 6), kx = kk & 63; const bool ok = kx >= wstart && kx < wstart + 16;
            const int dy = ky - r + 7, dx = min(max(kx - qc + 15, 0), 30);
            return ok ? s + rpb[dy * 31 + dx] : -1.0e30f; });
    }
    const float* ck = A.in[I_CK] + ((size_t)(b * 2 + layer) * 512 * 8 + h) * 128; const float* cv = A.in[I_CV] + ((size_t)(b * 2 + layer) * 512 * 8 + h) * 128;
    for (int ci = 0; ci < 2; ++ci) {
        __syncthreads();
        attn_stage32(F.lds, F.tid, [&](int k) { return ck + (size_t)(ci * 256 + k) * 1024; }, [&](int k) { return cv + (size_t)(ci * 256 + k) * 1024; });
        __syncthreads();
        attn_chunk<8, false>(F.lds, qf, st, F.lane, 0, [](int, float s) { return s; });
    }
#else
    const bf16* kl = KB + (size_t)(NCTX + b * DSEQ) * 1024 + h * 128; const bf16* vl = VT + (size_t)4096 * 1024 + (size_t)(b * 8 + h) * 128 * 1024;
    for (int ci = 0; ci < 2; ++ci) {
        const int krow = kr0 + 4 * ci;
        if (ci) __syncthreads();
        attn_stage(F.lds, F.tid, kl + (size_t)(krow * 64) * 1024, 1024, vl + krow * 64, 1024);
        __syncthreads();
        attn_chunk<4, true>(F.lds, qf, st, F.lane, t0, [&](int kk, float s) {
            const int ky = krow + (kk >> 6), kx = kk & 63; const bool ok = kx >= wstart && kx < wstart + 16;
            const int dy = ky - r + 7, dx = min(max(kx - qc + 15, 0), 30);
            return ok ? s + rpb[dy * 31 + dx] : -1.0e30f; });
    }
    const bf16* ck = (const bf16*)(A.ws + WS_CKB) + (size_t)(b * 2 + layer) * 512 * 1024 + h * 128; const bf16* cv = (const bf16*)(A.ws + WS_CVT) + (size_t)((b * 2 + layer) * 8 + h) * 128 * 512;
    for (int ci = 0; ci < 2; ++ci) {
        __syncthreads();
        attn_stage(F.lds, F.tid, ck + (size_t)(ci * 256) * 1024, 1024, cv + ci * 256, 512);
        __syncthreads();
        attn_chunk<8, false>(F.lds, qf, st, F.lane, 0, [](int, float s) { return s; });
    }
#endif
    if (c < 8) attn_store(st, (bf16*)(A.ws + WS_OB) + (size_t)row * 1024 + h * 128, g);
}

__device__ __forceinline__ int hg_slot(int s, int h, int dir, int c) { return s < 16 ? s * 32 + c * 8 + h * 2 + dir : 512 + (s - 16) * 128 + c * 8 + h * 2 + dir; }
template <int CTRL> __device__ __forceinline__ float dpp_xor(float v) { return __builtin_bit_cast(float, __builtin_amdgcn_update_dpp(0, __builtin_bit_cast(int, v), CTRL, 0xf, 0xf, true)); }
__device__ __forceinline__ void hgrn_local_unit(const Frame& F_, const Args& A, int u, int layer) {
    Frame F = F_; F.tid = opq(F_.tid); F.lane = F.tid & 63;
    int s, c, hd;
    if (u < 512) { s = u >> 5; c = (u >> 3) & 3; hd = u & 7; } else { const int v = u - 512; s = 16 + (v >> 7); c = (v >> 3) & 15; hd = v & 7; }
    const int h = hd >> 1, dir = hd & 1, tokbase = s < 16 ? s * SEQ : NCTX + (s - 16) * DSEQ, g = F.lane >> 4, c15 = F.lane & 15, w = F.wave;
    const float* Z = (const float*)(A.ws + WS_ZF);
    constexpr int LS = 132, AS = 68;
    LAS float* Qt = (LAS float*)F.lds; LAS float* Kt = Qt + 64 * LS; LAS float* Vs = Kt + 64 * LS; LAS float* Bs = Vs + 64 * LS; LAS float* SC = Bs + 64 * LS; LAS float* As = Bs;
    const int d = F.tid & 127;
    {   float lbv = 0.f;
        if (layer == 1) { const float* lg = A.in[I_LBL]; lbv = sigmoid_f(lg[1024 + dir * 512 + h * 128 + d] - lg[dir * 512 + h * 128 + d]); }
        for (int i = F.tid >> 7; i < 64; i += 4) { const int t = dir ? 64 * c + 63 - i : 64 * c + i; const float* zr = Z + (size_t)(tokbase + t) * ZFW + h * 128 + d;
            const float zq = zr[ZQ], zf = zr[dir ? ZFB : ZFF], zv = zr[ZI], f = lbv + (1.f - lbv) * sigmoid_f(zf);
            Qt[i * LS + d] = silu_f(zq); Kt[i * LS + d] = (1.f - lbv) * sigmoid_f(-zf); Vs[i * LS + d] = zv; Bs[i * LS + d] = __logf(fmaxf(f, 1e-30f)); }
    }
    __syncthreads();
    if (F.tid < 128) { float b = 0.f;
#pragma unroll 8
        for (int i = 0; i < 64; ++i) { b += Bs[i * LS + d]; Bs[i * LS + d] = b; } }
    __syncthreads();
    {   float* QD = (float*)(A.ws + WS_HQD);
        for (int i = F.tid >> 7; i < 64; i += 4) { const int I = i >> 4, t = dir ? 64 * c + 63 - i : 64 * c + i;
            const float bi = Bs[i * LS + d], bs = I ? Bs[(16 * I - 1) * LS + d] : 0.f, be = Bs[(16 * I + 15) * LS + d], q = Qt[i * LS + d], k = Kt[i * LS + d];
            QD[((size_t)(tokbase + t) * 2 + dir) * 512 + h * 128 + d] = q * __expf(bi);
            Qt[i * LS + d] = q * __expf(bi - bs); Kt[i * LS + d] = k * __expf(be - bi); }
        for (int idx = F.tid; idx < 14 * 128; idx += NTHREADS) { const int v = idx >> 7, dd = idx & 127; int I, J;
            if (v < 6) { I = v < 1 ? 1 : (v < 3 ? 2 : 3); J = v < 1 ? 0 : (v < 3 ? v - 1 : v - 3); } else if (v < 10) { I = v - 6; J = I; } else { I = 4; J = v - 10; }
            const float bsI = I ? Bs[(16 * I - 1) * LS + dd] : 0.f, beJ = Bs[(16 * J + 15) * LS + dd];
            SC[idx] = __expf(bsI - beJ);
            if (v == 13) ((float*)(A.ws + WS_HDEC))[(size_t)u * 128 + dd] = __expf(bsI); }
    }
    __syncthreads();
    {
        float av[16];
#pragma unroll
        for (int ks = 0; ks < 16; ++ks) { const int j = 4 * ks + g; av[ks] = Kt[j * LS + 16 * w + c15] * SC[(10 + (j >> 4)) * 128 + 16 * w + c15]; }
        float* SL = (float*)(A.ws + WS_HSL) + (size_t)u * 16384;
        for (int et = 0; et < 8; ++et) { f32x4 acc = {0.f, 0.f, 0.f, 0.f};
#pragma unroll
            for (int ks = 0; ks < 16; ++ks) acc = __builtin_amdgcn_mfma_f32_16x16x4f32(av[ks], Vs[(4 * ks + g) * LS + 16 * et + c15], acc, 0, 0, 0);
#pragma unroll
            for (int r = 0; r < 4; ++r) SL[(16 * w + 4 * g + r) * 128 + 16 * et + c15] = acc[r]; }
    }
    for (int tl = w; tl < 10; tl += 8) {
        int I, J, sv;
        if (tl < 4) { I = tl; J = tl; sv = 6 + tl; } else { const int v = tl - 4; I = v < 1 ? 1 : (v < 3 ? 2 : 3); J = v < 1 ? 0 : (v < 3 ? v - 1 : v - 3); sv = v; }
        f32x4 acc = {0.f, 0.f, 0.f, 0.f};
#pragma unroll 8
        for (int ks = 0; ks < 32; ++ks) { const int dd = 4 * ks + g;
            acc = __builtin_amdgcn_mfma_f32_16x16x4f32(Qt[(16 * I + c15) * LS + dd] * SC[sv * 128 + dd], Kt[(16 * J + c15) * LS + dd], acc, 0, 0, 0); }
#pragma unroll
        for (int r = 0; r < 4; ++r) As[(16 * I + 4 * g + r) * AS + 16 * J + c15] = (I == J && c15 > 4 * g + r) ? 0.f : acc[r];
    }
    __syncthreads();
    {   float* OL = (float*)(A.ws + WS_HOL);
#pragma unroll
        for (int I = 0; I < 4; ++I) { f32x4 acc = {0.f, 0.f, 0.f, 0.f};
            for (int ks = 0; ks < 4 * (I + 1); ++ks) acc = __builtin_amdgcn_mfma_f32_16x16x4f32(As[(16 * I + c15) * AS + 4 * ks + g], Vs[(4 * ks + g) * LS + 16 * w + c15], acc, 0, 0, 0);
#pragma unroll
            for (int r = 0; r < 4; ++r) { const int i = 16 * I + 4 * g + r, t = dir ? 64 * c + 63 - i : 64 * c + i; OL[((size_t)(tokbase + t) * 2 + dir) * 512 + h * 128 + 16 * w + c15] = acc[r]; } }
    }
}
__device__ __forceinline__ void hgrn_final_unit(const Frame& F_, const Args& A, int u, int layer) {
    Frame F = F_; F.tid = opq(F_.tid); F.lane = F.tid & 63;
    int s, c, h, nC;
    if (u < 128) { s = 16 + (u >> 6); c = (u >> 2) & 15; h = u & 3; nC = 16; } else { const int v = u - 128; s = v >> 4; c = (v >> 2) & 3; h = v & 3; nC = 4; }
    const int tokbase = s < 16 ? s * SEQ : NCTX + (s - 16) * DSEQ, g = F.lane >> 4, c15 = F.lane & 15, w = F.wave;
    constexpr int LS = 132;
    LAS float* Ss = (LAS float*)F.lds; LAS float* Qd = Ss + 128 * LS; LAS float* Os = Qd + 64 * LS;
    const float* HSL = (const float*)(A.ws + WS_HSL); const float* HDEC = (const float*)(A.ws + WS_HDEC); const float* QD = (const float*)(A.ws + WS_HQD);
    f32x4 acc[4];
#pragma unroll
    for (int tt = 0; tt < 4; ++tt) acc[tt] = (f32x4){0.f, 0.f, 0.f, 0.f};
    for (int dir = 0; dir < 2; ++dir) {
        f32x4 S[8];
        if (s >= 16) { const float* s0 = A.in[I_SHG] + ((size_t)(((s - 16) * 2 + layer) * 2 + dir) * 4 + h) * 16384;
#pragma unroll
            for (int j = 0; j < 8; ++j) S[j] = *(const f32x4*)(s0 + 4 * (F.tid + 512 * j)); }
        else {
#pragma unroll
            for (int j = 0; j < 8; ++j) S[j] = (f32x4){0.f, 0.f, 0.f, 0.f}; }
        const int nprev = dir ? nC - 1 - c : c;
        if (nprev > 0) {
            f32x4 cur[8]; float dcur[8];
            { const int sl = hg_slot(s, h, dir, dir ? nC - 1 : 0);
#pragma unroll
              for (int j = 0; j < 8; ++j) { const int idx4 = F.tid + 512 * j; dcur[j] = HDEC[(size_t)sl * 128 + (idx4 >> 5)]; cur[j] = *(const f32x4*)(HSL + (size_t)sl * 16384 + 4 * idx4); } }
            for (int q = 0; q < nprev; ++q) {
                f32x4 nxt[8]; float dnx[8];
                const int qn = q + 1 < nprev ? q + 1 : q, sl = hg_slot(s, h, dir, dir ? nC - 1 - qn : qn);
#pragma unroll
                for (int j = 0; j < 8; ++j) { const int idx4 = F.tid + 512 * j; dnx[j] = HDEC[(size_t)sl * 128 + (idx4 >> 5)]; nxt[j] = *(const f32x4*)(HSL + (size_t)sl * 16384 + 4 * idx4); }
#pragma unroll
                for (int j = 0; j < 8; ++j) { S[j] = S[j] * dcur[j] + cur[j]; cur[j] = nxt[j]; dcur[j] = dnx[j]; }
            }
        }
        if (s < 16 && (dir ? c == 0 : c == nC - 1)) {
            const int sl = hg_slot(s, h, dir, c); float* so = A.out + OUT_SH + ((size_t)((s * 2 + layer) * 2 + dir) * 4 + h) * 16384;
#pragma unroll
            for (int j = 0; j < 8; ++j) { const int idx4 = F.tid + 512 * j; const float dc = HDEC[(size_t)sl * 128 + (idx4 >> 5)];
                *(f32x4*)(so + 4 * idx4) = S[j] * dc + *(const f32x4*)(HSL + (size_t)sl * 16384 + 4 * idx4); } }
        if (dir) __syncthreads();
#pragma unroll
        for (int j = 0; j < 8; ++j) { const int idx4 = F.tid + 512 * j; *(LAS f32x4*)(Ss + (idx4 >> 5) * LS + 4 * (idx4 & 31)) = S[j]; }
#pragma unroll
        for (int j = 0; j < 4; ++j) { const int idx4 = F.tid + 512 * j, i = idx4 >> 5;
            *(LAS f32x4*)(Qd + i * LS + 4 * (idx4 & 31)) = *(const f32x4*)(QD + ((size_t)(tokbase + 64 * c + i) * 2 + dir) * 512 + h * 128 + 4 * (idx4 & 31)); }
        __syncthreads();
        for (int ks = 0; ks < 32; ++ks) { const float bv = Ss[(4 * ks + g) * LS + 16 * w + c15];
#pragma unroll
            for (int tt = 0; tt < 4; ++tt) acc[tt] = __builtin_amdgcn_mfma_f32_16x16x4f32(Qd[(16 * tt + c15) * LS + 4 * ks + g], bv, acc[tt], 0, 0, 0); }
    }
    const float* OL = (const float*)(A.ws + WS_HOL);
#pragma unroll
    for (int tt = 0; tt < 4; ++tt)
#pragma unroll
        for (int r = 0; r < 4; ++r) { const int t = 16 * tt + 4 * g + r; const float* ol = OL + (size_t)(tokbase + 64 * c + t) * 1024 + h * 128 + 16 * w + c15;
            Os[t * LS + 16 * w + c15] = acc[tt][r] + ol[0] + ol[512]; }
    __syncthreads();
    {
        const int t = F.tid >> 3, seg = F.tid & 7; const size_t row = (size_t)(tokbase + 64 * c + t);
        f32x4 o[4]; float ss = 0.f;
#pragma unroll
        for (int j = 0; j < 4; ++j) { o[j] = *(const LAS f32x4*)(Os + t * LS + 16 * seg + 4 * j); ss += (o[j].x * o[j].x + o[j].y * o[j].y) + (o[j].z * o[j].z + o[j].w * o[j].w); }
        ss += __shfl_xor(ss, 1); ss += __shfl_xor(ss, 2); ss += __shfl_xor(ss, 4);
        const float rstd = 1.0f / sqrtf(ss * (1.0f / 128.f) + 1e-6f);
        const float* gn = A.in[I_HGN] + (size_t)(layer * 4 + h) * 128 + 16 * seg; const float* zo = (const float*)(A.ws + WS_ZF) + row * ZFW + ZO + h * 128 + 16 * seg;
        unsigned pk[8];
#pragma unroll
        for (int j = 0; j < 4; ++j) { const f32x4 gg = *(const f32x4*)(gn + 4 * j), zz = *(const f32x4*)(zo + 4 * j);
            pk[2 * j] = pk2(o[j].x * rstd * gg.x * silu_f(zz.x), o[j].y * rstd * gg.y * silu_f(zz.y)); pk[2 * j + 1] = pk2(o[j].z * rstd * gg.z * silu_f(zz.z), o[j].w * rstd * gg.w * silu_f(zz.w)); }
        bf16* oa = (bf16*)(A.ws + WS_OA) + row * 512 + h * 128 + 16 * seg;
        *(v4u*)oa = (v4u){pk[0], pk[1], pk[2], pk[3]}; *(v4u*)(oa + 8) = (v4u){pk[4], pk[5], pk[6], pk[7]};
    }
}

__device__ __forceinline__ float neg_expm1(float x) {
    return x > -0.03f ? -x * (1.f + x * (0.5f + x * (0.16666667f + x * 0.041666668f))) : 1.f - __expf(x);
}
__device__ __forceinline__ void lru_gate_unit(const Frame& F_, const Args& A, int u, int layer) {
    Frame F = F_; F.tid = opq(F_.tid); F.lane = F.tid & 63;
    const int k = u & 7, tt = (u >> 3) * 8 + F.wave, lane = F.lane, g = lane >> 4, c15 = lane & 15, r0 = 16 * tt;
    const int sstart = r0 < NCTX ? (r0 & ~255) : NCTX + ((r0 - NCTX) & ~1023), send = sstart + (r0 < NCTX ? SEQ : DSEQ);
    const float* Z = (const float*)(A.ws + WS_ZF);
    constexpr int WS_ = 68;
    LAS float* xs = (LAS float*)(F.lds + F.wave * 12544); LAS float* au = xs + 1088;
    LAS float* Wa = (LAS float*)(F.lds + 8 * 12544); LAS float* Wx = Wa + 64 * WS_;
    {   const int ch = 64 * k + lane; const float* cw = A.in[I_CONVW] + (size_t)layer * 4 * 512 + ch; const float w0 = cw[0], w1 = cw[512], w2 = cw[1024], w3 = cw[1536], cb = A.in[I_CONVB][layer * 512 + ch];
        float lx[19];
#pragma unroll
        for (int j = 0; j < 19; ++j) { const int row = r0 - 2 + j; lx[j] = (row >= sstart && row < send) ? Z[(size_t)row * ZFW + ZLX + ch] : 0.f; }
#pragma unroll
        for (int j = 0; j < 16; ++j) xs[j * 65 + lane] = cb + w0 * lx[j] + w1 * lx[j + 1] + w2 * lx[j + 2] + w3 * lx[j + 3]; }
    float* LHL = (float*)(A.ws + WS_LHL); float* LPP = (float*)(A.ws + WS_LPP);
    for (int dir = 0; dir < 2; ++dir) {
        if (dir) __syncthreads();
        {   const float* wsa = A.in[I_LWA] + (size_t)((layer * 2 + dir) * 8 + k) * 4096; const float* wsx = A.in[I_LWX] + (size_t)((layer * 2 + dir) * 8 + k) * 4096;
#pragma unroll
            for (int j = 0; j < 2; ++j) { const int r4 = F.tid + 512 * j;
                *(LAS f32x4*)(Wa + (r4 >> 4) * WS_ + 4 * (r4 & 15)) = *(const f32x4*)(wsa + 4 * r4); *(LAS f32x4*)(Wx + (r4 >> 4) * WS_ + 4 * (r4 & 15)) = *(const f32x4*)(wsx + 4 * r4); } }
        __syncthreads();
        f32x4 aa[4], ax[4];
#pragma unroll
        for (int jt = 0; jt < 4; ++jt) { aa[jt] = (f32x4){0.f, 0.f, 0.f, 0.f}; ax[jt] = aa[jt]; }
#pragma unroll 4
        for (int ks = 0; ks < 16; ++ks) { const float a = xs[c15 * 65 + 4 * ks + g];
#pragma unroll
            for (int jt = 0; jt < 4; ++jt) { const int wi = (4 * ks + g) * WS_ + 16 * jt + c15;
                aa[jt] = __builtin_amdgcn_mfma_f32_16x16x4f32(a, Wa[wi], aa[jt], 0, 0, 0); ax[jt] = __builtin_amdgcn_mfma_f32_16x16x4f32(a, Wx[wi], ax[jt], 0, 0, 0); } }
        const int pb = (layer * 2 + dir) * 512 + 64 * k;
#pragma unroll
        for (int jt = 0; jt < 4; ++jt) { const int chl = 16 * jt + c15; const float ba = A.in[I_LBA][pb + chl], bx = A.in[I_LBX][pb + chl], sp = log1pf(__expf(-A.in[I_LAM][pb + chl]));
#pragma unroll
            for (int r = 0; r < 4; ++r) { const int j = 4 * g + r; const float rg = sigmoid_f(aa[jt][r] + ba), ig = sigmoid_f(ax[jt][r] + bx);
                const float la = -8.0f * rg * sp, av = __expf(la), mult = __builtin_amdgcn_sqrtf(neg_expm1(2.0f * la)), uv = mult * ig * xs[j * 65 + chl];
                au[(j * 64 + chl) * 2] = av; au[(j * 64 + chl) * 2 + 1] = uv; } }
        LDS_WAIT(); asm volatile("" ::: "memory");
        float hh = 0.f, P = 1.f;
#pragma unroll
        for (int jj = 0; jj < 16; ++jj) { const int j = dir ? 15 - jj : jj; const float av = au[(j * 64 + lane) * 2], uv = au[(j * 64 + lane) * 2 + 1];
            hh = av * hh + uv; P *= av; const size_t o = ((size_t)(r0 + j) * 2 + dir) * 512 + 64 * k + lane; LHL[o] = hh; LPP[o] = P; }
        LDS_WAIT(); asm volatile("" ::: "memory");
    }
}
__device__ __forceinline__ float gelu_tanh(float x) { const float t = 0.7978845608028654f * (x + 0.044715f * x * x * x); return 0.5f * x * (1.0f + tanhf(t)); }
__device__ __forceinline__ void lru_final_unit(const Frame& F_, const Args& A, int tt, int layer) {
    Frame F = F_; F.tid = opq(F_.tid); F.lane = F.tid & 63;
    const int ch = F.tid, r0 = 16 * tt;
    const int s = r0 < NCTX ? r0 >> 8 : 16 + ((r0 - NCTX) >> 10), f0 = (r0 < NCTX ? (r0 & ~255) : NCTX + ((r0 - NCTX) & ~1023)) >> 4, nt = r0 < NCTX ? 16 : 64;
    const float* LHL = (const float*)(A.ws + WS_LHL); const float* LPP = (const float*)(A.ws + WS_LPP); const float* Z = (const float*)(A.ws + WS_ZF);
    float cf = 0.f, cb = 0.f;
    if (s >= 16) { const float* h0 = A.in[I_SLRU] + (size_t)((s - 16) * 2 + layer) * 1024; cf = h0[ch]; cb = h0[512 + ch]; }
    {   int j = f0;
        for (; j + 8 <= tt; j += 8) { float hv[8], pv[8];
#pragma unroll
            for (int q = 0; q < 8; ++q) { const size_t o = ((size_t)(16 * (j + q) + 15) * 2 + 0) * 512 + ch; hv[q] = LHL[o]; pv[q] = LPP[o]; }
#pragma unroll
            for (int q = 0; q < 8; ++q) cf = hv[q] + pv[q] * cf; }
        for (; j < tt; ++j) { const size_t o = ((size_t)(16 * j + 15) * 2 + 0) * 512 + ch; cf = LHL[o] + LPP[o] * cf; } }
    {   int j = f0 + nt - 1;
        for (; j - 8 >= tt; j -= 8) { float hv[8], pv[8];
#pragma unroll
            for (int q = 0; q < 8; ++q) { const size_t o = ((size_t)(16 * (j - q)) * 2 + 1) * 512 + ch; hv[q] = LHL[o]; pv[q] = LPP[o]; }
#pragma unroll
            for (int q = 0; q < 8; ++q) cb = hv[q] + pv[q] * cb; }
        for (; j > tt; --j) { const size_t o = ((size_t)(16 * j) * 2 + 1) * 512 + ch; cb = LHL[o] + LPP[o] * cb; } }
    bf16* OC = (bf16*)(A.ws + WS_OC);
#pragma unroll 4
    for (int i = 0; i < 16; ++i) { const size_t row = (size_t)(r0 + i), o0 = (row * 2) * 512 + ch, o1 = o0 + 512;
        const float hf = LHL[o0] + LPP[o0] * cf, hb = LHL[o1] + LPP[o1] * cb, y = (hf + hb) * gelu_tanh(Z[row * ZFW + ZLG + ch]);
        OC[row * 512 + ch] = (bf16)f2bf(y);
        if (s < 16) { if (i == 15 && tt == f0 + nt - 1) A.out[OUT_SL + (size_t)((s * 2 + layer) * 2 + 0) * 512 + ch] = hf;
                      if (i == 0 && tt == f0) A.out[OUT_SL + (size_t)((s * 2 + layer) * 2 + 1) * 512 + ch] = hb; } }
}

#ifndef DUP_P0C
#define DUP_P0C 0
#endif
#ifndef DUP_P0M
#define DUP_P0M 0
#endif
#ifndef DUP_H1
#define DUP_H1 0
#endif
#ifndef DUP_UP1
#define DUP_UP1 0
#endif
#ifndef DUP_NA
#define DUP_NA 0
#endif
#ifndef DUP_CA
#define DUP_CA 0
#endif
#ifndef DUP_L1
#define DUP_L1 0
#endif
#ifndef DUP_H3
#define DUP_H3 0
#endif
#ifndef DUP_L2
#define DUP_L2 0
#endif
#ifndef DUP_NORM
#define DUP_NORM 0
#endif
#ifndef PROBE_NOCACHE
#define PROBE_NOCACHE 0
#endif
#ifndef PROBE_MEMSET
#define PROBE_MEMSET 0
#endif
#ifndef MK_N_LAUNCHES
#define MK_N_LAUNCHES 1
#endif
constexpr int N_PHASES = 3 + 12 * DEPTH;
__global__ void __launch_bounds__(NTHREADS, 2) trunk_fwd(Args A) {
    extern __shared__ __attribute__((aligned(16))) unsigned char lds_raw[];
    Frame F; F.lds = (LAS unsigned char*)lds_raw; F.tid = threadIdx.x; F.lane = F.tid & 63; F.wave = __builtin_amdgcn_readfirstlane(F.tid >> 6);
    F.G = gridDim.x; F.gw = blockIdx.x * NWAVES + F.wave; F.NGW = F.G * NWAVES;
    volatile LAS unsigned* MISC = (volatile LAS unsigned*)(F.lds + LDSCTL_OFF);
    for (int u = F.tid; u < (LDS_BYTES - LDSCTL_OFF) / 4; u += NTHREADS) MISC[u] = 0u;
    __syncthreads();
    gu32* ctl = (gu32*)(A.ws + WS_CTL);
    XcdBarrier bar; bar.bar = (unsigned*)(ctl + CW_BAR); bar.x = 0; bar.st = nullptr;
    if (MK_N_LAUNCHES == 1) bar = xcd_barrier_post((unsigned*)(ctl + CW_BAR), MISC + 8);
    const int lo = A.ph_lo, hi = A.ph_hi;
#define IN(k) (lo <= (k) && (k) < hi)
#define SEAM(k) do { if (IN(k) && IN((k) + 1)) { XcdBarrier b2_ = bar; asm volatile("" : "+s"(b2_.bar)); xcd_barrier(b2_); } } while (0)
    gu32* cvq = ctl + CW_Q + 30 * 64;
#define CV_END(l_, j_, gemm_) do { if (CV_BACKGROUND && IN(3 + 12 * (l_) + (j_))) cv_until(F, A, cvq, cv_need((l_), (j_)), (gemm_) ? ctl + CW_Q + (32 + 12 * (l_) + (j_)) * 64 : (gu32*)nullptr, MISC + 20); } while (0)
    unsigned char* ws = A.ws;
    float* X = (float*)(ws + WS_X); bf16* H = (bf16*)(ws + WS_H); bf16* HID = (bf16*)(ws + WS_HID);
    float* MODS = (float*)(ws + WS_MODS);
    LAS unsigned char* ring = F.lds;

#ifndef NO_P0
    if (IN(0)) { p0_convert(F, A); p0_mods_partial(F, A);
#if !PROBE_NOCACHE
        p0_cache(F, A);
#endif
    }
#if DUP_P0C
    if (IN(0)) { __syncthreads(); p0_convert(F, A); }
#endif
#if DUP_P0M
    if (IN(0)) { __syncthreads(); p0_mods_partial(F, A); }
#endif
    #endif
        SEAM(0);
#ifndef NO_P1
    if (IN(1)) p0_mods_reduce(F, A);
    #endif
        SEAM(1);
#ifndef NO_P2
    if (IN(2)) norm_rows<0>(F, A.in[I_XP], A.in[I_XS], X, A.in[I_NORMG], MODS, 0, H, nullptr);
    #endif
        SEAM(2);

    for (int l = 0; l < DEPTH; ++l) {
        const int pb = 3 + 12 * l;
        unsigned char* wl = ws + WS_W + (size_t)l * W_LAYER;
        const float* mods_l = MODS + (size_t)l * 3 * 9 * DM;
        const float* ng = A.in[I_NORMG] + (size_t)l * 3 * DM;
#ifndef NO_G0
        if (IN(pb + 0)) { pg8::Gemm g{H, (const bf16*)(wl + WO_UP1), MTOK, 2 * DFF, DM}; pg8::StaticOrder S; S.init(MTOK, 2 * DFF, F.G, (int)blockIdx.x);
            pg8::EpiSwiglu E{HID, DFF}; pg8::gemm_phase<pg8::EpiSwiglu, pg8::StaticOrder, true, true>(ring, g, S, E);
#if DUP_UP1
            __syncthreads(); pg8::gemm_phase<pg8::EpiSwiglu, pg8::StaticOrder, true, true>(ring, g, S, E);
#endif
        }
        #endif
        CV_END(l, 0, 1);
        SEAM(pb + 0);
#ifndef NO_G1
        if (IN(pb + 1)) { pg8::Gemm g{HID, (const bf16*)(wl + WO_DN1), MTOK, DM, DFF}; pg8::StaticOrder S; S.init(MTOK, DM, F.G, (int)blockIdx.x);
            pg8::EpiResid E{X, DM, mods_l, 0, 0.5f}; pg8::gemm_phase<pg8::EpiResid, pg8::StaticOrder, true, true>(ring, g, S, E); }
        #endif
        CV_END(l, 1, 1);
        SEAM(pb + 1);
#ifndef NO_N2
        if (IN(pb + 2)) norm_rows<0>(F, X, X + (size_t)NCTX * DM, nullptr, ng + DM, mods_l, 1, H, nullptr);
#if DUP_NORM
        if (IN(pb + 2)) norm_rows<0>(F, X, X + (size_t)NCTX * DM, nullptr, ng + DM, mods_l, 1, H, nullptr);
#endif
        #endif
        CV_END(l, 2, 0);
        SEAM(pb + 2);
#ifndef NO_G3
        if (IN(pb + 3)) { pg8::Gemm g{H, (const bf16*)(wl + WO_IN), MTOK, DIN, DM}; pg8::StaticOrder S; S.init(MTOK, DIN, F.G, (int)blockIdx.x);
            pg8::EpiZ E{(float*)(ws + WS_ZF), (bf16*)(ws + WS_QB), (bf16*)(ws + WS_KB), (bf16*)(ws + WS_VT), (bf16*)(ws + WS_GB), A.out + OUT_K, A.out + OUT_V, l, (float*)(ws + 736 * MiB)}; pg8::gemm_phase<pg8::EpiZ, pg8::StaticOrder, true, true>(ring, g, S, E); }
        #endif
        CV_END(l, 3, 1);
        SEAM(pb + 3);
        if (IN(pb + 4)) {
            gu32* q = ctl + CW_Q + (l * 8) * 64;
            #ifndef NO_H1
            for (int u; (u = next_unit(q + 0 * 64, MISC + 16)) < 768;) hgrn_local_unit(F, A, u, l);
#endif
#if DUP_H1
            for (int u; (u = next_unit(q + 6 * 64, MISC + 16)) < 768;) hgrn_local_unit(F, A, u, l);
#endif
            #ifndef NO_NA
            for (int u; (u = next_unit(q + 1 * 64, MISC + 16)) < 256;) attn_na_unit(F, A, u, l);
#endif
#if DUP_NA
            for (int u; (u = next_unit(q + 6 * 64, MISC + 16)) < 256;) attn_na_unit(F, A, u, l);
#endif
            #ifndef NO_CA
            for (int u; (u = next_unit(q + 2 * 64, MISC + 16)) < 256;) attn_ctx_unit(F, A, u);
#endif
#if DUP_CA
            for (int u; (u = next_unit(q + 6 * 64, MISC + 16)) < 256;) attn_ctx_unit(F, A, u);
#endif
            #ifndef NO_L1
            for (int u; (u = next_unit(q + 3 * 64, MISC + 16)) < 384;) lru_gate_unit(F, A, u, l);
#endif
#if DUP_L1
            for (int u; (u = next_unit(q + 6 * 64, MISC + 16)) < 384;) lru_gate_unit(F, A, u, l);
#endif
        }
        CV_END(l, 4, 0);
        SEAM(pb + 4);
        if (IN(pb + 5)) {
            gu32* q = ctl + CW_Q + (l * 8) * 64;
            #ifndef NO_H3
            for (int u; (u = next_unit(q + 4 * 64, MISC + 16)) < 384;) hgrn_final_unit(F, A, u, l);
#endif
#if DUP_H3
            for (int u; (u = next_unit(q + 7 * 64, MISC + 16)) < 384;) hgrn_final_unit(F, A, u, l);
#endif
            #ifndef NO_L2
            for (int u; (u = next_unit(q + 5 * 64, MISC + 16)) < 384;) lru_final_unit(F, A, u, l);
#endif
#if DUP_L2
            for (int u; (u = next_unit(q + 7 * 64, MISC + 16)) < 384;) lru_final_unit(F, A, u, l);
#endif
        }
        CV_END(l, 5, 0);
        SEAM(pb + 5);
#ifndef NO_G6
        if (IN(pb + 6)) {
            __syncthreads();
            float* MACC = (float*)(ws + WS_MACC); bf16* MB = (bf16*)(ws + WS_MB);
            { pg8::Gemm g{(const bf16*)(ws + WS_OA), (const bf16*)(wl + WO_PA), MTOK, DM, 512}; pg8::StaticOrder S; S.init(MTOK, DM, F.G, (int)blockIdx.x);
              pg8::EpiMerge E{(const bf16*)(ws + WS_GB), MACC, MB, 0}; pg8::gemm_phase<pg8::EpiMerge, pg8::StaticOrder, true, true>(ring, g, S, E); }
            { pg8::Gemm g{(const bf16*)(ws + WS_OB), (const bf16*)(wl + WO_PB), MTOK, DM, 1024}; pg8::StaticOrder S; S.init(MTOK, DM, F.G, (int)blockIdx.x);
              pg8::EpiMerge E{(const bf16*)(ws + WS_GB) + DM, MACC, MB, 1}; pg8::gemm_phase<pg8::EpiMerge, pg8::StaticOrder, true, true>(ring, g, S, E); }
            { pg8::Gemm g{(const bf16*)(ws + WS_OC), (const bf16*)(wl + WO_PC), MTOK, DM, 512}; pg8::StaticOrder S; S.init(MTOK, DM, F.G, (int)blockIdx.x);
              pg8::EpiMerge E{(const bf16*)(ws + WS_GB) + 2 * DM, MACC, MB, 2}; pg8::gemm_phase<pg8::EpiMerge, pg8::StaticOrder, true, true>(ring, g, S, E); }
        }
        #endif
        CV_END(l, 6, 1);
        SEAM(pb + 6);
#ifndef NO_G7
        if (IN(pb + 7)) { pg8::Gemm g{(const bf16*)(ws + WS_MB), (const bf16*)(wl + WO_OUT), MTOK, DM, DM}; pg8::StaticOrder S; S.init(MTOK, DM, F.G, (int)blockIdx.x);
            pg8::EpiResid E{X, DM, mods_l, 1, 1.0f}; pg8::gemm_phase<pg8::EpiResid, pg8::StaticOrder, true, true>(ring, g, S, E); }
        #endif
        CV_END(l, 7, 1);
        SEAM(pb + 7);
#ifndef NO_N8
        if (IN(pb + 8)) norm_rows<0>(F, X, X + (size_t)NCTX * DM, nullptr, ng + 2 * DM, mods_l, 2, H, nullptr);
        #endif
        CV_END(l, 8, 0);
        SEAM(pb + 8);
#ifndef NO_G9
        if (IN(pb + 9)) { pg8::Gemm g{H, (const bf16*)(wl + WO_UP2), MTOK, 2 * DFF, DM}; pg8::StaticOrder S; S.init(MTOK, 2 * DFF, F.G, (int)blockIdx.x);
            pg8::EpiSwiglu E{HID, DFF}; pg8::gemm_phase<pg8::EpiSwiglu, pg8::StaticOrder, true, true>(ring, g, S, E); }
        #endif
        CV_END(l, 9, 1);
        SEAM(pb + 9);
#ifndef NO_G10
        if (IN(pb + 10)) { pg8::Gemm g{HID, (const bf16*)(wl + WO_DN2), MTOK, DM, DFF}; pg8::StaticOrder S; S.init(MTOK, DM, F.G, (int)blockIdx.x);
            pg8::EpiResid E{X, DM, mods_l, 2, 0.5f}; pg8::gemm_phase<pg8::EpiResid, pg8::StaticOrder, true, true>(ring, g, S, E); }
        #endif
        CV_END(l, 10, 1);
        SEAM(pb + 10);
#ifndef NO_N11
        if (IN(pb + 11)) {
            if (l + 1 < DEPTH) norm_rows<0>(F, X, X + (size_t)NCTX * DM, nullptr, ng + 3 * DM, mods_l + 3 * 9 * DM, 0, H, nullptr);
            else norm_rows<1>(F, X, X + (size_t)NCTX * DM, nullptr, A.in[I_FNG], nullptr, 0, nullptr, A.out + OUT_Y);
        }
        #endif
        CV_END(l, 11, 0);
        SEAM(pb + 11);
    }
#undef IN
#undef SEAM
}

extern "C" void kernel_launch(void* const* d_in, const int* in_sizes, int n_in, void* d_out, int out_size, void* d_ws, size_t ws_size, hipStream_t stream) {
    static int grid = 0;
    if (grid == 0) {
        if (n_in != 31 || out_size != 33587200 || ws_size < WS_END) { fprintf(stderr, "kernel_launch: unexpected shapes (n_in %d, out %d, ws %zu); nothing launched\n", n_in, out_size, ws_size); grid = -1; return; }
        int dev = 0, cus = 0, per_cu = 0;
        if (hipGetDevice(&dev) != hipSuccess || hipDeviceGetAttribute(&cus, hipDeviceAttributeMultiprocessorCount, dev) != hipSuccess) { grid = -1; return; }
        if (hipFuncSetAttribute((const void*)trunk_fwd, hipFuncAttributeMaxDynamicSharedMemorySize, LDS_BYTES) != hipSuccess) { fprintf(stderr, "kernel_launch: hipFuncSetAttribute failed\n"); grid = -1; return; }
        if (hipOccupancyMaxActiveBlocksPerMultiprocessor(&per_cu, (const void*)trunk_fwd, NTHREADS, LDS_BYTES) != hipSuccess || per_cu < 1) { fprintf(stderr, "kernel_launch: occupancy query says %d blocks per CU\n", per_cu); (void)hipGetLastError(); grid = -1; return; }
        grid = cus;
    }
    if (grid < 0) return;
    if (hipMemsetAsync((char*)d_ws + WS_CTL, 0, CTL_ZERO_BYTES, stream) != hipSuccess) return;
#if PROBE_MEMSET
    (void)hipMemsetAsync((char*)d_ws + PROBE_MS_LO * MiB, 0, (PROBE_MS_HI - PROBE_MS_LO) * MiB, stream);
#endif
    Args a{};
    for (int i = 0; i < 31; ++i) a.in[i] = (const float*)d_in[i];
    a.out = (float*)d_out; a.ws = (unsigned char*)d_ws;
#if MK_N_LAUNCHES == 1
    a.ph_lo = 0; a.ph_hi = N_PHASES;
    hipLaunchKernelGGL(trunk_fwd, dim3(grid), dim3(NTHREADS), LDS_BYTES, stream, a);
#else
    for (int p = 0; p < N_PHASES; ++p) { a.ph_lo = p; a.ph_hi = p + 1; hipLaunchKernelGGL(trunk_fwd, dim3(grid), dim3(NTHREADS), LDS_BYTES, stream, a); }
#endif
}
```

```cpp
#include <hip/hip_runtime.h>
#include <cstdio>
#include <cstdint>
namespace pg8 {
#define PG8_LAS __attribute__((address_space(3)))
typedef unsigned short bf16_t;
typedef short bf16x8 __attribute__((ext_vector_type(8)));
typedef float f32x4 __attribute__((ext_vector_type(4)));
typedef unsigned u32x4 __attribute__((ext_vector_type(4)));
constexpr int BM = 256, BK = 64, HALF = 128, HTB = HALF * BK * 2  , STAGE_BYTES = 8 * HTB, NXCD = 8, WGM = 8;

__host__ __device__ __forceinline__ int lds_byte(int r, int c) { const int st = (r >> 4) * 2 + (c >> 5), rr = r & 15, cc = c & 31, ob = rr * 64 + cc * 2; return st * 1024 + (ob ^ (((ob >> 9) & 1) << 5)); }
__host__ __device__ __forceinline__ void stage_rc(int b, int& R, int& C) { const int st = b / 1024, sb = b % 1024, swz = sb ^ (((sb >> 9) & 1) << 5); R = (st >> 1) * 16 + swz / 64; C = (st & 1) * 32 + (swz % 64) / 2; }
__host__ __device__ __forceinline__ int perm32(int rho) { const int n = rho >> 4, i = rho & 15; return 8 * (i >> 2) + 4 * n + (i & 3); }

struct Unit { int pm, pn; };
struct Gemm { const bf16_t* A; const bf16_t* Bt; int M, N, K; };

struct StaticOrder {
    int nM, nN, nwg, G, c;
    __host__ __device__ void init(int M, int N, int G_, int c_) { nM = M / BM; nN = N / BM; nwg = nM * nN; G = G_; c = c_; }
    __host__ __device__ bool next(int i, Unit& u) const {
        const long L = (long)i * G + c; if (L >= nwg) return false;
        int wgid = (int)L; { const int q = nwg / NXCD, r = nwg % NXCD, xcd = wgid % NXCD, off = wgid / NXCD; wgid = (xcd < r ? xcd * (q + 1) : r * (q + 1) + (xcd - r) * q) + off; }
        const int nig = WGM * nN, gid = wgid / nig, fm = gid * WGM, gsz = (nM - fm) < WGM ? (nM - fm) : WGM;
        u.pm = fm + ((wgid % nig) % gsz); u.pn = (wgid % nig) / gsz; return true;
    }
    __device__ __forceinline__ void a_ready(const Unit&) const {}
    __device__ __forceinline__ void done(const Unit&) const {}
};
typedef float f32x2_cv __attribute__((ext_vector_type(2)));
typedef __bf16 bf16x2_cv __attribute__((ext_vector_type(2)));
__device__ __forceinline__ unsigned cvt_pk_bf16(float lo, float hi) { const f32x2_cv v = {lo, hi}; return __builtin_bit_cast(unsigned, __builtin_convertvector(v, bf16x2_cv)); }
typedef float f32x2 __attribute__((ext_vector_type(2)));

typedef unsigned u32x2 __attribute__((ext_vector_type(2)));
#ifndef PROBE_NOGATE
#define PROBE_NOGATE 0
#endif
#ifndef PROBE_GCONST
#define PROBE_GCONST 0
#endif
#ifndef PROBE_GRAW
#define PROBE_GRAW 0
#endif
#ifndef PROBE_QKV32
#define PROBE_QKV32 0
#endif
__device__ __forceinline__ float silu_f(float a) { return a * __builtin_amdgcn_rcpf(1.0f + __expf(-a)); }
__device__ __forceinline__ float sigmoid_f(float a) { return __builtin_amdgcn_rcpf(1.0f + __expf(-a)); }
__device__ __forceinline__ int opq_(int v) { asm volatile("" : "+v"(v)); return v; }

struct EpiSwiglu {
    static constexpr bool PERM = true, AFTER_DRAIN = false;
    bf16_t* O; int ldo;
    __device__ __forceinline__ void operator()(const f32x4 (&acc)[2][2][4][2], const Unit& u, int wr, int wc, int fr_, int fq_) const {
        const int fr = opq_(fr_), fq = opq_(fq_);
        const int row0 = u.pm * BM + wr * 64 + fr, col0 = u.pn * HALF + wc * 32 + 8 * fq;
#pragma unroll
        for (int ai = 0; ai < 2; ++ai)
#pragma unroll
            for (int m = 0; m < 4; ++m) { bf16_t* rowp = O + (size_t)(row0 + ai * HALF + m * 16) * ldo + col0;
                const f32x4 a0 = acc[ai][0][m][0], a1 = acc[ai][0][m][1], u0 = acc[ai][1][m][0], u1 = acc[ai][1][m][1];
                f32x4 v0, v1;
#pragma unroll
                for (int j = 0; j < 4; ++j) { v0[j] = silu_f(a0[j]) * u0[j]; v1[j] = silu_f(a1[j]) * u1[j]; }
                u32x4 w; w.x = cvt_pk_bf16(v0[0], v0[1]); w.y = cvt_pk_bf16(v0[2], v0[3]); w.z = cvt_pk_bf16(v1[0], v1[1]); w.w = cvt_pk_bf16(v1[2], v1[3]);
                *(u32x4*)rowp = w; }
    }
};
struct EpiResid {
    static constexpr bool PERM = false, AFTER_DRAIN = false;
    float* X; int ldx; const float* mods_l; int slot; float coef;
    __device__ __forceinline__ void operator()(const f32x4 (&acc)[2][2][4][2], const Unit& u, int wr, int wc, int fr_, int fq_) const {
        const int fr = opq_(fr_), fq = opq_(fq_);
        const int row0 = u.pm * BM + wr * 64 + fr, col0 = u.pn * BM + wc * 32 + 4 * fq;
        const int cidx = u.pm < 16 ? 0 : 1 + ((u.pm - 16) >> 2);
        const float* g = mods_l + (size_t)(cidx * 9 + 3 * slot + 2) * 2048 + col0;
        f32x4 gv[2][2];
#pragma unroll
        for (int bj = 0; bj < 2; ++bj)
#pragma unroll
            for (int n = 0; n < 2; ++n) gv[bj][n] = *(const f32x4*)(g + bj * HALF + n * 16) * coef;
#pragma unroll
        for (int ai = 0; ai < 2; ++ai)
#pragma unroll
            for (int m = 0; m < 4; ++m) { float* rowp = X + (size_t)(row0 + ai * HALF + m * 16) * ldx + col0;
#pragma unroll
                for (int bj = 0; bj < 2; ++bj)
#pragma unroll
                    for (int n = 0; n < 2; ++n) { f32x4* p = (f32x4*)(rowp + bj * HALF + n * 16); *p = *p + gv[bj][n] * acc[ai][bj][m][n]; } }
    }
};
struct EpiZ {
    static constexpr bool PERM = false, AFTER_DRAIN = false;
    float* ZF; bf16_t* QB; bf16_t* KB; bf16_t* VT; bf16_t* GB; float* outk; float* outv; int layer; float* Q32;
    __device__ __forceinline__ void operator()(const f32x4 (&acc)[2][2][4][2], const Unit& u, int wr, int wc, int fr_, int fq_) const {
        const int fr = opq_(fr_), fq = opq_(fq_);
        const int rl0 = wr * 64 + fr, ct0 = wc * 32 + 4 * fq, pn = u.pn;
#if PROBE_QKV32
        if (pn >= 10 && pn < 22) { float* base = Q32 + (size_t)(u.pm * BM + rl0) * 3072 + (pn - 10) * 256 + ct0;
#pragma unroll
            for (int ai = 0; ai < 2; ++ai)
#pragma unroll
                for (int m = 0; m < 4; ++m) { float* rowp = base + (size_t)(ai * HALF + m * 16) * 3072;
#pragma unroll
                    for (int bj = 0; bj < 2; ++bj)
#pragma unroll
                        for (int n = 0; n < 2; ++n) *(f32x4*)(rowp + bj * HALF + n * 16) = acc[ai][bj][m][n]; } }
#endif
        if (pn < 10 || (pn >= 22 && pn < 26)) {
            float* base = ZF + (size_t)(u.pm * BM + rl0) * 3584 + (pn < 10 ? pn * 256 : 2560 + (pn - 22) * 256) + ct0;
#pragma unroll
            for (int ai = 0; ai < 2; ++ai)
#pragma unroll
                for (int m = 0; m < 4; ++m) { float* rowp = base + (size_t)(ai * HALF + m * 16) * 3584;
#pragma unroll
                    for (int bj = 0; bj < 2; ++bj)
#pragma unroll
                        for (int n = 0; n < 2; ++n) *(f32x4*)(rowp + bj * HALF + n * 16) = acc[ai][bj][m][n]; }
        } else if (pn < 18) {
            bf16_t* dst = (pn < 14 ? QB + (pn - 10) * 256 : KB + (pn - 14) * 256) + (size_t)(u.pm * BM + rl0) * 1024 + ct0;
            float* ko = (pn >= 14 && u.pm < 16) ? outk + ((size_t)(u.pm * 2 + layer) * 256 + rl0) * 1024 + (pn - 14) * 256 + ct0 : nullptr;
#pragma unroll
            for (int ai = 0; ai < 2; ++ai)
#pragma unroll
                for (int m = 0; m < 4; ++m) { const size_t ro = (size_t)(ai * HALF + m * 16) * 1024;
#pragma unroll
                    for (int bj = 0; bj < 2; ++bj)
#pragma unroll
                        for (int n = 0; n < 2; ++n) { const f32x4 v = acc[ai][bj][m][n]; u32x2 w; w.x = cvt_pk_bf16(v[0], v[1]); w.y = cvt_pk_bf16(v[2], v[3]);
                            *(u32x2*)(dst + ro + bj * HALF + n * 16) = w; if (ko) *(f32x4*)(ko + ro + bj * HALF + n * 16) = v; } }
        } else if (pn < 22) {
            const bool ctx = u.pm < 16; const int L = ctx ? 256 : 1024, t0 = (ctx ? 0 : ((u.pm - 16) & 3) * 256) + rl0;
            bf16_t* vb = ctx ? VT + (size_t)u.pm * 8 * 128 * 256 : VT + (size_t)4096 * 1024 + (size_t)((u.pm - 16) >> 2) * 8 * 128 * 1024;
            vb += (size_t)(2 * (pn - 18)) * 128 * L + (size_t)ct0 * L + t0;
            float* vo = ctx ? outv + ((size_t)(u.pm * 2 + layer) * 256 + rl0) * 1024 + (pn - 18) * 256 + ct0 : nullptr;
#pragma unroll
            for (int ai = 0; ai < 2; ++ai)
#pragma unroll
                for (int m = 0; m < 4; ++m) { const int tr = ai * HALF + m * 16;
#pragma unroll
                    for (int bj = 0; bj < 2; ++bj)
#pragma unroll
                        for (int n = 0; n < 2; ++n) { const f32x4 v = acc[ai][bj][m][n]; bf16_t* p = vb + (size_t)(bj * 128 + n * 16) * L + tr;
                            const unsigned w0 = cvt_pk_bf16(v[0], v[1]), w1 = cvt_pk_bf16(v[2], v[3]);
                            p[0] = (bf16_t)(w0 & 0xffffu); p[L] = (bf16_t)(w0 >> 16); p[2 * L] = (bf16_t)(w1 & 0xffffu); p[3 * L] = (bf16_t)(w1 >> 16);
                            if (vo) *(f32x4*)(vo + (size_t)tr * 1024 + bj * HALF + n * 16) = v; } }
        } else {
            bf16_t* dst = GB + (size_t)(u.pm * BM + rl0) * 6144 + (pn - 26) * 256 + ct0;
#pragma unroll
            for (int ai = 0; ai < 2; ++ai)
#pragma unroll
                for (int m = 0; m < 4; ++m) { const size_t ro = (size_t)(ai * HALF + m * 16) * 6144;
#pragma unroll
                    for (int bj = 0; bj < 2; ++bj)
#pragma unroll
                        for (int n = 0; n < 2; ++n) { const f32x4 v = acc[ai][bj][m][n]; u32x2 w; w.x = cvt_pk_bf16(sigmoid_f(v[0]), sigmoid_f(v[1])); w.y = cvt_pk_bf16(sigmoid_f(v[2]), sigmoid_f(v[3]));
#if PROBE_GCONST
                            w.x = 0x3f003f00u; w.y = 0x3f003f00u;
#endif
#if PROBE_GRAW
                            w.x = cvt_pk_bf16(v[0] * 0.01f, v[1] * 0.01f); w.y = cvt_pk_bf16(v[2] * 0.01f, v[3] * 0.01f);
#endif
                            *(u32x2*)(dst + ro + bj * HALF + n * 16) = w; } }
        }
    }
};
struct EpiMerge {
    static constexpr bool PERM = false, AFTER_DRAIN = false;
    const bf16_t* Gg; float* MACC; bf16_t* MB; int mode;
    __device__ __forceinline__ void operator()(const f32x4 (&acc)[2][2][4][2], const Unit& u, int wr, int wc, int fr_, int fq_) const {
        const int fr = opq_(fr_), fq = opq_(fq_);
        const int row0 = u.pm * BM + wr * 64 + fr, col0 = u.pn * BM + wc * 32 + 4 * fq;
#pragma unroll
        for (int ai = 0; ai < 2; ++ai)
#pragma unroll
            for (int m = 0; m < 4; ++m) { const size_t row = (size_t)(row0 + ai * HALF + m * 16);
#pragma unroll
                for (int bj = 0; bj < 2; ++bj)
#pragma unroll
                    for (int n = 0; n < 2; ++n) { const int c = col0 + bj * HALF + n * 16;
#if PROBE_NOGATE
                        const u32x2 gw = {0x3f003f00u, 0x3f003f00u}; f32x4 v = acc[ai][bj][m][n];
#else
                        const u32x2 gw = *(const u32x2*)(Gg + row * 6144 + c); f32x4 v = acc[ai][bj][m][n];
#endif
                        v[0] *= __uint_as_float(gw.x << 16); v[1] *= __uint_as_float(gw.x & 0xffff0000u); v[2] *= __uint_as_float(gw.y << 16); v[3] *= __uint_as_float(gw.y & 0xffff0000u);
                        f32x4* mp = (f32x4*)(MACC + row * 2048 + c);
                        if (mode == 0) *mp = v;
                        else if (mode == 1) *mp = *mp + v;
                        else { v = *mp + v; u32x2 w; w.x = cvt_pk_bf16(v[0], v[1]); w.y = cvt_pk_bf16(v[2], v[3]); *(u32x2*)(MB + row * 2048 + c) = w; } } }
    }
};
template <class Epi, class Sched, bool ALIGN_EPI = false, bool SP2 = false>
__device__ __forceinline__ void gemm_phase(PG8_LAS unsigned char* lds, const Gemm g, const Sched& S, const Epi& E) {
    int tid_ = threadIdx.x; asm volatile("" : "+v"(tid_));
    const int tid = tid_, wid = __builtin_amdgcn_readfirstlane(tid >> 6), lane = tid & 63, wr = wid >> 2, wc = wid & 3, fr = lane & 15, fq = lane >> 4;
    const int K = g.K, nt = K / BK;
    unsigned voffA[2], voffB[2];
#pragma unroll
    for (int i = 0; i < 2; ++i) { int R, C; stage_rc(tid * 16 + i * 8192, R, C); const int Rb = Epi::PERM ? ((R & ~31) + perm32(R & 31)) : R;
        voffA[i] = (unsigned)(R * K + C) * 2u; voffB[i] = (unsigned)(Rb * K + C) * 2u; }
    const size_t kstep = (size_t)(BK * 2);
    const size_t hstep = (size_t)HALF * K * 2;
    const size_t tstep = 2 * hstep;
    const unsigned ldsw = (unsigned)wid * 1024u;
    const int aoff = lds_byte(wr * 64 + fr, fq * 8), boff = lds_byte(wc * 32 + fr, fq * 8);
#define PG8_SA(b, h) (((b) * 2 + (h)) * HTB)
#define PG8_SB(b, h) ((4 + (b) * 2 + (h)) * HTB)
#define PG8_STAGE(bufoff, gbase, voff) do { _Pragma("unroll") for (int _i = 0; _i < 2; ++_i) \
        __builtin_amdgcn_global_load_lds((const unsigned*)((const char*)(gbase) + (voff)[_i]), (PG8_LAS unsigned*)(lds + (bufoff) + ldsw + _i * 8192), 16, 0, 0); } while (0)
#define PG8_LDA(dst, b, h) do { _Pragma("unroll") for (int m = 0; m < 4; ++m) _Pragma("unroll") for (int k = 0; k < 2; ++k) dst[m][k] = *(const PG8_LAS bf16x8*)(lds + PG8_SA(b, h) + aoff + m * 2048 + k * 1024); } while (0)
#define PG8_LDB(dst, b, h) do { _Pragma("unroll") for (int n = 0; n < 2; ++n) _Pragma("unroll") for (int k = 0; k < 2; ++k) dst[n][k] = *(const PG8_LAS bf16x8*)(lds + PG8_SB(b, h) + boff + n * 2048 + k * 1024); } while (0)
#define PG8_MMA(ai, bj, At, Bt) do { __builtin_amdgcn_s_setprio(1); _Pragma("unroll") for (int m = 0; m < 4; ++m) _Pragma("unroll") for (int n = 0; n < 2; ++n) _Pragma("unroll") for (int k = 0; k < 2; ++k) \
        acc[ai][bj][m][n] = __builtin_amdgcn_mfma_f32_16x16x32_bf16(Bt[n][k], At[m][k], acc[ai][bj][m][n], 0, 0, 0); __builtin_amdgcn_s_setprio(0); } while (0)
#define PG8_WAIT_V(n) asm volatile("s_waitcnt vmcnt(" #n ")" ::: "memory")
#define PG8_WAIT_L(n) asm volatile("s_waitcnt lgkmcnt(" #n ")" ::: "memory")
#define PG8_BAR __builtin_amdgcn_s_barrier()
#define PG8_SCHED __builtin_amdgcn_sched_barrier(0)
    Unit cur, nxt; int ui = 0;
    if (!S.next(0, cur)) return;
    f32x4 acc[2][2][4][2];
#pragma unroll
    for (int a = 0; a < 2; ++a)
#pragma unroll
        for (int b = 0; b < 2; ++b)
#pragma unroll
            for (int m = 0; m < 4; ++m)
#pragma unroll
                for (int n = 0; n < 2; ++n) acc[a][b][m][n] = (f32x4){0.f, 0.f, 0.f, 0.f};
    bf16x8 At[4][2], B0[2][2], B1[2][2];
    const char* cA = (const char*)g.A + (size_t)cur.pm * tstep; const char* cB = (const char*)g.Bt + (size_t)cur.pn * tstep;
    S.a_ready(cur);
    if constexpr (SP2) {
        PG8_STAGE(PG8_SB(0, 0), cB, voffB); PG8_STAGE(PG8_SB(0, 1), cB + hstep, voffB); PG8_STAGE(PG8_SA(0, 0), cA, voffA); PG8_STAGE(PG8_SA(0, 1), cA + hstep, voffA);
        if (wr == 1) PG8_BAR;
        PG8_WAIT_V(2); PG8_BAR;
        PG8_STAGE(PG8_SB(1, 0), cB + kstep, voffB); PG8_STAGE(PG8_SA(1, 0), cA + kstep, voffA); PG8_STAGE(PG8_SB(1, 1), cB + hstep + kstep, voffB);
        PG8_WAIT_V(6); PG8_BAR;
    } else {
        PG8_STAGE(PG8_SB(0, 0), cB, voffB); PG8_STAGE(PG8_SA(0, 0), cA, voffA); PG8_STAGE(PG8_SB(0, 1), cB + hstep, voffB); PG8_STAGE(PG8_SA(0, 1), cA + hstep, voffA);
        if (wr == 1) PG8_BAR;
        PG8_WAIT_V(4); PG8_BAR;
        PG8_STAGE(PG8_SB(1, 0), cB + kstep, voffB); PG8_STAGE(PG8_SA(1, 0), cA + kstep, voffA); PG8_STAGE(PG8_SB(1, 1), cB + hstep + kstep, voffB);
        PG8_WAIT_V(6); PG8_BAR;
    }
    for (;;) {
        const bool has_next = S.next(ui + 1, nxt);
        const char* nA = has_next ? (const char*)g.A + (size_t)nxt.pm * tstep : cA; const char* nB = has_next ? (const char*)g.Bt + (size_t)nxt.pn * tstep : cB;
        for (int t = 0; t < nt; t += 2) {
            const bool last = (t == nt - 2);
            const char* a1 = cA + (size_t)(t + 1) * kstep;
            const char* a2 = last ? nA : cA + (size_t)(t + 2) * kstep; const char* b2 = last ? nB : cB + (size_t)(t + 2) * kstep;
            const char* a3 = a2 + kstep; const char* b3 = b2 + kstep;
            if (last && has_next) S.a_ready(nxt);
            if constexpr (SP2) {
            PG8_LDB(B0, 0, 0); PG8_LDB(B1, 0, 1); PG8_SCHED; PG8_LDA(At, 0, 0); PG8_STAGE(PG8_SA(1, 1), a1 + hstep, voffA);
            PG8_WAIT_V(8); PG8_WAIT_L(0); PG8_BAR; PG8_MMA(0, 0, At, B0); PG8_MMA(0, 1, At, B1); PG8_BAR; PG8_SCHED;
            PG8_LDA(At, 0, 1); PG8_STAGE(PG8_SB(0, 0), b2, voffB); PG8_STAGE(PG8_SB(0, 1), b2 + hstep, voffB); PG8_STAGE(PG8_SA(0, 0), a2, voffA);
            PG8_WAIT_V(8); PG8_WAIT_L(0); PG8_BAR; PG8_MMA(1, 0, At, B0); PG8_MMA(1, 1, At, B1); PG8_BAR; PG8_SCHED;
            PG8_LDB(B0, 1, 0); PG8_LDB(B1, 1, 1); PG8_SCHED; PG8_LDA(At, 1, 0); PG8_STAGE(PG8_SA(0, 1), a2 + hstep, voffA);
            PG8_WAIT_V(8); PG8_WAIT_L(0); PG8_BAR; PG8_MMA(0, 0, At, B0); PG8_MMA(0, 1, At, B1); PG8_BAR; PG8_SCHED;
            PG8_LDA(At, 1, 1); PG8_STAGE(PG8_SB(1, 0), b3, voffB); PG8_STAGE(PG8_SB(1, 1), b3 + hstep, voffB); PG8_STAGE(PG8_SA(1, 0), a3, voffA);
            PG8_WAIT_V(8); PG8_WAIT_L(0); PG8_BAR; PG8_MMA(1, 0, At, B0); PG8_MMA(1, 1, At, B1); PG8_BAR; PG8_SCHED;
            } else {
            PG8_LDB(B0, 0, 0); PG8_SCHED; PG8_LDA(At, 0, 0); PG8_STAGE(PG8_SA(1, 1), a1 + hstep, voffA);
            PG8_WAIT_L(8); PG8_BAR; PG8_WAIT_L(0); PG8_MMA(0, 0, At, B0); PG8_BAR; PG8_SCHED;
            PG8_LDB(B1, 0, 1); PG8_STAGE(PG8_SB(0, 0), b2, voffB);
            PG8_BAR; PG8_WAIT_L(0); PG8_MMA(0, 1, At, B1); PG8_BAR;
            PG8_LDA(At, 0, 1); PG8_STAGE(PG8_SA(0, 0), a2, voffA);
            PG8_BAR; PG8_WAIT_L(0); PG8_MMA(1, 0, At, B0); PG8_BAR; PG8_SCHED;
            PG8_STAGE(PG8_SB(0, 1), b2 + hstep, voffB);
            PG8_WAIT_V(6); PG8_BAR; PG8_MMA(1, 1, At, B1); PG8_BAR;
            PG8_LDB(B0, 1, 0); PG8_SCHED; PG8_LDA(At, 1, 0); PG8_STAGE(PG8_SA(0, 1), a2 + hstep, voffA);
            PG8_WAIT_L(8); PG8_BAR; PG8_WAIT_L(0); PG8_MMA(0, 0, At, B0); PG8_BAR; PG8_SCHED;
            PG8_LDB(B1, 1, 1); PG8_STAGE(PG8_SB(1, 0), b3, voffB);
            PG8_BAR; PG8_WAIT_L(0); PG8_MMA(0, 1, At, B1); PG8_BAR;
            PG8_LDA(At, 1, 1); PG8_STAGE(PG8_SA(1, 0), a3, voffA);
            PG8_BAR; PG8_WAIT_L(0); PG8_MMA(1, 0, At, B0); PG8_BAR; PG8_SCHED;
            PG8_STAGE(PG8_SB(1, 1), b3 + hstep, voffB);
            PG8_WAIT_V(6); PG8_BAR; PG8_MMA(1, 1, At, B1); PG8_BAR;
            }
        }
        if constexpr (ALIGN_EPI) { if (wr == 0) PG8_BAR; }
        if constexpr (!Epi::AFTER_DRAIN) { E(acc, cur, wr, wc, fr, fq); S.done(cur); }
        if (!has_next) break;
#pragma unroll
        for (int a = 0; a < 2; ++a)
#pragma unroll
            for (int b = 0; b < 2; ++b)
#pragma unroll
                for (int m = 0; m < 4; ++m)
#pragma unroll
                    for (int n = 0; n < 2; ++n) acc[a][b][m][n] = (f32x4){0.f, 0.f, 0.f, 0.f};
        cur = nxt; cA = nA; cB = nB; ++ui;
        if constexpr (ALIGN_EPI) { if (wr == 1) PG8_BAR; }
    }
    PG8_WAIT_V(0);
    if constexpr (!ALIGN_EPI) { if (wr == 0) PG8_BAR; }
    PG8_BAR;
    if constexpr (Epi::AFTER_DRAIN) { E.fused(acc, cur, wr, wc, fr, fq, lds, wid, lane); S.done(cur); }
#undef PG8_SA
#undef PG8_SB
#undef PG8_STAGE
#undef PG8_LDA
#undef PG8_LDB
#undef PG8_MMA
#undef PG8_WAIT_V
#undef PG8_WAIT_L
#undef PG8_BAR
#undef PG8_SCHED
}
}

constexpr int DM = 2048, DFF = 5632, DIN = 12800, NCTX = 4096, NLAT = 2048, MTOK = 6144, DEPTH = 2;
constexpr int SEQ = 256, DSEQ = 1024, NSEQ = 18;
constexpr int ZQ = 0, ZFF = 512, ZFB = 1024, ZI = 1536, ZO = 2048, ZLX = 2560, ZLG = 3072, ZFW = 3584;
constexpr int NWAVES = 8, NTHREADS = 512;
constexpr size_t MiB = 1u << 20;
constexpr size_t WS_CTL = 0, CTL_ZERO_BYTES = 1 * MiB;
constexpr size_t WS_W = 2 * MiB, W_LAYER = 198 * MiB;
constexpr size_t WO_UP1 = 0, WO_DN1 = 44 * MiB, WO_UP2 = 66 * MiB, WO_DN2 = 110 * MiB, WO_IN = 132 * MiB, WO_PA = 182 * MiB, WO_PB = 184 * MiB, WO_PC = 188 * MiB, WO_OUT = 190 * MiB;
constexpr size_t WS_X = 398 * MiB;
constexpr size_t WS_H = 446 * MiB;
constexpr size_t WS_HID = 470 * MiB;
constexpr size_t WS_ZF = 536 * MiB;
constexpr size_t WS_QB = 620 * MiB;
constexpr size_t WS_KB = 632 * MiB;
constexpr size_t WS_VT = 644 * MiB;
constexpr size_t WS_GB = 656 * MiB;
constexpr size_t WS_CKB = 728 * MiB;
constexpr size_t WS_CVT = 732 * MiB;
constexpr size_t WS_OA = 836 * MiB, WS_OB = 842 * MiB, WS_OC = 854 * MiB;
constexpr size_t WS_MACC = 860 * MiB;
constexpr size_t WS_MB = 908 * MiB;
constexpr size_t WS_MODP = 932 * MiB;
constexpr size_t WS_MODS = 946 * MiB;
constexpr size_t WS_HOL = 947 * MiB;
constexpr size_t WS_HQD = 971 * MiB;
constexpr size_t WS_HSL = 995 * MiB;
constexpr size_t WS_HDEC = 1043 * MiB;
constexpr size_t WS_LHL = 1044 * MiB;
constexpr size_t WS_LPP = 1068 * MiB;
constexpr size_t WS_END = 1092 * MiB;
constexpr int CW_BAR = 4096;
constexpr int CW_Q = 16384;
constexpr int RING_BYTES = 131072, LDSCTL_OFF = 143360, LDS_BYTES = 147456;

#define GAS __attribute__((address_space(1)))
#define LAS __attribute__((address_space(3)))
typedef unsigned short bf16;
typedef unsigned v4u __attribute__((ext_vector_type(4)));
typedef unsigned v2u __attribute__((ext_vector_type(2)));
typedef float f32x4 __attribute__((ext_vector_type(4)));
typedef short bf16x8 __attribute__((ext_vector_type(8)));
typedef GAS unsigned gu32;
#define RLX_AGENT __ATOMIC_RELAXED, __HIP_MEMORY_SCOPE_AGENT
#define LDS_WAIT() asm volatile("s_waitcnt lgkmcnt(0)" ::: "memory")
#define VM_WAIT() asm volatile("s_waitcnt vmcnt(0)" ::: "memory")
__device__ __forceinline__ unsigned f2bf(float f) { unsigned u = __builtin_bit_cast(unsigned, f); return (u + 0x7fffu + ((u >> 16) & 1u)) >> 16; }
__device__ __forceinline__ unsigned pk2(float lo, float hi) { return pg8::cvt_pk_bf16(lo, hi); }
__device__ __forceinline__ float wave_sum(float v) {
#pragma unroll
    for (int o = 1; o < 64; o <<= 1) v += __shfl_xor(v, o);
    return v;
}
using pg8::silu_f; using pg8::sigmoid_f;
#define XB_TMO      128
#define XB_XCNT(j)  (256  + 64 * (j))
#define XB_XSUB(j)  (1280 + 64 * (j))
#define XB_XGEN(j)  (2304 + 64 * (j))
#define XB_TOP      3328
#define XB_TOPGEN   3392
#define XCD_BAR_WORDS 3456
#define XB_SPIN_CAP (1u << 18)

__device__ __forceinline__ unsigned xb_ld(unsigned* p)              { return __hip_atomic_load(p, __ATOMIC_RELAXED, __HIP_MEMORY_SCOPE_AGENT); }
__device__ __forceinline__ unsigned xb_add(unsigned* p, unsigned v) { return __hip_atomic_fetch_add(p, v, __ATOMIC_RELAXED, __HIP_MEMORY_SCOPE_AGENT); }
__device__ __forceinline__ unsigned xb_xcc_id() { return (unsigned)__builtin_amdgcn_s_getreg((3 << 11) | 20) & 0xFu; }
#define XB_SPIN(cond, bar) do { unsigned _sp = 0; while (cond) { __builtin_amdgcn_s_sleep(1); \
    if ((++_sp & 255u) == 0u) { if (xb_ld(&(bar)[XB_TMO])) break; if (_sp > XB_SPIN_CAP) { atomicAdd(&(bar)[XB_TMO], 1u); break; } } } } while (0)

struct XcdBarrier {
    unsigned* bar; unsigned x;
    volatile LAS unsigned* st;
};

__device__ __forceinline__ XcdBarrier xcd_barrier_post(unsigned* bar, volatile LAS unsigned* st) {
    XcdBarrier b; b.bar = bar; b.x = xb_xcc_id(); b.st = st;
    if (threadIdx.x == 0) (void)xb_add(&bar[XB_XCNT(b.x)], 1u);
    return b;
}
__device__ __forceinline__ void xcd_barrier_complete(unsigned* bar, unsigned x, unsigned& nloc, unsigned& nx) {
    const unsigned G = gridDim.x * gridDim.y * gridDim.z;
    unsigned sum, cnt, mine, sp = 0u;
    for (;;) {
        sum = 0u; cnt = 0u; mine = 0u;
#pragma unroll
        for (unsigned j = 0; j < 16; ++j) { const unsigned c = xb_ld(&bar[XB_XCNT(j)]); sum += c; cnt += (c > 0u) ? 1u : 0u; mine = (j == x) ? c : mine; }
        if (sum == G) break;
        __builtin_amdgcn_s_sleep(1);
        if ((++sp & 255u) == 0u) { if (xb_ld(&bar[XB_TMO])) break; if (sp > XB_SPIN_CAP) { atomicAdd(&bar[XB_TMO], 1u); break; } }
    }
    nloc = mine > 0u ? mine : 1u; nx = cnt > 0u ? cnt : 1u;
}

__device__ __forceinline__ void xcd_barrier(const XcdBarrier& b) {
    asm volatile("s_waitcnt vmcnt(0)" ::: "memory");
    __syncthreads();
    if (threadIdx.x == 0) {
        unsigned* bar = b.bar;
        __builtin_amdgcn_s_waitcnt(0);
        unsigned nloc = b.st[0], nx = b.st[1];
        if (nloc == 0u) { xcd_barrier_complete(bar, b.x, nloc, nx); b.st[0] = nloc; b.st[1] = nx; }
        const unsigned old = xb_add(&bar[XB_XSUB(b.x)], 1u);
        const unsigned gen = old / nloc;
        if (old + 1u == (gen + 1u) * nloc) {
            __builtin_amdgcn_fence(__ATOMIC_RELEASE, "agent");
            asm volatile("s_waitcnt vmcnt(0)" ::: "memory");
            const unsigned og = xb_add(&bar[XB_TOP], 1u);
            const unsigned tg = og / nx;
            if (og + 1u == (tg + 1u) * nx) xb_add(&bar[XB_TOPGEN], 1u);
            else XB_SPIN(xb_ld(&bar[XB_TOPGEN]) == tg, bar);
            __builtin_amdgcn_fence(__ATOMIC_ACQUIRE, "agent");
            xb_add(&bar[XB_XGEN(b.x)], 1u);
            asm volatile("s_waitcnt vmcnt(0)" ::: "memory");
        } else {
            XB_SPIN(xb_ld(&bar[XB_XGEN(b.x)]) == gen, bar);
            __builtin_amdgcn_fence(__ATOMIC_ACQUIRE, "agent");
            asm volatile("s_waitcnt vmcnt(0)" ::: "memory");
        }
    }
    __syncthreads();
}

struct Args { const float* in[31]; float* out; unsigned char* ws; int ph_lo, ph_hi; };
enum { I_XP = 0, I_XS, I_CK, I_CV, I_SHG, I_SLRU, I_C, I_CCTX, I_MODW, I_MODB, I_NORMG, I_F1UP, I_F1DN, I_F2UP, I_F2DN, I_WIN, I_LBL, I_HGN, I_RPB, I_CONVW, I_CONVB,
       I_LWA, I_LBA, I_LWX, I_LBX, I_LAM, I_PA, I_PB, I_PC, I_WOUT, I_FNG };
constexpr size_t OUT_Y = 0, OUT_K = 12582912, OUT_V = 20971520, OUT_SH = 29360128, OUT_SL = 33554432;

#ifndef PROBE_ZERO_YS
#define PROBE_ZERO_YS 0
#endif
#ifndef PROBE_ZERO_YP
#define PROBE_ZERO_YP 0
#endif
#ifndef CV_BACKGROUND
#define CV_BACKGROUND 0
#endif
struct Frame { LAS unsigned char* lds; int tid, lane, wave, G, gw, NGW; };
__device__ __forceinline__ int opq(int v) { asm volatile("" : "+v"(v)); return v; }

__device__ __forceinline__ int next_unit(gu32* head, volatile LAS unsigned* slot) {
    __syncthreads();
    if (threadIdx.x == 0) *slot = __hip_atomic_fetch_add(head, 1u, RLX_AGENT);
    __syncthreads();
    return (int)*slot;
}

__device__ __forceinline__ void cv_load(const float* W, int N, int k0, int n0, int lane, float (&v)[32]) {
#pragma unroll
    for (int i = 0; i < 32; ++i) v[i] = __builtin_nontemporal_load(W + (size_t)(k0 + 2 * i + (lane >> 5)) * N + n0 + (lane & 31));
}
__device__ __forceinline__ void cv_store(const float (&v)[32], int K, bf16* WT, int dst_row0, LAS float* scr, int k0, int lane) {
#pragma unroll
    for (int i = 0; i < 32; ++i) scr[(2 * i + (lane >> 5)) * 33 + (lane & 31)] = v[i];
    LDS_WAIT(); asm volatile("" ::: "memory");
    const int c = lane & 7;
#pragma unroll
    for (int j = 0; j < 4; ++j) { const int n = (lane >> 3) + 8 * j; const LAS float* s = scr + (8 * c) * 33 + n;
        v4u o; o.x = pk2(s[0 * 33], s[1 * 33]); o.y = pk2(s[2 * 33], s[3 * 33]); o.z = pk2(s[4 * 33], s[5 * 33]); o.w = pk2(s[6 * 33], s[7 * 33]);
        *(v4u*)(WT + (size_t)(dst_row0 + n) * K + k0 + 8 * c) = o; }
    LDS_WAIT(); asm volatile("" ::: "memory");
}
constexpr int CV_UP = 32 * 352, CV_DN = 88 * 64, CV_IN = 32 * 400, CV_A = 8 * 64, CV_B = 16 * 64, CV_O = 32 * 64, CV_PER_LAYER = 2 * CV_UP + 2 * CV_DN + CV_IN + 2 * CV_A + CV_B + CV_O;
constexpr int CV_CLAIM = 16, CV_CPL = CV_PER_LAYER / CV_CLAIM, CV_NCLAIM = DEPTH * CV_CPL, CV_STATIC = CV_UP / CV_CLAIM;
static_assert(CV_PER_LAYER % CV_CLAIM == 0 && CV_UP % CV_CLAIM == 0, "claims");
__device__ __forceinline__ int cv_need(int l, int j) {
    constexpr int T_DN1 = (CV_UP + CV_DN) / CV_CLAIM, T_IN = T_DN1 + CV_IN / CV_CLAIM, T_MRG = T_IN + (2 * CV_A + CV_B) / CV_CLAIM, T_OUT = T_MRG + CV_O / CV_CLAIM, T_UP2 = T_OUT + CV_UP / CV_CLAIM, T_DN2 = T_UP2 + CV_DN / CV_CLAIM;
    const int r = j == 0 ? T_DN1 : j <= 2 ? T_IN : j <= 5 ? T_MRG : j == 6 ? T_OUT : j <= 8 ? T_UP2 : j == 9 ? T_DN2 : T_DN2 + CV_STATIC;
    const int n = l * CV_CPL + r; return n < CV_NCLAIM ? n : CV_NCLAIM;
}
struct CvItem { const float* W; bf16* WT; int K, N, k0, n0, drow; };
__device__ __forceinline__ CvItem cv_decode(const Args& A, int it) {
    const int l = it / CV_PER_LAYER; int r = it % CV_PER_LAYER;
    unsigned char* wl = A.ws + WS_W + (size_t)l * W_LAYER;
    const float* W; int K, N; bf16* WT; int up = 0;
    if (r < CV_UP) { W = A.in[I_F1UP] + (size_t)l * DM * 2 * DFF; K = DM; N = 2 * DFF; WT = (bf16*)(wl + WO_UP1); up = 1; }
    else if ((r -= CV_UP) < CV_DN) { W = A.in[I_F1DN] + (size_t)l * DFF * DM; K = DFF; N = DM; WT = (bf16*)(wl + WO_DN1); }
    else if ((r -= CV_DN) < CV_IN) { W = A.in[I_WIN] + (size_t)l * DM * DIN; K = DM; N = DIN; WT = (bf16*)(wl + WO_IN); }
    else if ((r -= CV_IN) < CV_A) { W = A.in[I_PA] + (size_t)l * 512 * DM; K = 512; N = DM; WT = (bf16*)(wl + WO_PA); }
    else if ((r -= CV_A) < CV_B) { W = A.in[I_PB] + (size_t)l * 1024 * DM; K = 1024; N = DM; WT = (bf16*)(wl + WO_PB); }
    else if ((r -= CV_B) < CV_A) { W = A.in[I_PC] + (size_t)l * 512 * DM; K = 512; N = DM; WT = (bf16*)(wl + WO_PC); }
    else if ((r -= CV_A) < CV_O) { W = A.in[I_WOUT] + (size_t)l * DM * DM; K = DM; N = DM; WT = (bf16*)(wl + WO_OUT); }
    else if ((r -= CV_O) < CV_UP) { W = A.in[I_F2UP] + (size_t)l * DM * 2 * DFF; K = DM; N = 2 * DFF; WT = (bf16*)(wl + WO_UP2); up = 1; }
    else { r -= CV_UP; W = A.in[I_F2DN] + (size_t)l * DFF * DM; K = DFF; N = DM; WT = (bf16*)(wl + WO_DN2); }
    const int nblk = N / 32, kb = r / nblk, nb = r % nblk, n0 = 32 * nb;
    int drow = n0;
    if (up) { const int j0 = n0 < DFF ? n0 : n0 - DFF; drow = 256 * (j0 >> 7) + (j0 & 127) + (n0 < DFF ? 0 : 128); }
    CvItem c; c.W = W; c.WT = WT; c.K = K; c.N = N; c.k0 = 64 * kb; c.n0 = n0; c.drow = drow; return c;
}
__device__ __forceinline__ void p0_convert(const Frame& F_, const Args& A) {
    Frame F = F_; F.tid = opq(F_.tid); F.lane = F.tid & 63;
    LAS float* scr = (LAS float*)(F.lds + F.wave * 16384);
    for (int it = F.gw; it < (CV_BACKGROUND ? CV_UP : DEPTH * CV_PER_LAYER); it += F.NGW) { const CvItem c = cv_decode(A, it); float v[32]; cv_load(c.W, c.N, c.k0, c.n0, F.lane, v); cv_store(v, c.K, c.WT, c.drow, scr, c.k0, F.lane); }
}
__device__ __forceinline__ void cv_until(const Frame& F_, const Args& A, gu32* head, int need, gu32* fin, volatile LAS unsigned* slot) {
    Frame F = F_; F.tid = opq(F_.tid); F.lane = F.tid & 63;
    LAS float* scr = (LAS float*)(F.lds + F.wave * 16384);
    if (fin) { __syncthreads(); if (F.tid == 0) __hip_atomic_fetch_add(fin, 1u, RLX_AGENT); }
    for (;;) {
        __syncthreads();
        if (F.tid == 0) { const unsigned f = fin ? __hip_atomic_load(fin, RLX_AGENT) : 0xffffffffu, h = CV_STATIC + __hip_atomic_load(head, RLX_AGENT);
            slot[1] = f; slot[0] = (h >= (unsigned)need && f >= (unsigned)F.G) ? 0x7fffffffu : CV_STATIC + __hip_atomic_fetch_add(head, 1u, RLX_AGENT); }
        __syncthreads();
        const int c = (int)slot[0]; const bool others_done = slot[1] >= (unsigned)F.G;
        if (c >= CV_NCLAIM) break;
        { const CvItem c0 = cv_decode(A, c * CV_CLAIM + 2 * F.wave), c1 = cv_decode(A, c * CV_CLAIM + 2 * F.wave + 1); float v0[32], v1[32];
          cv_load(c0.W, c0.N, c0.k0, c0.n0, F.lane, v0); cv_load(c1.W, c1.N, c1.k0, c1.n0, F.lane, v1);
          cv_store(v0, c0.K, c0.WT, c0.drow, scr, c0.k0, F.lane); cv_store(v1, c1.K, c1.WT, c1.drow, scr, c1.k0, F.lane); }
        if (c >= need && others_done) break;
    }
}
__device__ __forceinline__ void p0_cache(const Frame& F_, const Args& A) {
    Frame F = F_; F.tid = opq(F_.tid); F.lane = F.tid & 63;
    const int gt = blockIdx.x * NTHREADS + F.tid, NT = F.G * NTHREADS;
    bf16* CKB = (bf16*)(A.ws + WS_CKB); bf16* CVT = (bf16*)(A.ws + WS_CVT);
    for (int i = gt; i < 2 * 2 * 512 * 1024 / 8; i += NT) { const float* p = A.in[I_CK] + (size_t)i * 8; const f32x4 a = *(const f32x4*)p, b = *(const f32x4*)(p + 4);
        v4u o; o.x = pk2(a.x, a.y); o.y = pk2(a.z, a.w); o.z = pk2(b.x, b.y); o.w = pk2(b.z, b.w); *(v4u*)(CKB + (size_t)i * 8) = o; }
    for (int i = gt; i < 2 * 2 * 64 * 1024; i += NT) {
        const int hd = i & 1023, jb = (i >> 10) & 63, bl = i >> 16; const float* p = A.in[I_CV] + ((size_t)(bl * 512 + jb * 8)) * 1024 + hd;
        v4u o; o.x = pk2(p[0], p[1024]); o.y = pk2(p[2048], p[3072]); o.z = pk2(p[4096], p[5120]); o.w = pk2(p[6144], p[7168]);
        *(v4u*)(CVT + ((size_t)(bl * 8 + (hd >> 7)) * 128 + (hd & 127)) * 512 + jb * 8) = o; }
}
__device__ __forceinline__ void p0_mods_partial(const Frame& F_, const Args& A) {
    Frame F = F_; F.tid = opq(F_.tid); F.lane = F.tid & 63;
    float* MODP = (float*)(A.ws + WS_MODP);
    const float* cc = A.in[I_CCTX]; const float* c1 = A.in[I_C];
    for (int task = F.gw; task < 2 * 32 * 72; task += F.NGW) {
        const int l = task / 2304, r = task % 2304, kc = r / 72, nb = r % 72, n = nb * 256 + F.lane * 4;
        const float* w = A.in[I_MODW] + ((size_t)l * DM + kc * 64) * 18432 + n;
        f32x4 a0 = {0.f, 0.f, 0.f, 0.f}, a1 = a0, a2 = a0;
#pragma unroll 16
        for (int k = 0; k < 64; ++k) { const f32x4 wv = __builtin_nontemporal_load((const f32x4*)(w + (size_t)k * 18432)); const int kk = kc * 64 + k;
            const float s0 = silu_f(cc[kk]), s1 = silu_f(c1[kk]), s2 = silu_f(c1[DM + kk]);
            a0 += wv * s0; a1 += wv * s1; a2 += wv * s2; }
        float* o = MODP + (size_t)kc * 110592 + (size_t)l * 55296 + n;
        *(f32x4*)(o) = a0; *(f32x4*)(o + 18432) = a1; *(f32x4*)(o + 2 * 18432) = a2;
    }
}
__device__ __forceinline__ void p0_mods_reduce(const Frame& F_, const Args& A) {
    Frame F = F_; F.tid = opq(F_.tid); F.lane = F.tid & 63;
    const float* MODP = (const float*)(A.ws + WS_MODP); float* MODS = (float*)(A.ws + WS_MODS);
    for (int idx = blockIdx.x * NTHREADS + F.tid; idx < 110592; idx += F.G * NTHREADS) {
        const int l = idx / 55296, n = idx % 18432; float s = A.in[I_MODB][l * 18432 + n];
#pragma unroll 8
        for (int kc = 0; kc < 32; ++kc) s += MODP[(size_t)kc * 110592 + idx];
        MODS[idx] = s;
    }
}
template <int MODE>
__device__ __forceinline__ void norm_rows(const Frame& F_, const float* x0, const float* x1, float* xcopy, const float* g, const float* mods_l, int slot, bf16* H, float* outf) {
    Frame F = F_; F.tid = opq(F_.tid); F.lane = F.tid & 63;
    for (int row = F.gw; row < MTOK; row += F.NGW) {
        const float* xr = row < NCTX ? x0 + (size_t)row * DM : x1 + (size_t)(row - NCTX) * DM;
        const int cidx = row < NCTX ? 0 : 1 + ((row - NCTX) >> 10);
        f32x4 v[8]; float ss = 0.f;
#pragma unroll
        for (int j = 0; j < 8; ++j) { v[j] = *(const f32x4*)(xr + 4 * F.lane + 256 * j); ss += (v[j].x * v[j].x + v[j].y * v[j].y) + (v[j].z * v[j].z + v[j].w * v[j].w); }
        const float rstd = 1.0f / sqrtf(wave_sum(ss) * (1.0f / DM) + 1e-6f);
        if (MODE == 0) {
            const float* sh = mods_l + (size_t)(cidx * 9 + 3 * slot) * DM; const float* sc = sh + DM;
#pragma unroll
            for (int j = 0; j < 8; ++j) { const int c = 4 * F.lane + 256 * j; const f32x4 gg = *(const f32x4*)(g + c), s1 = *(const f32x4*)(sc + c), s0 = *(const f32x4*)(sh + c);
                const f32x4 y = v[j] * rstd * gg * (s1 + 1.0f) + s0; v2u o; o.x = pk2(y.x, y.y); o.y = pk2(y.z, y.w);
                *(v2u*)(H + (size_t)row * DM + c) = o;
                if (xcopy) *(f32x4*)(xcopy + (size_t)row * DM + c) = v[j]; }
        } else {
#pragma unroll
            for (int j = 0; j < 8; ++j) { const int c = 4 * F.lane + 256 * j; const f32x4 gg = *(const f32x4*)(g + c);
                f32x4 yv = v[j] * rstd * gg;
#if PROBE_ZERO_YS
                if (row >= NCTX) yv = (f32x4){0.f, 0.f, 0.f, 0.f};
#endif
#if PROBE_ZERO_YP
                if (row < NCTX) yv = (f32x4){0.f, 0.f, 0.f, 0.f};
#endif
                *(f32x4*)(outf + (size_t)row * DM + c) = yv; }
        }
    }
}

constexpr int AK_STRIDE = 272, AV_STRIDE = 528, A_K_OFF = 0, A_V_OFF = 69632;
constexpr float NA_SCALE = 0.08838834764831845f;
__device__ __forceinline__ void attn_stage(LAS unsigned char* lds, int tid, const bf16* kbase, size_t kstride, const bf16* vbase, size_t vstride) {
    v4u kx[8], vx[8];
#pragma unroll
    for (int i = 0; i < 8; ++i) { const int idx = tid + 512 * i; kx[i] = *(const v4u*)(kbase + (size_t)(idx >> 4) * kstride + (idx & 15) * 8); }
#pragma unroll
    for (int i = 0; i < 8; ++i) { const int idx = tid + 512 * i; vx[i] = *(const v4u*)(vbase + (size_t)(idx >> 5) * vstride + (idx & 31) * 8); }
#pragma unroll
    for (int i = 0; i < 8; ++i) { const int idx = tid + 512 * i; *(LAS v4u*)(lds + A_K_OFF + (idx >> 4) * AK_STRIDE + (idx & 15) * 16) = kx[i]; }
#pragma unroll
    for (int i = 0; i < 8; ++i) { const int idx = tid + 512 * i; *(LAS v4u*)(lds + A_V_OFF + (idx >> 5) * AV_STRIDE + (idx & 31) * 16) = vx[i]; }
}
template <class KF, class VF>
__device__ __forceinline__ void attn_stage32(LAS unsigned char* lds, int tid, KF kf, VF vf) {
    { const int key = tid >> 1, half = tid & 1; const float* p = kf(key) + 64 * half; LAS unsigned char* dst = lds + A_K_OFF + key * AK_STRIDE + half * 128;
#pragma unroll
      for (int i = 0; i < 8; ++i) { const f32x4 a = *(const f32x4*)(p + 8 * i), b = *(const f32x4*)(p + 8 * i + 4);
          v4u o; o.x = pk2(a.x, a.y); o.y = pk2(a.z, a.w); o.z = pk2(b.x, b.y); o.w = pk2(b.z, b.w); *(LAS v4u*)(dst + 16 * i) = o; } }
    { const int kp = tid >> 2, dq = tid & 3; const float* p0 = vf(2 * kp) + 32 * dq; const float* p1 = vf(2 * kp + 1) + 32 * dq;
#pragma unroll
      for (int i = 0; i < 8; ++i) { const f32x4 a = *(const f32x4*)(p0 + 4 * i), b = *(const f32x4*)(p1 + 4 * i);
#pragma unroll
          for (int j = 0; j < 4; ++j) *(LAS unsigned*)(lds + A_V_OFF + (32 * dq + 4 * i + j) * AV_STRIDE + kp * 4) = pk2(a[j], b[j]); } }
}
__device__ __forceinline__ void attn_load_q32(const float* qrow, int g, bf16x8 (&qf)[4]) {
#pragma unroll
    for (int s = 0; s < 4; ++s) { const f32x4 a = *(const f32x4*)(qrow + 32 * s + 8 * g), b = *(const f32x4*)(qrow + 32 * s + 8 * g + 4);
        v4u o; o.x = pk2(a.x, a.y); o.y = pk2(a.z, a.w); o.z = pk2(b.x, b.y); o.w = pk2(b.z, b.w); qf[s] = __builtin_bit_cast(bf16x8, o); }
}
struct AttnState { float m, l; f32x4 ot[8]; };
template <int NKS, bool LOCAL, class BF>
__device__ __forceinline__ void attn_chunk(LAS unsigned char* lds, const bf16x8 (&qf)[4], AttnState& st, int lane, int t0, BF bias) {
    const int g = lane >> 4, c = lane & 15;
    f32x4 sc[NKS][2];
#pragma unroll
    for (int i = 0; i < NKS; ++i) { const int T0 = LOCAL ? 4 * i + t0 : 2 * i;
#pragma unroll
        for (int a = 0; a < 2; ++a) { f32x4 acc = {0.f, 0.f, 0.f, 0.f};
#pragma unroll
            for (int s = 0; s < 4; ++s) { const bf16x8 kfr = *(const LAS bf16x8*)(lds + A_K_OFF + (16 * (T0 + a) + c) * AK_STRIDE + 64 * s + 16 * g);
                acc = __builtin_amdgcn_mfma_f32_16x16x32_bf16(kfr, qf[s], acc, 0, 0, 0); }
            sc[i][a] = acc; } }
    float mx = -3.0e38f;
#pragma unroll
    for (int i = 0; i < NKS; ++i) { const int T0 = LOCAL ? 4 * i + t0 : 2 * i;
#pragma unroll
        for (int a = 0; a < 2; ++a)
#pragma unroll
            for (int r = 0; r < 4; ++r) { float s = sc[i][a][r] * NA_SCALE; if (LOCAL) s = bias(16 * (T0 + a) + 4 * g + r, s); sc[i][a][r] = s; mx = fmaxf(mx, s); } }
    mx = fmaxf(mx, __shfl_xor(mx, 16)); mx = fmaxf(mx, __shfl_xor(mx, 32));
    const float mnew = fmaxf(st.m, mx), alpha = __expf(st.m - mnew); float sum = 0.f;
#pragma unroll
    for (int i = 0; i < NKS; ++i)
#pragma unroll
        for (int a = 0; a < 2; ++a)
#pragma unroll
            for (int r = 0; r < 4; ++r) { const float p = __expf(sc[i][a][r] - mnew); sc[i][a][r] = p; sum += p; }
    sum += __shfl_xor(sum, 16); sum += __shfl_xor(sum, 32);
    st.l = st.l * alpha + sum; st.m = mnew;
#pragma unroll
    for (int dt = 0; dt < 8; ++dt) st.ot[dt] = st.ot[dt] * alpha;
#pragma unroll
    for (int i = 0; i < NKS; ++i) { const int T0 = LOCAL ? 4 * i + t0 : 2 * i;
        v4u pb; pb.x = pk2(sc[i][0][0], sc[i][0][1]); pb.y = pk2(sc[i][0][2], sc[i][0][3]); pb.z = pk2(sc[i][1][0], sc[i][1][1]); pb.w = pk2(sc[i][1][2], sc[i][1][3]);
        const bf16x8 pfr = __builtin_bit_cast(bf16x8, pb);
#pragma unroll
        for (int dt = 0; dt < 8; ++dt) { const LAS unsigned char* vp = lds + A_V_OFF + (16 * dt + c) * AV_STRIDE + (16 * T0 + 4 * g) * 2;
            const v2u lo = *(const LAS v2u*)vp, hi = *(const LAS v2u*)(vp + 32); v4u av; av.x = lo.x; av.y = lo.y; av.z = hi.x; av.w = hi.y;
            st.ot[dt] = __builtin_amdgcn_mfma_f32_16x16x32_bf16(__builtin_bit_cast(bf16x8, av), pfr, st.ot[dt], 0, 0, 0); } }
}
__device__ __forceinline__ void attn_load_q(const bf16* qrow, int g, bf16x8 (&qf)[4]) {
#pragma unroll
    for (int s = 0; s < 4; ++s) qf[s] = *(const bf16x8*)(qrow + 32 * s + 8 * g);
}
__device__ __forceinline__ void attn_store(const AttnState& st, bf16* orow, int g) {
    const float inv = 1.0f / st.l;
#pragma unroll
    for (int dt = 0; dt < 8; ++dt) { v2u o; o.x = pk2(st.ot[dt][0] * inv, st.ot[dt][1] * inv); o.y = pk2(st.ot[dt][2] * inv, st.ot[dt][3] * inv); *(v2u*)(orow + 16 * dt + 4 * g) = o; }
}
__device__ __forceinline__ void attn_ctx_unit(const Frame& F_, const Args& A, int u) {
    Frame F = F_; F.tid = opq(F_.tid); F.lane = F.tid & 63;
    const int b = u >> 4, h = (u >> 1) & 7, qh = u & 1, g = F.lane >> 4, c = F.lane & 15;
    const bf16* QB = (const bf16*)(A.ws + WS_QB); const bf16* KB = (const bf16*)(A.ws + WS_KB); const bf16* VT = (const bf16*)(A.ws + WS_VT);
    const int row = b * SEQ + qh * 128 + 16 * F.wave + c;
    bf16x8 qf[4];
#if PROBE_QKV32
    { const float* Z3 = (const float*)(A.ws + 736 * MiB); const float* zb = Z3 + (size_t)(b * SEQ) * 3072 + h * 128;
      attn_stage32(F.lds, F.tid, [&](int k) { return zb + (size_t)k * 3072 + 1024; }, [&](int k) { return zb + (size_t)k * 3072 + 2048; });
      attn_load_q32(Z3 + (size_t)row * 3072 + h * 128, g, qf); }
#else
    attn_stage(F.lds, F.tid, KB + (size_t)(b * SEQ) * 1024 + h * 128, 1024, VT + (size_t)(b * 8 + h) * 128 * 256, 256);
    attn_load_q(QB + (size_t)row * 1024 + h * 128, g, qf);
#endif
    AttnState st; st.m = -3.0e38f; st.l = 0.f;
#pragma unroll
    for (int dt = 0; dt < 8; ++dt) st.ot[dt] = (f32x4){0.f, 0.f, 0.f, 0.f};
    __syncthreads();
    attn_chunk<8, false>(F.lds, qf, st, F.lane, 0, [](int, float s) { return s; });
    attn_store(st, (bf16*)(A.ws + WS_OB) + (size_t)row * 1024 + h * 128, g);
}
__device__ __forceinline__ void attn_na_unit(const Frame& F_, const Args& A, int u, int layer) {
    Frame F = F_; F.tid = opq(F_.tid); F.lane = F.tid & 63;
    const int b = u >> 7, h = (u >> 4) & 7, r = u & 15, g = F.lane >> 4, c = F.lane & 15, w = F.wave;
    const bf16* QB = (const bf16*)(A.ws + WS_QB); const bf16* KB = (const bf16*)(A.ws + WS_KB); const bf16* VT = (const bf16*)(A.ws + WS_VT);
    const int kr0 = min(max(r - 4, 0), 8);
    const int qc = 8 * w + (c & 7), row = NCTX + b * DSEQ + r * 64 + qc;
    const int wstart = min(max(qc - 8, 0), 48), t0 = min(max(8 * w - 8, 0), 40) >> 4;
    const float* rpb = A.in[I_RPB] + (size_t)(layer * 8 + h) * 15 * 31;
    bf16x8 qf[4];
#if PROBE_QKV32
    attn_load_q32((const float*)(A.ws + 736 * MiB) + (size_t)row * 3072 + h * 128, g, qf);
#else
    attn_load_q(QB + (size_t)row * 1024 + h * 128, g, qf);
#endif
    AttnState st; st.m = -3.0e38f; st.l = 0.f;
#pragma unroll
    for (int dt = 0; dt < 8; ++dt) st.ot[dt] = (f32x4){0.f, 0.f, 0.f, 0.f};
#if PROBE_QKV32
    const float* Z3 = (const float*)(A.ws + 736 * MiB); const float* zl = Z3 + (size_t)(NCTX + b * DSEQ) * 3072 + h * 128;
    for (int ci = 0; ci < 2; ++ci) {
        const int krow = kr0 + 4 * ci;
        if (ci) __syncthreads();
        attn_stage32(F.lds, F.tid, [&](int k) { return zl + (size_t)(krow * 64 + k) * 3072 + 1024; }, [&](int k) { return zl + (size_t)(krow * 64 + k) * 3072 + 2048; });
        __syncthreads();
        attn_chunk<4, true>(F.lds, qf, st, F.lane, t0, [&](int kk, float s) {
            const int ky = krow + (kk >> 6), kx = kk & 63; const bool ok = kx >= wstart && kx < wstart + 16;
            const int dy = ky - r + 7, dx = min(max(kx - qc + 15, 0), 30);
            return ok ? s + rpb[dy * 31 + dx] : -1.0e30f; });
    }
    const float* ck = A.in[I_CK] + ((size_t)(b * 2 + layer) * 512 * 8 + h) * 128; const float* cv = A.in[I_CV] + ((size_t)(b * 2 + layer) * 512 * 8 + h) * 128;
    for (int ci = 0; ci < 2; ++ci) {
        __syncthreads();
        attn_stage32(F.lds, F.tid, [&](int k) { return ck + (size_t)(ci * 256 + k) * 1024; }, [&](int k) { return cv + (size_t)(ci * 256 + k) * 1024; });
        __syncthreads();
        attn_chunk<8, false>(F.lds, qf, st, F.lane, 0, [](int, float s) { return s; });
    }
#else
    const bf16* kl = KB + (size_t)(NCTX + b * DSEQ) * 1024 + h * 128; const bf16* vl = VT + (size_t)4096 * 1024 + (size_t)(b * 8 + h) * 128 * 1024;
    for (int ci = 0; ci < 2; ++ci) {
        const int krow = kr0 + 4 * ci;
        if (ci) __syncthreads();
        attn_stage(F.lds, F.tid, kl + (size_t)(krow * 64) * 1024, 1024, vl + krow * 64, 1024);
        __syncthreads();
        attn_chunk<4, true>(F.lds, qf, st, F.lane, t0, [&](int kk, float s) {
            const int ky = krow + (kk >> 6), kx = kk & 63; const bool ok = kx >= wstart && kx < wstart + 16;
            const int dy = ky - r + 7, dx = min(max(kx - qc + 15, 0), 30);
            return ok ? s + rpb[dy * 31 + dx] : -1.0e30f; });
    }
    const bf16* ck = (const bf16*)(A.ws + WS_CKB) + (size_t)(b * 2 + layer) * 512 * 1024 + h * 128; const bf16* cv = (const bf16*)(A.ws + WS_CVT) + (size_t)((b * 2 + layer) * 8 + h) * 128 * 512;
    for (int ci = 0; ci < 2; ++ci) {
        __syncthreads();
        attn_stage(F.lds, F.tid, ck + (size_t)(ci * 256) * 1024, 1024, cv + ci * 256, 512);
        __syncthreads();
        attn_chunk<8, false>(F.lds, qf, st, F.lane, 0, [](int, float s) { return s; });
    }
#endif
    if (c < 8) attn_store(st, (bf16*)(A.ws + WS_OB) + (size_t)row * 1024 + h * 128, g);
}

__device__ __forceinline__ int hg_slot(int s, int h, int dir, int c) { return s < 16 ? s * 32 + c * 8 + h * 2 + dir : 512 + (s - 16) * 128 + c * 8 + h * 2 + dir; }
template <int CTRL> __device__ __forceinline__ float dpp_xor(float v) { return __builtin_bit_cast(float, __builtin_amdgcn_update_dpp(0, __builtin_bit_cast(int, v), CTRL, 0xf, 0xf, true)); }
__device__ __forceinline__ void hgrn_local_unit(const Frame& F_, const Args& A, int u, int layer) {
    Frame F = F_; F.tid = opq(F_.tid); F.lane = F.tid & 63;
    int s, c, hd;
    if (u < 512) { s = u >> 5; c = (u >> 3) & 3; hd = u & 7; } else { const int v = u - 512; s = 16 + (v >> 7); c = (v >> 3) & 15; hd = v & 7; }
    const int h = hd >> 1, dir = hd & 1, tokbase = s < 16 ? s * SEQ : NCTX + (s - 16) * DSEQ, g = F.lane >> 4, c15 = F.lane & 15, w = F.wave;
    const float* Z = (const float*)(A.ws + WS_ZF);
    constexpr int LS = 132, AS = 68;
    LAS float* Qt = (LAS float*)F.lds; LAS float* Kt = Qt + 64 * LS; LAS float* Vs = Kt + 64 * LS; LAS float* Bs = Vs + 64 * LS; LAS float* SC = Bs + 64 * LS; LAS float* As = Bs;
    const int d = F.tid & 127, I4 = F.tid >> 7;
    {   float lbv = 0.f;
        if (layer == 1) { const float* lg = A.in[I_LBL]; lbv = sigmoid_f(lg[1024 + dir * 512 + h * 128 + d] - lg[dir * 512 + h * 128 + d]); }
        float zq[16], zf[16], zv[16];
#pragma unroll
        for (int k = 0; k < 16; ++k) { const int i = 16 * I4 + k, t = dir ? 64 * c + 63 - i : 64 * c + i; const float* zr = Z + (size_t)(tokbase + t) * ZFW + h * 128 + d;
            zq[k] = zr[ZQ]; zf[k] = zr[dir ? ZFB : ZFF]; zv[k] = zr[ZI]; }
        float b = 0.f;
#pragma unroll
        for (int k = 0; k < 16; ++k) { const int i = 16 * I4 + k; const float f = lbv + (1.f - lbv) * sigmoid_f(zf[k]);
            b += __logf(fmaxf(f, 1e-30f));
            Qt[i * LS + d] = silu_f(zq[k]); Kt[i * LS + d] = (1.f - lbv) * sigmoid_f(-zf[k]); Vs[i * LS + d] = zv[k]; Bs[i * LS + d] = b; }
    }
    __syncthreads();
    {
        float* QD = (float*)(A.ws + WS_HQD);
        const float t0 = Bs[15 * LS + d], t1 = Bs[31 * LS + d], t2 = Bs[47 * LS + d], t3 = Bs[63 * LS + d];
        const float bsI = I4 == 0 ? 0.f : I4 == 1 ? t0 : I4 == 2 ? t0 + t1 : t0 + t1 + t2, totI = I4 == 0 ? t0 : I4 == 1 ? t1 : I4 == 2 ? t2 : t3;
#pragma unroll
        for (int k = 0; k < 16; ++k) { const int i = 16 * I4 + k, t = dir ? 64 * c + 63 - i : 64 * c + i;
            const float bl = Bs[i * LS + d], q = Qt[i * LS + d], kk = Kt[i * LS + d], e1 = __expf(bl);
            QD[((size_t)(tokbase + t) * 2 + dir) * 512 + h * 128 + d] = q * e1 * __expf(bsI);
            Qt[i * LS + d] = q * e1; Kt[i * LS + d] = kk * __expf(totI - bl); }
        for (int idx = F.tid; idx < 14 * 128; idx += NTHREADS) { const int v = idx >> 7, dd = idx & 127;
            const float u0 = Bs[15 * LS + dd], u1 = Bs[31 * LS + dd], u2 = Bs[47 * LS + dd], u3 = Bs[63 * LS + dd];
            float x;
            if (v < 6) x = v == 0 ? 0.f : v == 1 ? u1 : v == 2 ? 0.f : v == 3 ? u1 + u2 : v == 4 ? u2 : 0.f;
            else if (v < 10) x = -(v == 6 ? u0 : v == 7 ? u1 : v == 8 ? u2 : u3);
            else x = v == 10 ? u1 + u2 + u3 : v == 11 ? u2 + u3 : v == 12 ? u3 : 0.f;
            SC[idx] = __expf(x);
            if (v == 13) ((float*)(A.ws + WS_HDEC))[(size_t)u * 128 + dd] = __expf(u0 + u1 + u2 + u3); }
    }
    __syncthreads();
    {
        float av[16];
#pragma unroll
        for (int ks = 0; ks < 16; ++ks) { const int j = 4 * ks + g; av[ks] = Kt[j * LS + 16 * w + c15] * SC[(10 + (j >> 4)) * 128 + 16 * w + c15]; }
        float* SL = (float*)(A.ws + WS_HSL) + (size_t)u * 16384;
        for (int et = 0; et < 8; ++et) { f32x4 acc = {0.f, 0.f, 0.f, 0.f};
#pragma unroll
            for (int ks = 0; ks < 16; ++ks) acc = __builtin_amdgcn_mfma_f32_16x16x4f32(av[ks], Vs[(4 * ks + g) * LS + 16 * et + c15], acc, 0, 0, 0);
#pragma unroll
            for (int r = 0; r < 4; ++r) SL[(16 * w + 4 * g + r) * 128 + 16 * et + c15] = acc[r]; }
    }
    for (int tl = w; tl < 10; tl += 8) {
        int I, J, sv;
        if (tl < 4) { I = tl; J = tl; sv = 6 + tl; } else { const int v = tl - 4; I = v < 1 ? 1 : (v < 3 ? 2 : 3); J = v < 1 ? 0 : (v < 3 ? v - 1 : v - 3); sv = v; }
        f32x4 acc = {0.f, 0.f, 0.f, 0.f};
#pragma unroll 8
        for (int ks = 0; ks < 32; ++ks) { const int dd = 4 * ks + g;
            acc = __builtin_amdgcn_mfma_f32_16x16x4f32(Qt[(16 * I + c15) * LS + dd] * SC[sv * 128 + dd], Kt[(16 * J + c15) * LS + dd], acc, 0, 0, 0); }
#pragma unroll
        for (int r = 0; r < 4; ++r) As[(16 * I + 4 * g + r) * AS + 16 * J + c15] = (I == J && c15 > 4 * g + r) ? 0.f : acc[r];
    }
    __syncthreads();
    {   float* OL = (float*)(A.ws + WS_HOL);
#pragma unroll
        for (int I = 0; I < 4; ++I) { f32x4 acc = {0.f, 0.f, 0.f, 0.f};
            for (int ks = 0; ks < 4 * (I + 1); ++ks) acc = __builtin_amdgcn_mfma_f32_16x16x4f32(As[(16 * I + c15) * AS + 4 * ks + g], Vs[(4 * ks + g) * LS + 16 * w + c15], acc, 0, 0, 0);
#pragma unroll
            for (int r = 0; r < 4; ++r) { const int i = 16 * I + 4 * g + r, t = dir ? 64 * c + 63 - i : 64 * c + i; OL[((size_t)(tokbase + t) * 2 + dir) * 512 + h * 128 + 16 * w + c15] = acc[r]; } }
    }
}
__device__ __forceinline__ void hgrn_final_unit(const Frame& F_, const Args& A, int u, int layer) {
    Frame F = F_; F.tid = opq(F_.tid); F.lane = F.tid & 63;
    int s, c, h, nC;
    if (u < 128) { s = 16 + (u >> 6); c = (u >> 2) & 15; h = u & 3; nC = 16; } else { const int v = u - 128; s = v >> 4; c = (v >> 2) & 3; h = v & 3; nC = 4; }
    const int tokbase = s < 16 ? s * SEQ : NCTX + (s - 16) * DSEQ, g = F.lane >> 4, c15 = F.lane & 15, w = F.wave;
    constexpr int LS = 132;
    LAS float* Ss = (LAS float*)F.lds; LAS float* Qd = Ss + 128 * LS; LAS float* Os = Qd + 64 * LS;
    const float* HSL = (const float*)(A.ws + WS_HSL); const float* HDEC = (const float*)(A.ws + WS_HDEC); const float* QD = (const float*)(A.ws + WS_HQD);
    f32x4 acc[4];
#pragma unroll
    for (int tt = 0; tt < 4; ++tt) acc[tt] = (f32x4){0.f, 0.f, 0.f, 0.f};
    for (int dir = 0; dir < 2; ++dir) {
        f32x4 S[8];
        if (s >= 16) { const float* s0 = A.in[I_SHG] + ((size_t)(((s - 16) * 2 + layer) * 2 + dir) * 4 + h) * 16384;
#pragma unroll
            for (int j = 0; j < 8; ++j) S[j] = *(const f32x4*)(s0 + 4 * (F.tid + 512 * j)); }
        else {
#pragma unroll
            for (int j = 0; j < 8; ++j) S[j] = (f32x4){0.f, 0.f, 0.f, 0.f}; }
        const int nprev = dir ? nC - 1 - c : c;
        if (nprev > 0) {
            f32x4 cur[8]; float dcur[8];
            { const int sl = hg_slot(s, h, dir, dir ? nC - 1 : 0);
#pragma unroll
              for (int j = 0; j < 8; ++j) { const int idx4 = F.tid + 512 * j; dcur[j] = HDEC[(size_t)sl * 128 + (idx4 >> 5)]; cur[j] = *(const f32x4*)(HSL + (size_t)sl * 16384 + 4 * idx4); } }
            for (int q = 0; q < nprev; ++q) {
                f32x4 nxt[8]; float dnx[8];
                const int qn = q + 1 < nprev ? q + 1 : q, sl = hg_slot(s, h, dir, dir ? nC - 1 - qn : qn);
#pragma unroll
                for (int j = 0; j < 8; ++j) { const int idx4 = F.tid + 512 * j; dnx[j] = HDEC[(size_t)sl * 128 + (idx4 >> 5)]; nxt[j] = *(const f32x4*)(HSL + (size_t)sl * 16384 + 4 * idx4); }
#pragma unroll
                for (int j = 0; j < 8; ++j) { S[j] = S[j] * dcur[j] + cur[j]; cur[j] = nxt[j]; dcur[j] = dnx[j]; }
            }
        }
        if (s < 16 && (dir ? c == 0 : c == nC - 1)) {
            const int sl = hg_slot(s, h, dir, c); float* so = A.out + OUT_SH + ((size_t)((s * 2 + layer) * 2 + dir) * 4 + h) * 16384;
#pragma unroll
            for (int j = 0; j < 8; ++j) { const int idx4 = F.tid + 512 * j; const float dc = HDEC[(size_t)sl * 128 + (idx4 >> 5)];
                *(f32x4*)(so + 4 * idx4) = S[j] * dc + *(const f32x4*)(HSL + (size_t)sl * 16384 + 4 * idx4); } }
        if (dir) __syncthreads();
#pragma unroll
        for (int j = 0; j < 8; ++j) { const int idx4 = F.tid + 512 * j; *(LAS f32x4*)(Ss + (idx4 >> 5) * LS + 4 * (idx4 & 31)) = S[j]; }
#pragma unroll
        for (int j = 0; j < 4; ++j) { const int idx4 = F.tid + 512 * j, i = idx4 >> 5;
            *(LAS f32x4*)(Qd + i * LS + 4 * (idx4 & 31)) = *(const f32x4*)(QD + ((size_t)(tokbase + 64 * c + i) * 2 + dir) * 512 + h * 128 + 4 * (idx4 & 31)); }
        __syncthreads();
        for (int ks = 0; ks < 32; ++ks) { const float bv = Ss[(4 * ks + g) * LS + 16 * w + c15];
#pragma unroll
            for (int tt = 0; tt < 4; ++tt) acc[tt] = __builtin_amdgcn_mfma_f32_16x16x4f32(Qd[(16 * tt + c15) * LS + 4 * ks + g], bv, acc[tt], 0, 0, 0); }
    }
    const float* OL = (const float*)(A.ws + WS_HOL);
#pragma unroll
    for (int tt = 0; tt < 4; ++tt)
#pragma unroll
        for (int r = 0; r < 4; ++r) { const int t = 16 * tt + 4 * g + r; const float* ol = OL + (size_t)(tokbase + 64 * c + t) * 1024 + h * 128 + 16 * w + c15;
            Os[t * LS + 16 * w + c15] = acc[tt][r] + ol[0] + ol[512]; }
    __syncthreads();
    {
        const int t = F.tid >> 3, seg = F.tid & 7; const size_t row = (size_t)(tokbase + 64 * c + t);
        f32x4 o[4]; float ss = 0.f;
#pragma unroll
        for (int j = 0; j < 4; ++j) { o[j] = *(const LAS f32x4*)(Os + t * LS + 16 * seg + 4 * j); ss += (o[j].x * o[j].x + o[j].y * o[j].y) + (o[j].z * o[j].z + o[j].w * o[j].w); }
        ss += __shfl_xor(ss, 1); ss += __shfl_xor(ss, 2); ss += __shfl_xor(ss, 4);
        const float rstd = 1.0f / sqrtf(ss * (1.0f / 128.f) + 1e-6f);
        const float* gn = A.in[I_HGN] + (size_t)(layer * 4 + h) * 128 + 16 * seg; const float* zo = (const float*)(A.ws + WS_ZF) + row * ZFW + ZO + h * 128 + 16 * seg;
        unsigned pk[8];
#pragma unroll
        for (int j = 0; j < 4; ++j) { const f32x4 gg = *(const f32x4*)(gn + 4 * j), zz = *(const f32x4*)(zo + 4 * j);
            pk[2 * j] = pk2(o[j].x * rstd * gg.x * silu_f(zz.x), o[j].y * rstd * gg.y * silu_f(zz.y)); pk[2 * j + 1] = pk2(o[j].z * rstd * gg.z * silu_f(zz.z), o[j].w * rstd * gg.w * silu_f(zz.w)); }
        bf16* oa = (bf16*)(A.ws + WS_OA) + row * 512 + h * 128 + 16 * seg;
        *(v4u*)oa = (v4u){pk[0], pk[1], pk[2], pk[3]}; *(v4u*)(oa + 8) = (v4u){pk[4], pk[5], pk[6], pk[7]};
    }
}

__device__ __forceinline__ float neg_expm1(float x) {
    return x > -0.03f ? -x * (1.f + x * (0.5f + x * (0.16666667f + x * 0.041666668f))) : 1.f - __expf(x);
}
__device__ __forceinline__ void lru_gate_unit(const Frame& F_, const Args& A, int u, int layer) {
    Frame F = F_; F.tid = opq(F_.tid); F.lane = F.tid & 63;
    const int k = u & 7, tt = (u >> 3) * 8 + F.wave, lane = F.lane, g = lane >> 4, c15 = lane & 15, r0 = 16 * tt;
    const int sstart = r0 < NCTX ? (r0 & ~255) : NCTX + ((r0 - NCTX) & ~1023), send = sstart + (r0 < NCTX ? SEQ : DSEQ);
    const float* Z = (const float*)(A.ws + WS_ZF);
    constexpr int WS_ = 68;
    LAS float* xs = (LAS float*)(F.lds + F.wave * 12544); LAS float* au = xs + 1088;
    LAS float* Wa = (LAS float*)(F.lds + 8 * 12544); LAS float* Wx = Wa + 64 * WS_;
    {   const int ch = 64 * k + lane; const float* cw = A.in[I_CONVW] + (size_t)layer * 4 * 512 + ch; const float w0 = cw[0], w1 = cw[512], w2 = cw[1024], w3 = cw[1536], cb = A.in[I_CONVB][layer * 512 + ch];
        float lx[19];
#pragma unroll
        for (int j = 0; j < 19; ++j) { const int row = r0 - 2 + j; lx[j] = (row >= sstart && row < send) ? Z[(size_t)row * ZFW + ZLX + ch] : 0.f; }
#pragma unroll
        for (int j = 0; j < 16; ++j) xs[j * 65 + lane] = cb + w0 * lx[j] + w1 * lx[j + 1] + w2 * lx[j + 2] + w3 * lx[j + 3]; }
    float* LHL = (float*)(A.ws + WS_LHL); float* LPP = (float*)(A.ws + WS_LPP);
    for (int dir = 0; dir < 2; ++dir) {
        if (dir) __syncthreads();
        {   const float* wsa = A.in[I_LWA] + (size_t)((layer * 2 + dir) * 8 + k) * 4096; const float* wsx = A.in[I_LWX] + (size_t)((layer * 2 + dir) * 8 + k) * 4096;
#pragma unroll
            for (int j = 0; j < 2; ++j) { const int r4 = F.tid + 512 * j;
                *(LAS f32x4*)(Wa + (r4 >> 4) * WS_ + 4 * (r4 & 15)) = *(const f32x4*)(wsa + 4 * r4); *(LAS f32x4*)(Wx + (r4 >> 4) * WS_ + 4 * (r4 & 15)) = *(const f32x4*)(wsx + 4 * r4); } }
        __syncthreads();
        f32x4 aa[4], ax[4];
#pragma unroll
        for (int jt = 0; jt < 4; ++jt) { aa[jt] = (f32x4){0.f, 0.f, 0.f, 0.f}; ax[jt] = aa[jt]; }
#pragma unroll 4
        for (int ks = 0; ks < 16; ++ks) { const float a = xs[c15 * 65 + 4 * ks + g];
#pragma unroll
            for (int jt = 0; jt < 4; ++jt) { const int wi = (4 * ks + g) * WS_ + 16 * jt + c15;
                aa[jt] = __builtin_amdgcn_mfma_f32_16x16x4f32(a, Wa[wi], aa[jt], 0, 0, 0); ax[jt] = __builtin_amdgcn_mfma_f32_16x16x4f32(a, Wx[wi], ax[jt], 0, 0, 0); } }
        const int pb = (layer * 2 + dir) * 512 + 64 * k;
#pragma unroll
        for (int jt = 0; jt < 4; ++jt) { const int chl = 16 * jt + c15; const float ba = A.in[I_LBA][pb + chl], bx = A.in[I_LBX][pb + chl], sp = log1pf(__expf(-A.in[I_LAM][pb + chl]));
#pragma unroll
            for (int r = 0; r < 4; ++r) { const int j = 4 * g + r; const float rg = sigmoid_f(aa[jt][r] + ba), ig = sigmoid_f(ax[jt][r] + bx);
                const float la = -8.0f * rg * sp, av = __expf(la), mult = __builtin_amdgcn_sqrtf(neg_expm1(2.0f * la)), uv = mult * ig * xs[j * 65 + chl];
                au[(j * 64 + chl) * 2] = av; au[(j * 64 + chl) * 2 + 1] = uv; } }
        LDS_WAIT(); asm volatile("" ::: "memory");
        float hh = 0.f, P = 1.f;
#pragma unroll
        for (int jj = 0; jj < 16; ++jj) { const int j = dir ? 15 - jj : jj; const float av = au[(j * 64 + lane) * 2], uv = au[(j * 64 + lane) * 2 + 1];
            hh = av * hh + uv; P *= av; const size_t o = ((size_t)(r0 + j) * 2 + dir) * 512 + 64 * k + lane; LHL[o] = hh; LPP[o] = P; }
        LDS_WAIT(); asm volatile("" ::: "memory");
    }
}
__device__ __forceinline__ float gelu_tanh(float x) { const float t = 0.7978845608028654f * (x + 0.044715f * x * x * x); return 0.5f * x * (1.0f + tanhf(t)); }
__device__ __forceinline__ void lru_final_unit(const Frame& F_, const Args& A, int tt, int layer) {
    Frame F = F_; F.tid = opq(F_.tid); F.lane = F.tid & 63;
    const int ch = F.tid, r0 = 16 * tt;
    const int s = r0 < NCTX ? r0 >> 8 : 16 + ((r0 - NCTX) >> 10), f0 = (r0 < NCTX ? (r0 & ~255) : NCTX + ((r0 - NCTX) & ~1023)) >> 4, nt = r0 < NCTX ? 16 : 64;
    const float* LHL = (const float*)(A.ws + WS_LHL); const float* LPP = (const float*)(A.ws + WS_LPP); const float* Z = (const float*)(A.ws + WS_ZF);
    float cf = 0.f, cb = 0.f;
    if (s >= 16) { const float* h0 = A.in[I_SLRU] + (size_t)((s - 16) * 2 + layer) * 1024; cf = h0[ch]; cb = h0[512 + ch]; }
    {   int j = f0;
        for (; j + 8 <= tt; j += 8) { float hv[8], pv[8];
#pragma unroll
            for (int q = 0; q < 8; ++q) { const size_t o = ((size_t)(16 * (j + q) + 15) * 2 + 0) * 512 + ch; hv[q] = LHL[o]; pv[q] = LPP[o]; }
#pragma unroll
            for (int q = 0; q < 8; ++q) cf = hv[q] + pv[q] * cf; }
        for (; j < tt; ++j) { const size_t o = ((size_t)(16 * j + 15) * 2 + 0) * 512 + ch; cf = LHL[o] + LPP[o] * cf; } }
    {   int j = f0 + nt - 1;
        for (; j - 8 >= tt; j -= 8) { float hv[8], pv[8];
#pragma unroll
            for (int q = 0; q < 8; ++q) { const size_t o = ((size_t)(16 * (j - q)) * 2 + 1) * 512 + ch; hv[q] = LHL[o]; pv[q] = LPP[o]; }
#pragma unroll
            for (int q = 0; q < 8; ++q) cb = hv[q] + pv[q] * cb; }
        for (; j > tt; --j) { const size_t o = ((size_t)(16 * j) * 2 + 1) * 512 + ch; cb = LHL[o] + LPP[o] * cb; } }
    bf16* OC = (bf16*)(A.ws + WS_OC);
#pragma unroll 4
    for (int i = 0; i < 16; ++i) { const size_t row = (size_t)(r0 + i), o0 = (row * 2) * 512 + ch, o1 = o0 + 512;
        const float hf = LHL[o0] + LPP[o0] * cf, hb = LHL[o1] + LPP[o1] * cb, y = (hf + hb) * gelu_tanh(Z[row * ZFW + ZLG + ch]);
        OC[row * 512 + ch] = (bf16)f2bf(y);
        if (s < 16) { if (i == 15 && tt == f0 + nt - 1) A.out[OUT_SL + (size_t)((s * 2 + layer) * 2 + 0) * 512 + ch] = hf;
                      if (i == 0 && tt == f0) A.out[OUT_SL + (size_t)((s * 2 + layer) * 2 + 1) * 512 + ch] = hb; } }
}

#ifndef DUP_P0C
#define DUP_P0C 0
#endif
#ifndef DUP_P0M
#define DUP_P0M 0
#endif
#ifndef DUP_H1
#define DUP_H1 0
#endif
#ifndef DUP_UP1
#define DUP_UP1 0
#endif
#ifndef DUP_NA
#define DUP_NA 0
#endif
#ifndef DUP_CA
#define DUP_CA 0
#endif
#ifndef DUP_L1
#define DUP_L1 0
#endif
#ifndef DUP_H3
#define DUP_H3 0
#endif
#ifndef DUP_L2
#define DUP_L2 0
#endif
#ifndef DUP_NORM
#define DUP_NORM 0
#endif
#ifndef PROBE_NOCACHE
#define PROBE_NOCACHE 0
#endif
#ifndef PROBE_MEMSET
#define PROBE_MEMSET 0
#endif
#ifndef MK_N_LAUNCHES
#define MK_N_LAUNCHES 1
#endif
constexpr int N_PHASES = 3 + 12 * DEPTH;
__global__ void __launch_bounds__(NTHREADS, 2) trunk_fwd(Args A) {
    extern __shared__ __attribute__((aligned(16))) unsigned char lds_raw[];
    Frame F; F.lds = (LAS unsigned char*)lds_raw; F.tid = threadIdx.x; F.lane = F.tid & 63; F.wave = __builtin_amdgcn_readfirstlane(F.tid >> 6);
    F.G = gridDim.x; F.gw = blockIdx.x * NWAVES + F.wave; F.NGW = F.G * NWAVES;
    volatile LAS unsigned* MISC = (volatile LAS unsigned*)(F.lds + LDSCTL_OFF);
    for (int u = F.tid; u < (LDS_BYTES - LDSCTL_OFF) / 4; u += NTHREADS) MISC[u] = 0u;
    __syncthreads();
    gu32* ctl = (gu32*)(A.ws + WS_CTL);
    XcdBarrier bar; bar.bar = (unsigned*)(ctl + CW_BAR); bar.x = 0; bar.st = nullptr;
    if (MK_N_LAUNCHES == 1) bar = xcd_barrier_post((unsigned*)(ctl + CW_BAR), MISC + 8);
    const int lo = A.ph_lo, hi = A.ph_hi;
#define IN(k) (lo <= (k) && (k) < hi)
#define SEAM(k) do { if (IN(k) && IN((k) + 1)) { XcdBarrier b2_ = bar; asm volatile("" : "+s"(b2_.bar)); xcd_barrier(b2_); } } while (0)
    gu32* cvq = ctl + CW_Q + 30 * 64;
#define CV_END(l_, j_, gemm_) do { if (CV_BACKGROUND && IN(3 + 12 * (l_) + (j_))) cv_until(F, A, cvq, cv_need((l_), (j_)), (gemm_) ? ctl + CW_Q + (32 + 12 * (l_) + (j_)) * 64 : (gu32*)nullptr, MISC + 20); } while (0)
    unsigned char* ws = A.ws;
    float* X = (float*)(ws + WS_X); bf16* H = (bf16*)(ws + WS_H); bf16* HID = (bf16*)(ws + WS_HID);
    float* MODS = (float*)(ws + WS_MODS);
    LAS unsigned char* ring = F.lds;

#ifndef NO_P0
    if (IN(0)) { p0_convert(F, A); p0_mods_partial(F, A);
#if !PROBE_NOCACHE
        p0_cache(F, A);
#endif
    }
#if DUP_P0C
    if (IN(0)) { __syncthreads(); p0_convert(F, A); }
#endif
#if DUP_P0M
    if (IN(0)) { __syncthreads(); p0_mods_partial(F, A); }
#endif
    #endif
        SEAM(0);
#ifndef NO_P1
    if (IN(1)) p0_mods_reduce(F, A);
    #endif
        SEAM(1);
#ifndef NO_P2
    if (IN(2)) norm_rows<0>(F, A.in[I_XP], A.in[I_XS], X, A.in[I_NORMG], MODS, 0, H, nullptr);
    #endif
        SEAM(2);

    for (int l = 0; l < DEPTH; ++l) {
        const int pb = 3 + 12 * l;
        unsigned char* wl = ws + WS_W + (size_t)l * W_LAYER;
        const float* mods_l = MODS + (size_t)l * 3 * 9 * DM;
        const float* ng = A.in[I_NORMG] + (size_t)l * 3 * DM;
#ifndef NO_G0
        if (IN(pb + 0)) { pg8::Gemm g{H, (const bf16*)(wl + WO_UP1), MTOK, 2 * DFF, DM}; pg8::StaticOrder S; S.init(MTOK, 2 * DFF, F.G, (int)blockIdx.x);
            pg8::EpiSwiglu E{HID, DFF}; pg8::gemm_phase<pg8::EpiSwiglu, pg8::StaticOrder, true, true>(ring, g, S, E);
#if DUP_UP1
            __syncthreads(); pg8::gemm_phase<pg8::EpiSwiglu, pg8::StaticOrder, true, true>(ring, g, S, E);
#endif
        }
        #endif
        CV_END(l, 0, 1);
        SEAM(pb + 0);
#ifndef NO_G1
        if (IN(pb + 1)) { pg8::Gemm g{HID, (const bf16*)(wl + WO_DN1), MTOK, DM, DFF}; pg8::StaticOrder S; S.init(MTOK, DM, F.G, (int)blockIdx.x);
            pg8::EpiResid E{X, DM, mods_l, 0, 0.5f}; pg8::gemm_phase<pg8::EpiResid, pg8::StaticOrder, true, true>(ring, g, S, E); }
        #endif
        CV_END(l, 1, 1);
        SEAM(pb + 1);
#ifndef NO_N2
        if (IN(pb + 2)) norm_rows<0>(F, X, X + (size_t)NCTX * DM, nullptr, ng + DM, mods_l, 1, H, nullptr);
#if DUP_NORM
        if (IN(pb + 2)) norm_rows<0>(F, X, X + (size_t)NCTX * DM, nullptr, ng + DM, mods_l, 1, H, nullptr);
#endif
        #endif
        CV_END(l, 2, 0);
        SEAM(pb + 2);
#ifndef NO_G3
        if (IN(pb + 3)) { pg8::Gemm g{H, (const bf16*)(wl + WO_IN), MTOK, DIN, DM}; pg8::StaticOrder S; S.init(MTOK, DIN, F.G, (int)blockIdx.x);
            pg8::EpiZ E{(float*)(ws + WS_ZF), (bf16*)(ws + WS_QB), (bf16*)(ws + WS_KB), (bf16*)(ws + WS_VT), (bf16*)(ws + WS_GB), A.out + OUT_K, A.out + OUT_V, l, (float*)(ws + 736 * MiB)}; pg8::gemm_phase<pg8::EpiZ, pg8::StaticOrder, true, true>(ring, g, S, E); }
        #endif
        CV_END(l, 3, 1);
        SEAM(pb + 3);
        if (IN(pb + 4)) {
            gu32* q = ctl + CW_Q + (l * 8) * 64;
            #ifndef NO_H1
            for (int u; (u = next_unit(q + 0 * 64, MISC + 16)) < 768;) hgrn_local_unit(F, A, u, l);
#endif
#if DUP_H1
            for (int u; (u = next_unit(q + 6 * 64, MISC + 16)) < 768;) hgrn_local_unit(F, A, u, l);
#endif
            #ifndef NO_NA
            for (int u; (u = next_unit(q + 1 * 64, MISC + 16)) < 256;) attn_na_unit(F, A, u, l);
#endif
#if DUP_NA
            for (int u; (u = next_unit(q + 6 * 64, MISC + 16)) < 256;) attn_na_unit(F, A, u, l);
#endif
            #ifndef NO_CA
            for (int u; (u = next_unit(q + 2 * 64, MISC + 16)) < 256;) attn_ctx_unit(F, A, u);
#endif
#if DUP_CA
            for (int u; (u = next_unit(q + 6 * 64, MISC + 16)) < 256;) attn_ctx_unit(F, A, u);
#endif
            #ifndef NO_L1
            for (int u; (u = next_unit(q + 3 * 64, MISC + 16)) < 384;) lru_gate_unit(F, A, u, l);
#endif
#if DUP_L1
            for (int u; (u = next_unit(q + 6 * 64, MISC + 16)) < 384;) lru_gate_unit(F, A, u, l);
#endif
        }
        CV_END(l, 4, 0);
        SEAM(pb + 4);
        if (IN(pb + 5)) {
            gu32* q = ctl + CW_Q + (l * 8) * 64;
            #ifndef NO_H3
            for (int u; (u = next_unit(q + 4 * 64, MISC + 16)) < 384;) hgrn_final_unit(F, A, u, l);
#endif
#if DUP_H3
            for (int u; (u = next_unit(q + 7 * 64, MISC + 16)) < 384;) hgrn_final_unit(F, A, u, l);
#endif
            #ifndef NO_L2
            for (int u; (u = next_unit(q + 5 * 64, MISC + 16)) < 384;) lru_final_unit(F, A, u, l);
#endif
#if DUP_L2
            for (int u; (u = next_unit(q + 7 * 64, MISC + 16)) < 384;) lru_final_unit(F, A, u, l);
#endif
        }
        CV_END(l, 5, 0);
        SEAM(pb + 5);
#ifndef NO_G6
        if (IN(pb + 6)) {
            __syncthreads();
            float* MACC = (float*)(ws + WS_MACC); bf16* MB = (bf16*)(ws + WS_MB);
            { pg8::Gemm g{(const bf16*)(ws + WS_OA), (const bf16*)(wl + WO_PA), MTOK, DM, 512}; pg8::StaticOrder S; S.init(MTOK, DM, F.G, (int)blockIdx.x);
              pg8::EpiMerge E{(const bf16*)(ws + WS_GB), MACC, MB, 0}; pg8::gemm_phase<pg8::EpiMerge, pg8::StaticOrder, true, true>(ring, g, S, E); }
            { pg8::Gemm g{(const bf16*)(ws + WS_OB), (const bf16*)(wl + WO_PB), MTOK, DM, 1024}; pg8::StaticOrder S; S.init(MTOK, DM, F.G, (int)blockIdx.x);
              pg8::EpiMerge E{(const bf16*)(ws + WS_GB) + DM, MACC, MB, 1}; pg8::gemm_phase<pg8::EpiMerge, pg8::StaticOrder, true, true>(ring, g, S, E); }
            { pg8::Gemm g{(const bf16*)(ws + WS_OC), (const bf16*)(wl + WO_PC), MTOK, DM, 512}; pg8::StaticOrder S; S.init(MTOK, DM, F.G, (int)blockIdx.x);
              pg8::EpiMerge E{(const bf16*)(ws + WS_GB) + 2 * DM, MACC, MB, 2}; pg8::gemm_phase<pg8::EpiMerge, pg8::StaticOrder, true, true>(ring, g, S, E); }
        }
        #endif
        CV_END(l, 6, 1);
        SEAM(pb + 6);
#ifndef NO_G7
        if (IN(pb + 7)) { pg8::Gemm g{(const bf16*)(ws + WS_MB), (const bf16*)(wl + WO_OUT), MTOK, DM, DM}; pg8::StaticOrder S; S.init(MTOK, DM, F.G, (int)blockIdx.x);
            pg8::EpiResid E{X, DM, mods_l, 1, 1.0f}; pg8::gemm_phase<pg8::EpiResid, pg8::StaticOrder, true, true>(ring, g, S, E); }
        #endif
        CV_END(l, 7, 1);
        SEAM(pb + 7);
#ifndef NO_N8
        if (IN(pb + 8)) norm_rows<0>(F, X, X + (size_t)NCTX * DM, nullptr, ng + 2 * DM, mods_l, 2, H, nullptr);
        #endif
        CV_END(l, 8, 0);
        SEAM(pb + 8);
#ifndef NO_G9
        if (IN(pb + 9)) { pg8::Gemm g{H, (const bf16*)(wl + WO_UP2), MTOK, 2 * DFF, DM}; pg8::StaticOrder S; S.init(MTOK, 2 * DFF, F.G, (int)blockIdx.x);
            pg8::EpiSwiglu E{HID, DFF}; pg8::gemm_phase<pg8::EpiSwiglu, pg8::StaticOrder, true, true>(ring, g, S, E); }
        #endif
        CV_END(l, 9, 1);
        SEAM(pb + 9);
#ifndef NO_G10
        if (IN(pb + 10)) { pg8::Gemm g{HID, (const bf16*)(wl + WO_DN2), MTOK, DM, DFF}; pg8::StaticOrder S; S.init(MTOK, DM, F.G, (int)blockIdx.x);
            pg8::EpiResid E{X, DM, mods_l, 2, 0.5f}; pg8::gemm_phase<pg8::EpiResid, pg8::StaticOrder, true, true>(ring, g, S, E); }
        #endif
        CV_END(l, 10, 1);
        SEAM(pb + 10);
#ifndef NO_N11
        if (IN(pb + 11)) {
            if (l + 1 < DEPTH) norm_rows<0>(F, X, X + (size_t)NCTX * DM, nullptr, ng + 3 * DM, mods_l + 3 * 9 * DM, 0, H, nullptr);
            else norm_rows<1>(F, X, X + (size_t)NCTX * DM, nullptr, A.in[I_FNG], nullptr, 0, nullptr, A.out + OUT_Y);
        }
        #endif
        CV_END(l, 11, 0);
        SEAM(pb + 11);
    }
#undef IN
#undef SEAM
}

extern "C" void kernel_launch(void* const* d_in, const int* in_sizes, int n_in, void* d_out, int out_size, void* d_ws, size_t ws_size, hipStream_t stream) {
    static int grid = 0;
    if (grid == 0) {
        if (n_in != 31 || out_size != 33587200 || ws_size < WS_END) { fprintf(stderr, "kernel_launch: unexpected shapes (n_in %d, out %d, ws %zu); nothing launched\n", n_in, out_size, ws_size); grid = -1; return; }
        int dev = 0, cus = 0, per_cu = 0;
        if (hipGetDevice(&dev) != hipSuccess || hipDeviceGetAttribute(&cus, hipDeviceAttributeMultiprocessorCount, dev) != hipSuccess) { grid = -1; return; }
        if (hipFuncSetAttribute((const void*)trunk_fwd, hipFuncAttributeMaxDynamicSharedMemorySize, LDS_BYTES) != hipSuccess) { fprintf(stderr, "kernel_launch: hipFuncSetAttribute failed\n"); grid = -1; return; }
        if (hipOccupancyMaxActiveBlocksPerMultiprocessor(&per_cu, (const void*)trunk_fwd, NTHREADS, LDS_BYTES) != hipSuccess || per_cu < 1) { fprintf(stderr, "kernel_launch: occupancy query says %d blocks per CU\n", per_cu); (void)hipGetLastError(); grid = -1; return; }
        grid = cus;
    }
    if (grid < 0) return;
    if (hipMemsetAsync((char*)d_ws + WS_CTL, 0, CTL_ZERO_BYTES, stream) != hipSuccess) return;
#if PROBE_MEMSET
    (void)hipMemsetAsync((char*)d_ws + PROBE_MS_LO * MiB, 0, (PROBE_MS_HI - PROBE_MS_LO) * MiB, stream);
#endif
    Args a{};
    for (int i = 0; i < 31; ++i) a.in[i] = (const float*)d_in[i];
    a.out = (float*)d_out; a.ws = (unsigned char*)d_ws;
#if MK_N_LAUNCHES == 1
    a.ph_lo = 0; a.ph_hi = N_PHASES;
    hipLaunchKernelGGL(trunk_fwd, dim3(grid), dim3(NTHREADS), LDS_BYTES, stream, a);
#else
    for (int p = 0; p < N_PHASES; ++p) { a.ph_lo = p; a.ph_hi = p + 1; hipLaunchKernelGGL(trunk_fwd, dim3(grid), dim3(NTHREADS), LDS_BYTES, stream, a); }
#endif
}
```

```cpp
#include <hip/hip_runtime.h>
#include <cstdio>
#include <cstdint>
namespace pg8 {
#define PG8_LAS __attribute__((address_space(3)))
typedef unsigned short bf16_t;
typedef short bf16x8 __attribute__((ext_vector_type(8)));
typedef float f32x4 __attribute__((ext_vector_type(4)));
typedef unsigned u32x4 __attribute__((ext_vector_type(4)));
constexpr int BM = 256, BK = 64, HALF = 128, HTB = HALF * BK * 2  , STAGE_BYTES = 8 * HTB, NXCD = 8, WGM = 8;

__host__ __device__ __forceinline__ int lds_byte(int r, int c) { const int st = (r >> 4) * 2 + (c >> 5), rr = r & 15, cc = c & 31, ob = rr * 64 + cc * 2; return st * 1024 + (ob ^ (((ob >> 9) & 1) << 5)); }
__host__ __device__ __forceinline__ void stage_rc(int b, int& R, int& C) { const int st = b / 1024, sb = b % 1024, swz = sb ^ (((sb >> 9) & 1) << 5); R = (st >> 1) * 16 + swz / 64; C = (st & 1) * 32 + (swz % 64) / 2; }
__host__ __device__ __forceinline__ int perm32(int rho) { const int n = rho >> 4, i = rho & 15; return 8 * (i >> 2) + 4 * n + (i & 3); }

struct Unit { int pm, pn; };
struct Gemm { const bf16_t* A; const bf16_t* Bt; int M, N, K; };

struct StaticOrder {
    int nM, nN, nwg, G, c;
    __host__ __device__ void init(int M, int N, int G_, int c_, int bm = BM) { nM = M / bm; nN = N / BM; nwg = nM * nN; G = G_; c = c_; }
    __host__ __device__ bool next(int i, Unit& u) const {
        const long L = (long)i * G + c; if (L >= nwg) return false;
        int wgid = (int)L; { const int q = nwg / NXCD, r = nwg % NXCD, xcd = wgid % NXCD, off = wgid / NXCD; wgid = (xcd < r ? xcd * (q + 1) : r * (q + 1) + (xcd - r) * q) + off; }
        const int nig = WGM * nN, gid = wgid / nig, fm = gid * WGM, gsz = (nM - fm) < WGM ? (nM - fm) : WGM;
        u.pm = fm + ((wgid % nig) % gsz); u.pn = (wgid % nig) / gsz; return true;
    }
    __device__ __forceinline__ void a_ready(const Unit&) const {}
    __device__ __forceinline__ void done(const Unit&) const {}
};
typedef float f32x2_cv __attribute__((ext_vector_type(2)));
typedef __bf16 bf16x2_cv __attribute__((ext_vector_type(2)));
__device__ __forceinline__ unsigned cvt_pk_bf16(float lo, float hi) { const f32x2_cv v = {lo, hi}; return __builtin_bit_cast(unsigned, __builtin_convertvector(v, bf16x2_cv)); }
typedef float f32x2 __attribute__((ext_vector_type(2)));

typedef unsigned u32x2 __attribute__((ext_vector_type(2)));
#ifndef PROBE_NOGATE
#define PROBE_NOGATE 0
#endif
#ifndef PROBE_GCONST
#define PROBE_GCONST 0
#endif
#ifndef PROBE_GRAW
#define PROBE_GRAW 0
#endif
#ifndef PROBE_QKV32
#define PROBE_QKV32 0
#endif
__device__ __forceinline__ float silu_f(float a) { return a * __builtin_amdgcn_rcpf(1.0f + __expf(-a)); }
__device__ __forceinline__ float sigmoid_f(float a) { return __builtin_amdgcn_rcpf(1.0f + __expf(-a)); }
__device__ __forceinline__ int opq_(int v) { asm volatile("" : "+v"(v)); return v; }

struct EpiSwiglu {
    static constexpr bool PERM = true, AFTER_DRAIN = false;
    bf16_t* O; int ldo;
    __device__ __forceinline__ void operator()(const f32x4 (&acc)[2][2][4][2], const Unit& u, int wr, int wc, int fr_, int fq_) const {
        const int fr = opq_(fr_), fq = opq_(fq_);
        const int row0 = u.pm * BM + wr * 64 + fr, col0 = u.pn * HALF + wc * 32 + 8 * fq;
#pragma unroll
        for (int ai = 0; ai < 2; ++ai)
#pragma unroll
            for (int m = 0; m < 4; ++m) { bf16_t* rowp = O + (size_t)(row0 + ai * HALF + m * 16) * ldo + col0;
                const f32x4 a0 = acc[ai][0][m][0], a1 = acc[ai][0][m][1], u0 = acc[ai][1][m][0], u1 = acc[ai][1][m][1];
                f32x4 v0, v1;
#pragma unroll
                for (int j = 0; j < 4; ++j) { v0[j] = silu_f(a0[j]) * u0[j]; v1[j] = silu_f(a1[j]) * u1[j]; }
                u32x4 w; w.x = cvt_pk_bf16(v0[0], v0[1]); w.y = cvt_pk_bf16(v0[2], v0[3]); w.z = cvt_pk_bf16(v1[0], v1[1]); w.w = cvt_pk_bf16(v1[2], v1[3]);
                *(u32x4*)rowp = w; }
    }
};
struct EpiResid {
    static constexpr bool PERM = false, AFTER_DRAIN = false;
    float* X; int ldx; const float* mods_l; int slot; float coef;
    template <int MT>
    __device__ __forceinline__ void operator()(const f32x4 (&acc)[2][2][MT][2], const Unit& u, int wr, int wc, int fr_, int fq_) const {
        const int fr = opq_(fr_), fq = opq_(fq_);
        constexpr int TM = 64 * MT, HM = 32 * MT, WM = 16 * MT;
        const int row0 = u.pm * TM + wr * WM + fr, col0 = u.pn * BM + wc * 32 + 4 * fq;
        if constexpr (MT == 4) {
            const int cidx = u.pm < 16 ? 0 : 1 + ((u.pm - 16) >> 2);
            const float* g = mods_l + (size_t)(cidx * 9 + 3 * slot + 2) * 2048 + col0;
            f32x4 gv[2][2];
#pragma unroll
            for (int bj = 0; bj < 2; ++bj)
#pragma unroll
                for (int n = 0; n < 2; ++n) gv[bj][n] = *(const f32x4*)(g + bj * HALF + n * 16) * coef;
#pragma unroll
            for (int ai = 0; ai < 2; ++ai)
#pragma unroll
                for (int m = 0; m < 4; ++m) { float* rowp = X + (size_t)(row0 + ai * HALF + m * 16) * ldx + col0;
#pragma unroll
                    for (int bj = 0; bj < 2; ++bj)
#pragma unroll
                        for (int n = 0; n < 2; ++n) { f32x4* p = (f32x4*)(rowp + bj * HALF + n * 16); *p = *p + gv[bj][n] * acc[ai][bj][m][n]; } }
        } else {
#pragma unroll
            for (int ai = 0; ai < 2; ++ai)
#pragma unroll
                for (int m = 0; m < MT; ++m) { const int rg = u.pm * TM + ai * HM + wr * WM + m * 16, cidx = rg < 4096 ? 0 : 1 + ((rg - 4096) >> 10);
                    const float* g = mods_l + (size_t)(cidx * 9 + 3 * slot + 2) * 2048 + col0;
                    float* rowp = X + (size_t)(row0 + ai * HM + m * 16) * ldx + col0;
#pragma unroll
                    for (int bj = 0; bj < 2; ++bj)
#pragma unroll
                        for (int n = 0; n < 2; ++n) { f32x4* p = (f32x4*)(rowp + bj * HALF + n * 16); *p = *p + (*(const f32x4*)(g + bj * HALF + n * 16) * coef) * acc[ai][bj][m][n]; } }
        }
    }
};
struct EpiZ {
    static constexpr bool PERM = false, AFTER_DRAIN = false;
    float* ZF; bf16_t* QB; bf16_t* KB; bf16_t* VT; bf16_t* GB; float* outk; float* outv; int layer; float* Q32;
    __device__ __forceinline__ void operator()(const f32x4 (&acc)[2][2][4][2], const Unit& u, int wr, int wc, int fr_, int fq_) const {
        const int fr = opq_(fr_), fq = opq_(fq_);
        const int rl0 = wr * 64 + fr, ct0 = wc * 32 + 4 * fq, pn = u.pn;
#if PROBE_QKV32
        if (pn >= 10 && pn < 22) { float* base = Q32 + (size_t)(u.pm * BM + rl0) * 3072 + (pn - 10) * 256 + ct0;
#pragma unroll
            for (int ai = 0; ai < 2; ++ai)
#pragma unroll
                for (int m = 0; m < 4; ++m) { float* rowp = base + (size_t)(ai * HALF + m * 16) * 3072;
#pragma unroll
                    for (int bj = 0; bj < 2; ++bj)
#pragma unroll
                        for (int n = 0; n < 2; ++n) *(f32x4*)(rowp + bj * HALF + n * 16) = acc[ai][bj][m][n]; } }
#endif
        if (pn < 10 || (pn >= 22 && pn < 26)) {
            float* base = ZF + (size_t)(u.pm * BM + rl0) * 3584 + (pn < 10 ? pn * 256 : 2560 + (pn - 22) * 256) + ct0;
#pragma unroll
            for (int ai = 0; ai < 2; ++ai)
#pragma unroll
                for (int m = 0; m < 4; ++m) { float* rowp = base + (size_t)(ai * HALF + m * 16) * 3584;
#pragma unroll
                    for (int bj = 0; bj < 2; ++bj)
#pragma unroll
                        for (int n = 0; n < 2; ++n) *(f32x4*)(rowp + bj * HALF + n * 16) = acc[ai][bj][m][n]; }
        } else if (pn < 18) {
            bf16_t* dst = (pn < 14 ? QB + (pn - 10) * 256 : KB + (pn - 14) * 256) + (size_t)(u.pm * BM + rl0) * 1024 + ct0;
            float* ko = (pn >= 14 && u.pm < 16) ? outk + ((size_t)(u.pm * 2 + layer) * 256 + rl0) * 1024 + (pn - 14) * 256 + ct0 : nullptr;
#pragma unroll
            for (int ai = 0; ai < 2; ++ai)
#pragma unroll
                for (int m = 0; m < 4; ++m) { const size_t ro = (size_t)(ai * HALF + m * 16) * 1024;
#pragma unroll
                    for (int bj = 0; bj < 2; ++bj)
#pragma unroll
                        for (int n = 0; n < 2; ++n) { const f32x4 v = acc[ai][bj][m][n]; u32x2 w; w.x = cvt_pk_bf16(v[0], v[1]); w.y = cvt_pk_bf16(v[2], v[3]);
                            *(u32x2*)(dst + ro + bj * HALF + n * 16) = w; if (ko) *(f32x4*)(ko + ro + bj * HALF + n * 16) = v; } }
        } else if (pn < 22) {
            const bool ctx = u.pm < 16; const int L = ctx ? 256 : 1024, t0 = (ctx ? 0 : ((u.pm - 16) & 3) * 256) + rl0;
            bf16_t* vb = ctx ? VT + (size_t)u.pm * 8 * 128 * 256 : VT + (size_t)4096 * 1024 + (size_t)((u.pm - 16) >> 2) * 8 * 128 * 1024;
            vb += (size_t)(2 * (pn - 18)) * 128 * L + (size_t)ct0 * L + t0;
            float* vo = ctx ? outv + ((size_t)(u.pm * 2 + layer) * 256 + rl0) * 1024 + (pn - 18) * 256 + ct0 : nullptr;
#pragma unroll
            for (int ai = 0; ai < 2; ++ai)
#pragma unroll
                for (int m = 0; m < 4; ++m) { const int tr = ai * HALF + m * 16;
#pragma unroll
                    for (int bj = 0; bj < 2; ++bj)
#pragma unroll
                        for (int n = 0; n < 2; ++n) { const f32x4 v = acc[ai][bj][m][n]; bf16_t* p = vb + (size_t)(bj * 128 + n * 16) * L + tr;
                            const unsigned w0 = cvt_pk_bf16(v[0], v[1]), w1 = cvt_pk_bf16(v[2], v[3]);
                            p[0] = (bf16_t)(w0 & 0xffffu); p[L] = (bf16_t)(w0 >> 16); p[2 * L] = (bf16_t)(w1 & 0xffffu); p[3 * L] = (bf16_t)(w1 >> 16);
                            if (vo) *(f32x4*)(vo + (size_t)tr * 1024 + bj * HALF + n * 16) = v; } }
        } else {
            bf16_t* dst = GB + (size_t)(u.pm * BM + rl0) * 6144 + (pn - 26) * 256 + ct0;
#pragma unroll
            for (int ai = 0; ai < 2; ++ai)
#pragma unroll
                for (int m = 0; m < 4; ++m) { const size_t ro = (size_t)(ai * HALF + m * 16) * 6144;
#pragma unroll
                    for (int bj = 0; bj < 2; ++bj)
#pragma unroll
                        for (int n = 0; n < 2; ++n) { const f32x4 v = acc[ai][bj][m][n]; u32x2 w; w.x = cvt_pk_bf16(sigmoid_f(v[0]), sigmoid_f(v[1])); w.y = cvt_pk_bf16(sigmoid_f(v[2]), sigmoid_f(v[3]));
#if PROBE_GCONST
                            w.x = 0x3f003f00u; w.y = 0x3f003f00u;
#endif
#if PROBE_GRAW
                            w.x = cvt_pk_bf16(v[0] * 0.01f, v[1] * 0.01f); w.y = cvt_pk_bf16(v[2] * 0.01f, v[3] * 0.01f);
#endif
                            *(u32x2*)(dst + ro + bj * HALF + n * 16) = w; } }
        }
    }
};
struct EpiMerge {
    static constexpr bool PERM = false, AFTER_DRAIN = false;
    const bf16_t* Gg; float* MACC; bf16_t* MB; int mode;
    template <int MT>
    __device__ __forceinline__ void operator()(const f32x4 (&acc)[2][2][MT][2], const Unit& u, int wr, int wc, int fr_, int fq_) const {
        const int fr = opq_(fr_), fq = opq_(fq_);
        constexpr int TM = 64 * MT, HM = 32 * MT, WM = 16 * MT;
        const int row0 = u.pm * TM + wr * WM + fr, col0 = u.pn * BM + wc * 32 + 4 * fq;
#pragma unroll
        for (int ai = 0; ai < 2; ++ai)
#pragma unroll
            for (int m = 0; m < MT; ++m) { const size_t row = (size_t)(row0 + ai * HM + m * 16);
#pragma unroll
                for (int bj = 0; bj < 2; ++bj)
#pragma unroll
                    for (int n = 0; n < 2; ++n) { const int c = col0 + bj * HALF + n * 16;
#if PROBE_NOGATE
                        const u32x2 gw = {0x3f003f00u, 0x3f003f00u}; f32x4 v = acc[ai][bj][m][n];
#else
                        const u32x2 gw = *(const u32x2*)(Gg + row * 6144 + c); f32x4 v = acc[ai][bj][m][n];
#endif
                        v[0] *= __uint_as_float(gw.x << 16); v[1] *= __uint_as_float(gw.x & 0xffff0000u); v[2] *= __uint_as_float(gw.y << 16); v[3] *= __uint_as_float(gw.y & 0xffff0000u);
                        f32x4* mp = (f32x4*)(MACC + row * 2048 + c);
                        if (mode == 0) *mp = v;
                        else if (mode == 1) *mp = *mp + v;
                        else { v = *mp + v; u32x2 w; w.x = cvt_pk_bf16(v[0], v[1]); w.y = cvt_pk_bf16(v[2], v[3]); *(u32x2*)(MB + row * 2048 + c) = w; } } }
    }
};
template <class Epi, class Sched, bool ALIGN_EPI = false, bool SP2 = false, int MT = 4>
__device__ __forceinline__ void gemm_phase(PG8_LAS unsigned char* lds, const Gemm g, const Sched& S, const Epi& E) {
    int tid_ = threadIdx.x; asm volatile("" : "+v"(tid_));
    const int tid = tid_, wid = __builtin_amdgcn_readfirstlane(tid >> 6), lane = tid & 63, wr = wid >> 2, wc = wid & 3, fr = lane & 15, fq = lane >> 4;
    const int K = g.K, nt = K / BK;
    unsigned voffA[2], voffB[2];
#pragma unroll
    for (int i = 0; i < 2; ++i) { int R, C; stage_rc(tid * 16 + i * 8192, R, C); const int Rb = Epi::PERM ? ((R & ~31) + perm32(R & 31)) : R;
        const int Ra = R < 32 * MT ? R : R - 32;
        voffA[i] = (unsigned)(Ra * K + C) * 2u; voffB[i] = (unsigned)(Rb * K + C) * 2u; }
    const size_t kstep = (size_t)(BK * 2);
    const size_t hstep = (size_t)HALF * K * 2;
    const size_t tstep = 2 * hstep;
    const size_t hstepA = (size_t)(32 * MT) * K * 2, tstepA = 2 * hstepA;
    const unsigned ldsw = (unsigned)wid * 1024u;
    const int aoff = lds_byte(wr * 16 * MT + fr, fq * 8), boff = lds_byte(wc * 32 + fr, fq * 8);
#define PG8_SA(b, h) (((b) * 2 + (h)) * HTB)
#define PG8_SB(b, h) ((4 + (b) * 2 + (h)) * HTB)
#define PG8_STAGE(bufoff, gbase, voff) do { _Pragma("unroll") for (int _i = 0; _i < 2; ++_i) \
        __builtin_amdgcn_global_load_lds((const unsigned*)((const char*)(gbase) + (voff)[_i]), (PG8_LAS unsigned*)(lds + (bufoff) + ldsw + _i * 8192), 16, 0, 0); } while (0)
#define PG8_LDA(dst, b, h) do { _Pragma("unroll") for (int m = 0; m < MT; ++m) _Pragma("unroll") for (int k = 0; k < 2; ++k) dst[m][k] = *(const PG8_LAS bf16x8*)(lds + PG8_SA(b, h) + aoff + m * 2048 + k * 1024); } while (0)
#define PG8_LDB(dst, b, h) do { _Pragma("unroll") for (int n = 0; n < 2; ++n) _Pragma("unroll") for (int k = 0; k < 2; ++k) dst[n][k] = *(const PG8_LAS bf16x8*)(lds + PG8_SB(b, h) + boff + n * 2048 + k * 1024); } while (0)
#define PG8_MMA(ai, bj, At, Bt) do { __builtin_amdgcn_s_setprio(1); _Pragma("unroll") for (int m = 0; m < MT; ++m) _Pragma("unroll") for (int n = 0; n < 2; ++n) _Pragma("unroll") for (int k = 0; k < 2; ++k) \
        acc[ai][bj][m][n] = __builtin_amdgcn_mfma_f32_16x16x32_bf16(Bt[n][k], At[m][k], acc[ai][bj][m][n], 0, 0, 0); __builtin_amdgcn_s_setprio(0); } while (0)
#define PG8_WAIT_V(n) asm volatile("s_waitcnt vmcnt(" #n ")" ::: "memory")
#define PG8_WAIT_L(n) asm volatile("s_waitcnt lgkmcnt(" #n ")" ::: "memory")
#define PG8_BAR __builtin_amdgcn_s_barrier()
#define PG8_SCHED __builtin_amdgcn_sched_barrier(0)
    Unit cur, nxt; int ui = 0;
    if (!S.next(0, cur)) return;
    f32x4 acc[2][2][MT][2];
#pragma unroll
    for (int a = 0; a < 2; ++a)
#pragma unroll
        for (int b = 0; b < 2; ++b)
#pragma unroll
            for (int m = 0; m < MT; ++m)
#pragma unroll
                for (int n = 0; n < 2; ++n) acc[a][b][m][n] = (f32x4){0.f, 0.f, 0.f, 0.f};
    bf16x8 At[MT][2], B0[2][2], B1[2][2];
    const char* cA = (const char*)g.A + (size_t)cur.pm * tstepA; const char* cB = (const char*)g.Bt + (size_t)cur.pn * tstep;
    S.a_ready(cur);
    if constexpr (SP2) {
        PG8_STAGE(PG8_SB(0, 0), cB, voffB); PG8_STAGE(PG8_SB(0, 1), cB + hstep, voffB); PG8_STAGE(PG8_SA(0, 0), cA, voffA); PG8_STAGE(PG8_SA(0, 1), cA + hstepA, voffA);
        if (wr == 1) PG8_BAR;
        PG8_WAIT_V(2); PG8_BAR;
        PG8_STAGE(PG8_SB(1, 0), cB + kstep, voffB); PG8_STAGE(PG8_SA(1, 0), cA + kstep, voffA); PG8_STAGE(PG8_SB(1, 1), cB + hstep + kstep, voffB);
        PG8_WAIT_V(6); PG8_BAR;
    } else {
        PG8_STAGE(PG8_SB(0, 0), cB, voffB); PG8_STAGE(PG8_SA(0, 0), cA, voffA); PG8_STAGE(PG8_SB(0, 1), cB + hstep, voffB); PG8_STAGE(PG8_SA(0, 1), cA + hstepA, voffA);
        if (wr == 1) PG8_BAR;
        PG8_WAIT_V(4); PG8_BAR;
        PG8_STAGE(PG8_SB(1, 0), cB + kstep, voffB); PG8_STAGE(PG8_SA(1, 0), cA + kstep, voffA); PG8_STAGE(PG8_SB(1, 1), cB + hstep + kstep, voffB);
        PG8_WAIT_V(6); PG8_BAR;
    }
    for (;;) {
        const bool has_next = S.next(ui + 1, nxt);
        const char* nA = has_next ? (const char*)g.A + (size_t)nxt.pm * tstepA : cA; const char* nB = has_next ? (const char*)g.Bt + (size_t)nxt.pn * tstep : cB;
        for (int t = 0; t < nt; t += 2) {
            const bool last = (t == nt - 2);
            const char* a1 = cA + (size_t)(t + 1) * kstep;
            const char* a2 = last ? nA : cA + (size_t)(t + 2) * kstep; const char* b2 = last ? nB : cB + (size_t)(t + 2) * kstep;
            const char* a3 = a2 + kstep; const char* b3 = b2 + kstep;
            if (last && has_next) S.a_ready(nxt);
            if constexpr (SP2) {
            PG8_LDB(B0, 0, 0); PG8_LDB(B1, 0, 1); PG8_SCHED; PG8_LDA(At, 0, 0); PG8_STAGE(PG8_SA(1, 1), a1 + hstepA, voffA);
            PG8_WAIT_V(8); PG8_WAIT_L(0); PG8_BAR; PG8_MMA(0, 0, At, B0); PG8_MMA(0, 1, At, B1); PG8_BAR; PG8_SCHED;
            PG8_LDA(At, 0, 1); PG8_STAGE(PG8_SB(0, 0), b2, voffB); PG8_STAGE(PG8_SB(0, 1), b2 + hstep, voffB); PG8_STAGE(PG8_SA(0, 0), a2, voffA);
            PG8_WAIT_V(8); PG8_WAIT_L(0); PG8_BAR; PG8_MMA(1, 0, At, B0); PG8_MMA(1, 1, At, B1); PG8_BAR; PG8_SCHED;
            PG8_LDB(B0, 1, 0); PG8_LDB(B1, 1, 1); PG8_SCHED; PG8_LDA(At, 1, 0); PG8_STAGE(PG8_SA(0, 1), a2 + hstepA, voffA);
            PG8_WAIT_V(8); PG8_WAIT_L(0); PG8_BAR; PG8_MMA(0, 0, At, B0); PG8_MMA(0, 1, At, B1); PG8_BAR; PG8_SCHED;
            PG8_LDA(At, 1, 1); PG8_STAGE(PG8_SB(1, 0), b3, voffB); PG8_STAGE(PG8_SB(1, 1), b3 + hstep, voffB); PG8_STAGE(PG8_SA(1, 0), a3, voffA);
            PG8_WAIT_V(8); PG8_WAIT_L(0); PG8_BAR; PG8_MMA(1, 0, At, B0); PG8_MMA(1, 1, At, B1); PG8_BAR; PG8_SCHED;
            } else {
            PG8_LDB(B0, 0, 0); PG8_SCHED; PG8_LDA(At, 0, 0); PG8_STAGE(PG8_SA(1, 1), a1 + hstepA, voffA);
            PG8_WAIT_L(8); PG8_BAR; PG8_WAIT_L(0); PG8_MMA(0, 0, At, B0); PG8_BAR; PG8_SCHED;
            PG8_LDB(B1, 0, 1); PG8_STAGE(PG8_SB(0, 0), b2, voffB);
            PG8_BAR; PG8_WAIT_L(0); PG8_MMA(0, 1, At, B1); PG8_BAR;
            PG8_LDA(At, 0, 1); PG8_STAGE(PG8_SA(0, 0), a2, voffA);
            PG8_BAR; PG8_WAIT_L(0); PG8_MMA(1, 0, At, B0); PG8_BAR; PG8_SCHED;
            PG8_STAGE(PG8_SB(0, 1), b2 + hstep, voffB);
            PG8_WAIT_V(6); PG8_BAR; PG8_MMA(1, 1, At, B1); PG8_BAR;
            PG8_LDB(B0, 1, 0); PG8_SCHED; PG8_LDA(At, 1, 0); PG8_STAGE(PG8_SA(0, 1), a2 + hstepA, voffA);
            PG8_WAIT_L(8); PG8_BAR; PG8_WAIT_L(0); PG8_MMA(0, 0, At, B0); PG8_BAR; PG8_SCHED;
            PG8_LDB(B1, 1, 1); PG8_STAGE(PG8_SB(1, 0), b3, voffB);
            PG8_BAR; PG8_WAIT_L(0); PG8_MMA(0, 1, At, B1); PG8_BAR;
            PG8_LDA(At, 1, 1); PG8_STAGE(PG8_SA(1, 0), a3, voffA);
            PG8_BAR; PG8_WAIT_L(0); PG8_MMA(1, 0, At, B0); PG8_BAR; PG8_SCHED;
            PG8_STAGE(PG8_SB(1, 1), b3 + hstep, voffB);
            PG8_WAIT_V(6); PG8_BAR; PG8_MMA(1, 1, At, B1); PG8_BAR;
            }
        }
        if constexpr (ALIGN_EPI) { if (wr == 0) PG8_BAR; }
        if constexpr (!Epi::AFTER_DRAIN) { E(acc, cur, wr, wc, fr, fq); S.done(cur); }
        if (!has_next) break;
#pragma unroll
        for (int a = 0; a < 2; ++a)
#pragma unroll
            for (int b = 0; b < 2; ++b)
#pragma unroll
                for (int m = 0; m < MT; ++m)
#pragma unroll
                    for (int n = 0; n < 2; ++n) acc[a][b][m][n] = (f32x4){0.f, 0.f, 0.f, 0.f};
        cur = nxt; cA = nA; cB = nB; ++ui;
        if constexpr (ALIGN_EPI) { if (wr == 1) PG8_BAR; }
    }
    PG8_WAIT_V(0);
    if constexpr (!ALIGN_EPI) { if (wr == 0) PG8_BAR; }
    PG8_BAR;
    if constexpr (Epi::AFTER_DRAIN) { E.fused(acc, cur, wr, wc, fr, fq, lds, wid, lane); S.done(cur); }
#undef PG8_SA
#undef PG8_SB
#undef PG8_STAGE
#undef PG8_LDA
#undef PG8_LDB
#undef PG8_MMA
#undef PG8_WAIT_V
#undef PG8_WAIT_L
#undef PG8_BAR
#undef PG8_SCHED
}
}

constexpr int DM = 2048, DFF = 5632, DIN = 12800, NCTX = 4096, NLAT = 2048, MTOK = 6144, DEPTH = 2;
constexpr int SEQ = 256, DSEQ = 1024, NSEQ = 18;
constexpr int ZQ = 0, ZFF = 512, ZFB = 1024, ZI = 1536, ZO = 2048, ZLX = 2560, ZLG = 3072, ZFW = 3584;
constexpr int NWAVES = 8, NTHREADS = 512;
constexpr size_t MiB = 1u << 20;
constexpr size_t WS_CTL = 0, CTL_ZERO_BYTES = 1 * MiB;
constexpr size_t WS_W = 2 * MiB, W_LAYER = 198 * MiB;
constexpr size_t WO_UP1 = 0, WO_DN1 = 44 * MiB, WO_UP2 = 66 * MiB, WO_DN2 = 110 * MiB, WO_IN = 132 * MiB, WO_PA = 182 * MiB, WO_PB = 184 * MiB, WO_PC = 188 * MiB, WO_OUT = 190 * MiB;
constexpr size_t WS_X = 398 * MiB;
constexpr size_t WS_H = 446 * MiB;
constexpr size_t WS_HID = 470 * MiB;
constexpr size_t WS_ZF = 536 * MiB;
constexpr size_t WS_QB = 620 * MiB;
constexpr size_t WS_KB = 632 * MiB;
constexpr size_t WS_VT = 644 * MiB;
constexpr size_t WS_GB = 656 * MiB;
constexpr size_t WS_CKB = 728 * MiB;
constexpr size_t WS_CVT = 732 * MiB;
constexpr size_t WS_OA = 836 * MiB, WS_OB = 842 * MiB, WS_OC = 854 * MiB;
constexpr size_t WS_MACC = 860 * MiB;
constexpr size_t WS_MB = 908 * MiB;
constexpr size_t WS_MODP = 932 * MiB;
constexpr size_t WS_MODS = 946 * MiB;
constexpr size_t WS_HOL = 947 * MiB;
constexpr size_t WS_HQD = 971 * MiB;
constexpr size_t WS_HSL = 995 * MiB;
constexpr size_t WS_HDEC = 1043 * MiB;
constexpr size_t WS_LHL = 1044 * MiB;
constexpr size_t WS_LPP = 1068 * MiB;
constexpr size_t WS_END = 1092 * MiB;
constexpr int CW_BAR = 4096;
constexpr int CW_Q = 16384;
constexpr int RING_BYTES = 131072, LDSCTL_OFF = 143360, LDS_BYTES = 147456;

#define GAS __attribute__((address_space(1)))
#define LAS __attribute__((address_space(3)))
typedef unsigned short bf16;
typedef unsigned v4u __attribute__((ext_vector_type(4)));
typedef unsigned v2u __attribute__((ext_vector_type(2)));
typedef float f32x4 __attribute__((ext_vector_type(4)));
typedef short bf16x8 __attribute__((ext_vector_type(8)));
typedef GAS unsigned gu32;
#define RLX_AGENT __ATOMIC_RELAXED, __HIP_MEMORY_SCOPE_AGENT
#define LDS_WAIT() asm volatile("s_waitcnt lgkmcnt(0)" ::: "memory")
#define VM_WAIT() asm volatile("s_waitcnt vmcnt(0)" ::: "memory")
__device__ __forceinline__ unsigned f2bf(float f) { unsigned u = __builtin_bit_cast(unsigned, f); return (u + 0x7fffu + ((u >> 16) & 1u)) >> 16; }
__device__ __forceinline__ unsigned pk2(float lo, float hi) { return pg8::cvt_pk_bf16(lo, hi); }
__device__ __forceinline__ float wave_sum(float v) {
#pragma unroll
    for (int o = 1; o < 64; o <<= 1) v += __shfl_xor(v, o);
    return v;
}
using pg8::silu_f; using pg8::sigmoid_f;
#define XB_TMO      128
#define XB_XCNT(j)  (256  + 64 * (j))
#define XB_XSUB(j)  (1280 + 64 * (j))
#define XB_XGEN(j)  (2304 + 64 * (j))
#define XB_TOP      3328
#define XB_TOPGEN   3392
#define XCD_BAR_WORDS 3456
#define XB_SPIN_CAP (1u << 18)

__device__ __forceinline__ unsigned xb_ld(unsigned* p)              { return __hip_atomic_load(p, __ATOMIC_RELAXED, __HIP_MEMORY_SCOPE_AGENT); }
__device__ __forceinline__ unsigned xb_add(unsigned* p, unsigned v) { return __hip_atomic_fetch_add(p, v, __ATOMIC_RELAXED, __HIP_MEMORY_SCOPE_AGENT); }
__device__ __forceinline__ unsigned xb_xcc_id() { return (unsigned)__builtin_amdgcn_s_getreg((3 << 11) | 20) & 0xFu; }
#define XB_SPIN(cond, bar) do { unsigned _sp = 0; while (cond) { __builtin_amdgcn_s_sleep(1); \
    if ((++_sp & 255u) == 0u) { if (xb_ld(&(bar)[XB_TMO])) break; if (_sp > XB_SPIN_CAP) { atomicAdd(&(bar)[XB_TMO], 1u); break; } } } } while (0)

struct XcdBarrier {
    unsigned* bar; unsigned x;
    volatile LAS unsigned* st;
};

__device__ __forceinline__ XcdBarrier xcd_barrier_post(unsigned* bar, volatile LAS unsigned* st) {
    XcdBarrier b; b.bar = bar; b.x = xb_xcc_id(); b.st = st;
    if (threadIdx.x == 0) (void)xb_add(&bar[XB_XCNT(b.x)], 1u);
    return b;
}
__device__ __forceinline__ void xcd_barrier_complete(unsigned* bar, unsigned x, unsigned& nloc, unsigned& nx) {
    const unsigned G = gridDim.x * gridDim.y * gridDim.z;
    unsigned sum, cnt, mine, sp = 0u;
    for (;;) {
        sum = 0u; cnt = 0u; mine = 0u;
#pragma unroll
        for (unsigned j = 0; j < 16; ++j) { const unsigned c = xb_ld(&bar[XB_XCNT(j)]); sum += c; cnt += (c > 0u) ? 1u : 0u; mine = (j == x) ? c : mine; }
        if (sum == G) break;
        __builtin_amdgcn_s_sleep(1);
        if ((++sp & 255u) == 0u) { if (xb_ld(&bar[XB_TMO])) break; if (sp > XB_SPIN_CAP) { atomicAdd(&bar[XB_TMO], 1u); break; } }
    }
    nloc = mine > 0u ? mine : 1u; nx = cnt > 0u ? cnt : 1u;
}

__device__ __forceinline__ void xcd_barrier(const XcdBarrier& b) {
    asm volatile("s_waitcnt vmcnt(0)" ::: "memory");
    __syncthreads();
    if (threadIdx.x == 0) {
        unsigned* bar = b.bar;
        __builtin_amdgcn_s_waitcnt(0);
        unsigned nloc = b.st[0], nx = b.st[1];
        if (nloc == 0u) { xcd_barrier_complete(bar, b.x, nloc, nx); b.st[0] = nloc; b.st[1] = nx; }
        const unsigned old = xb_add(&bar[XB_XSUB(b.x)], 1u);
        const unsigned gen = old / nloc;
        if (old + 1u == (gen + 1u) * nloc) {
            __builtin_amdgcn_fence(__ATOMIC_RELEASE, "agent");
            asm volatile("s_waitcnt vmcnt(0)" ::: "memory");
            const unsigned og = xb_add(&bar[XB_TOP], 1u);
            const unsigned tg = og / nx;
            if (og + 1u == (tg + 1u) * nx) xb_add(&bar[XB_TOPGEN], 1u);
            else XB_SPIN(xb_ld(&bar[XB_TOPGEN]) == tg, bar);
            __builtin_amdgcn_fence(__ATOMIC_ACQUIRE, "agent");
            xb_add(&bar[XB_XGEN(b.x)], 1u);
            asm volatile("s_waitcnt vmcnt(0)" ::: "memory");
        } else {
            XB_SPIN(xb_ld(&bar[XB_XGEN(b.x)]) == gen, bar);
            __builtin_amdgcn_fence(__ATOMIC_ACQUIRE, "agent");
            asm volatile("s_waitcnt vmcnt(0)" ::: "memory");
        }
    }
    __syncthreads();
}

struct Args { const float* in[31]; float* out; unsigned char* ws; int ph_lo, ph_hi; };
enum { I_XP = 0, I_XS, I_CK, I_CV, I_SHG, I_SLRU, I_C, I_CCTX, I_MODW, I_MODB, I_NORMG, I_F1UP, I_F1DN, I_F2UP, I_F2DN, I_WIN, I_LBL, I_HGN, I_RPB, I_CONVW, I_CONVB,
       I_LWA, I_LBA, I_LWX, I_LBX, I_LAM, I_PA, I_PB, I_PC, I_WOUT, I_FNG };
constexpr size_t OUT_Y = 0, OUT_K = 12582912, OUT_V = 20971520, OUT_SH = 29360128, OUT_SL = 33554432;

#ifndef PROBE_ZERO_YS
#define PROBE_ZERO_YS 0
#endif
#ifndef PROBE_ZERO_YP
#define PROBE_ZERO_YP 0
#endif
#ifndef CV_BACKGROUND
#define CV_BACKGROUND 0
#endif
struct Frame { LAS unsigned char* lds; int tid, lane, wave, G, gw, NGW; };
__device__ __forceinline__ int opq(int v) { asm volatile("" : "+v"(v)); return v; }

__device__ __forceinline__ int next_unit(gu32* head, volatile LAS unsigned* slot) {
    __syncthreads();
    if (threadIdx.x == 0) *slot = __hip_atomic_fetch_add(head, 1u, RLX_AGENT);
    __syncthreads();
    return (int)*slot;
}

__device__ __forceinline__ void cv_load(const float* W, int N, int k0, int n0, int lane, float (&v)[32]) {
#pragma unroll
    for (int i = 0; i < 32; ++i) v[i] = __builtin_nontemporal_load(W + (size_t)(k0 + 2 * i + (lane >> 5)) * N + n0 + (lane & 31));
}
__device__ __forceinline__ void cv_store(const float (&v)[32], int K, bf16* WT, int dst_row0, LAS float* scr, int k0, int lane) {
#pragma unroll
    for (int i = 0; i < 32; ++i) scr[(2 * i + (lane >> 5)) * 33 + (lane & 31)] = v[i];
    LDS_WAIT(); asm volatile("" ::: "memory");
    const int c = lane & 7;
#pragma unroll
    for (int j = 0; j < 4; ++j) { const int n = (lane >> 3) + 8 * j; const LAS float* s = scr + (8 * c) * 33 + n;
        v4u o; o.x = pk2(s[0 * 33], s[1 * 33]); o.y = pk2(s[2 * 33], s[3 * 33]); o.z = pk2(s[4 * 33], s[5 * 33]); o.w = pk2(s[6 * 33], s[7 * 33]);
        *(v4u*)(WT + (size_t)(dst_row0 + n) * K + k0 + 8 * c) = o; }
    LDS_WAIT(); asm volatile("" ::: "memory");
}
constexpr int CV_UP = 32 * 352, CV_DN = 88 * 64, CV_IN = 32 * 400, CV_A = 8 * 64, CV_B = 16 * 64, CV_O = 32 * 64, CV_PER_LAYER = 2 * CV_UP + 2 * CV_DN + CV_IN + 2 * CV_A + CV_B + CV_O;
constexpr int CV_CLAIM = 16, CV_CPL = CV_PER_LAYER / CV_CLAIM, CV_NCLAIM = DEPTH * CV_CPL, CV_STATIC = CV_UP / CV_CLAIM;
static_assert(CV_PER_LAYER % CV_CLAIM == 0 && CV_UP % CV_CLAIM == 0, "claims");
__device__ __forceinline__ int cv_need(int l, int j) {
    constexpr int T_DN1 = (CV_UP + CV_DN) / CV_CLAIM, T_IN = T_DN1 + CV_IN / CV_CLAIM, T_MRG = T_IN + (2 * CV_A + CV_B) / CV_CLAIM, T_OUT = T_MRG + CV_O / CV_CLAIM, T_UP2 = T_OUT + CV_UP / CV_CLAIM, T_DN2 = T_UP2 + CV_DN / CV_CLAIM;
    const int r = j == 0 ? T_DN1 : j <= 2 ? T_IN : j <= 5 ? T_MRG : j == 6 ? T_OUT : j <= 8 ? T_UP2 : j == 9 ? T_DN2 : T_DN2 + CV_STATIC;
    const int n = l * CV_CPL + r; return n < CV_NCLAIM ? n : CV_NCLAIM;
}
struct CvItem { const float* W; bf16* WT; int K, N, k0, n0, drow; };
__device__ __forceinline__ CvItem cv_decode(const Args& A, int it) {
    const int l = it / CV_PER_LAYER; int r = it % CV_PER_LAYER;
    unsigned char* wl = A.ws + WS_W + (size_t)l * W_LAYER;
    const float* W; int K, N; bf16* WT; int up = 0;
    if (r < CV_UP) { W = A.in[I_F1UP] + (size_t)l * DM * 2 * DFF; K = DM; N = 2 * DFF; WT = (bf16*)(wl + WO_UP1); up = 1; }
    else if ((r -= CV_UP) < CV_DN) { W = A.in[I_F1DN] + (size_t)l * DFF * DM; K = DFF; N = DM; WT = (bf16*)(wl + WO_DN1); }
    else if ((r -= CV_DN) < CV_IN) { W = A.in[I_WIN] + (size_t)l * DM * DIN; K = DM; N = DIN; WT = (bf16*)(wl + WO_IN); }
    else if ((r -= CV_IN) < CV_A) { W = A.in[I_PA] + (size_t)l * 512 * DM; K = 512; N = DM; WT = (bf16*)(wl + WO_PA); }
    else if ((r -= CV_A) < CV_B) { W = A.in[I_PB] + (size_t)l * 1024 * DM; K = 1024; N = DM; WT = (bf16*)(wl + WO_PB); }
    else if ((r -= CV_B) < CV_A) { W = A.in[I_PC] + (size_t)l * 512 * DM; K = 512; N = DM; WT = (bf16*)(wl + WO_PC); }
    else if ((r -= CV_A) < CV_O) { W = A.in[I_WOUT] + (size_t)l * DM * DM; K = DM; N = DM; WT = (bf16*)(wl + WO_OUT); }
    else if ((r -= CV_O) < CV_UP) { W = A.in[I_F2UP] + (size_t)l * DM * 2 * DFF; K = DM; N = 2 * DFF; WT = (bf16*)(wl + WO_UP2); up = 1; }
    else { r -= CV_UP; W = A.in[I_F2DN] + (size_t)l * DFF * DM; K = DFF; N = DM; WT = (bf16*)(wl + WO_DN2); }
    const int nblk = N / 32, kb = r / nblk, nb = r % nblk, n0 = 32 * nb;
    int drow = n0;
    if (up) { const int j0 = n0 < DFF ? n0 : n0 - DFF; drow = 256 * (j0 >> 7) + (j0 & 127) + (n0 < DFF ? 0 : 128); }
    CvItem c; c.W = W; c.WT = WT; c.K = K; c.N = N; c.k0 = 64 * kb; c.n0 = n0; c.drow = drow; return c;
}
__device__ __forceinline__ void p0_convert(const Frame& F_, const Args& A) {
    Frame F = F_; F.tid = opq(F_.tid); F.lane = F.tid & 63;
    LAS float* scr = (LAS float*)(F.lds + F.wave * 16384);
    for (int it = F.gw; it < (CV_BACKGROUND ? CV_UP : DEPTH * CV_PER_LAYER); it += F.NGW) { const CvItem c = cv_decode(A, it); float v[32]; cv_load(c.W, c.N, c.k0, c.n0, F.lane, v); cv_store(v, c.K, c.WT, c.drow, scr, c.k0, F.lane); }
}
__device__ __forceinline__ void cv_until(const Frame& F_, const Args& A, gu32* head, int need, gu32* fin, volatile LAS unsigned* slot) {
    Frame F = F_; F.tid = opq(F_.tid); F.lane = F.tid & 63;
    LAS float* scr = (LAS float*)(F.lds + F.wave * 16384);
    if (fin) { __syncthreads(); if (F.tid == 0) __hip_atomic_fetch_add(fin, 1u, RLX_AGENT); }
    for (;;) {
        __syncthreads();
        if (F.tid == 0) { const unsigned f = fin ? __hip_atomic_load(fin, RLX_AGENT) : 0xffffffffu, h = CV_STATIC + __hip_atomic_load(head, RLX_AGENT);
            slot[1] = f; slot[0] = (h >= (unsigned)need && f >= (unsigned)F.G) ? 0x7fffffffu : CV_STATIC + __hip_atomic_fetch_add(head, 1u, RLX_AGENT); }
        __syncthreads();
        const int c = (int)slot[0]; const bool others_done = slot[1] >= (unsigned)F.G;
        if (c >= CV_NCLAIM) break;
        { const CvItem c0 = cv_decode(A, c * CV_CLAIM + 2 * F.wave), c1 = cv_decode(A, c * CV_CLAIM + 2 * F.wave + 1); float v0[32], v1[32];
          cv_load(c0.W, c0.N, c0.k0, c0.n0, F.lane, v0); cv_load(c1.W, c1.N, c1.k0, c1.n0, F.lane, v1);
          cv_store(v0, c0.K, c0.WT, c0.drow, scr, c0.k0, F.lane); cv_store(v1, c1.K, c1.WT, c1.drow, scr, c1.k0, F.lane); }
        if (c >= need && others_done) break;
    }
}
__device__ __forceinline__ void p0_cache(const Frame& F_, const Args& A) {
    Frame F = F_; F.tid = opq(F_.tid); F.lane = F.tid & 63;
    const int gt = blockIdx.x * NTHREADS + F.tid, NT = F.G * NTHREADS;
    bf16* CKB = (bf16*)(A.ws + WS_CKB); bf16* CVT = (bf16*)(A.ws + WS_CVT);
    for (int i = gt; i < 2 * 2 * 512 * 1024 / 8; i += NT) { const float* p = A.in[I_CK] + (size_t)i * 8; const f32x4 a = *(const f32x4*)p, b = *(const f32x4*)(p + 4);
        v4u o; o.x = pk2(a.x, a.y); o.y = pk2(a.z, a.w); o.z = pk2(b.x, b.y); o.w = pk2(b.z, b.w); *(v4u*)(CKB + (size_t)i * 8) = o; }
    for (int i = gt; i < 2 * 2 * 64 * 1024; i += NT) {
        const int hd = i & 1023, jb = (i >> 10) & 63, bl = i >> 16; const float* p = A.in[I_CV] + ((size_t)(bl * 512 + jb * 8)) * 1024 + hd;
        v4u o; o.x = pk2(p[0], p[1024]); o.y = pk2(p[2048], p[3072]); o.z = pk2(p[4096], p[5120]); o.w = pk2(p[6144], p[7168]);
        *(v4u*)(CVT + ((size_t)(bl * 8 + (hd >> 7)) * 128 + (hd & 127)) * 512 + jb * 8) = o; }
}
__device__ __forceinline__ void p0_mods_partial(const Frame& F_, const Args& A) {
    Frame F = F_; F.tid = opq(F_.tid); F.lane = F.tid & 63;
    float* MODP = (float*)(A.ws + WS_MODP);
    const float* cc = A.in[I_CCTX]; const float* c1 = A.in[I_C];
    for (int task = F.gw; task < 2 * 32 * 72; task += F.NGW) {
        const int l = task / 2304, r = task % 2304, kc = r / 72, nb = r % 72, n = nb * 256 + F.lane * 4;
        const float* w = A.in[I_MODW] + ((size_t)l * DM + kc * 64) * 18432 + n;
        f32x4 a0 = {0.f, 0.f, 0.f, 0.f}, a1 = a0, a2 = a0;
#pragma unroll 16
        for (int k = 0; k < 64; ++k) { const f32x4 wv = __builtin_nontemporal_load((const f32x4*)(w + (size_t)k * 18432)); const int kk = kc * 64 + k;
            const float s0 = silu_f(cc[kk]), s1 = silu_f(c1[kk]), s2 = silu_f(c1[DM + kk]);
            a0 += wv * s0; a1 += wv * s1; a2 += wv * s2; }
        float* o = MODP + (size_t)kc * 110592 + (size_t)l * 55296 + n;
        *(f32x4*)(o) = a0; *(f32x4*)(o + 18432) = a1; *(f32x4*)(o + 2 * 18432) = a2;
    }
}
__device__ __forceinline__ void p0_mods_reduce(const Frame& F_, const Args& A) {
    Frame F = F_; F.tid = opq(F_.tid); F.lane = F.tid & 63;
    const float* MODP = (const float*)(A.ws + WS_MODP); float* MODS = (float*)(A.ws + WS_MODS);
    for (int idx = blockIdx.x * NTHREADS + F.tid; idx < 110592; idx += F.G * NTHREADS) {
        const int l = idx / 55296, n = idx % 18432; float s = A.in[I_MODB][l * 18432 + n];
#pragma unroll 8
        for (int kc = 0; kc < 32; ++kc) s += MODP[(size_t)kc * 110592 + idx];
        MODS[idx] = s;
    }
}
template <int MODE>
__device__ __forceinline__ void norm_rows(const Frame& F_, const float* x0, const float* x1, float* xcopy, const float* g, const float* mods_l, int slot, bf16* H, float* outf) {
    Frame F = F_; F.tid = opq(F_.tid); F.lane = F.tid & 63;
    for (int row = F.gw; row < MTOK; row += F.NGW) {
        const float* xr = row < NCTX ? x0 + (size_t)row * DM : x1 + (size_t)(row - NCTX) * DM;
        const int cidx = row < NCTX ? 0 : 1 + ((row - NCTX) >> 10);
        f32x4 v[8]; float ss = 0.f;
#pragma unroll
        for (int j = 0; j < 8; ++j) { v[j] = *(const f32x4*)(xr + 4 * F.lane + 256 * j); ss += (v[j].x * v[j].x + v[j].y * v[j].y) + (v[j].z * v[j].z + v[j].w * v[j].w); }
        const float rstd = 1.0f / sqrtf(wave_sum(ss) * (1.0f / DM) + 1e-6f);
        if (MODE == 0) {
            const float* sh = mods_l + (size_t)(cidx * 9 + 3 * slot) * DM; const float* sc = sh + DM;
#pragma unroll
            for (int j = 0; j < 8; ++j) { const int c = 4 * F.lane + 256 * j; const f32x4 gg = *(const f32x4*)(g + c), s1 = *(const f32x4*)(sc + c), s0 = *(const f32x4*)(sh + c);
                const f32x4 y = v[j] * rstd * gg * (s1 + 1.0f) + s0; v2u o; o.x = pk2(y.x, y.y); o.y = pk2(y.z, y.w);
                *(v2u*)(H + (size_t)row * DM + c) = o;
                if (xcopy) *(f32x4*)(xcopy + (size_t)row * DM + c) = v[j]; }
        } else {
#pragma unroll
            for (int j = 0; j < 8; ++j) { const int c = 4 * F.lane + 256 * j; const f32x4 gg = *(const f32x4*)(g + c);
                f32x4 yv = v[j] * rstd * gg;
#if PROBE_ZERO_YS
                if (row >= NCTX) yv = (f32x4){0.f, 0.f, 0.f, 0.f};
#endif
#if PROBE_ZERO_YP
                if (row < NCTX) yv = (f32x4){0.f, 0.f, 0.f, 0.f};
#endif
                *(f32x4*)(outf + (size_t)row * DM + c) = yv; }
        }
    }
}

constexpr int AK_STRIDE = 272, AV_STRIDE = 528, A_K_OFF = 0, A_V_OFF = 69632;
constexpr float NA_SCALE = 0.08838834764831845f;
__device__ __forceinline__ void attn_stage(LAS unsigned char* lds, int tid, const bf16* kbase, size_t kstride, const bf16* vbase, size_t vstride) {
    v4u kx[8], vx[8];
#pragma unroll
    for (int i = 0; i < 8; ++i) { const int idx = tid + 512 * i; kx[i] = *(const v4u*)(kbase + (size_t)(idx >> 4) * kstride + (idx & 15) * 8); }
#pragma unroll
    for (int i = 0; i < 8; ++i) { const int idx = tid + 512 * i; vx[i] = *(const v4u*)(vbase + (size_t)(idx >> 5) * vstride + (idx & 31) * 8); }
#pragma unroll
    for (int i = 0; i < 8; ++i) { const int idx = tid + 512 * i; *(LAS v4u*)(lds + A_K_OFF + (idx >> 4) * AK_STRIDE + (idx & 15) * 16) = kx[i]; }
#pragma unroll
    for (int i = 0; i < 8; ++i) { const int idx = tid + 512 * i; *(LAS v4u*)(lds + A_V_OFF + (idx >> 5) * AV_STRIDE + (idx & 31) * 16) = vx[i]; }
}
template <class KF, class VF>
__device__ __forceinline__ void attn_stage32(LAS unsigned char* lds, int tid, KF kf, VF vf) {
    { const int key = tid >> 1, half = tid & 1; const float* p = kf(key) + 64 * half; LAS unsigned char* dst = lds + A_K_OFF + key * AK_STRIDE + half * 128;
#pragma unroll
      for (int i = 0; i < 8; ++i) { const f32x4 a = *(const f32x4*)(p + 8 * i), b = *(const f32x4*)(p + 8 * i + 4);
          v4u o; o.x = pk2(a.x, a.y); o.y = pk2(a.z, a.w); o.z = pk2(b.x, b.y); o.w = pk2(b.z, b.w); *(LAS v4u*)(dst + 16 * i) = o; } }
    { const int kp = tid >> 2, dq = tid & 3; const float* p0 = vf(2 * kp) + 32 * dq; const float* p1 = vf(2 * kp + 1) + 32 * dq;
#pragma unroll
      for (int i = 0; i < 8; ++i) { const f32x4 a = *(const f32x4*)(p0 + 4 * i), b = *(const f32x4*)(p1 + 4 * i);
#pragma unroll
          for (int j = 0; j < 4; ++j) *(LAS unsigned*)(lds + A_V_OFF + (32 * dq + 4 * i + j) * AV_STRIDE + kp * 4) = pk2(a[j], b[j]); } }
}
__device__ __forceinline__ void attn_load_q32(const float* qrow, int g, bf16x8 (&qf)[4]) {
#pragma unroll
    for (int s = 0; s < 4; ++s) { const f32x4 a = *(const f32x4*)(qrow + 32 * s + 8 * g), b = *(const f32x4*)(qrow + 32 * s + 8 * g + 4);
        v4u o; o.x = pk2(a.x, a.y); o.y = pk2(a.z, a.w); o.z = pk2(b.x, b.y); o.w = pk2(b.z, b.w); qf[s] = __builtin_bit_cast(bf16x8, o); }
}
struct AttnState { float m, l; f32x4 ot[8]; };
template <int NKS, bool LOCAL, class BF>
__device__ __forceinline__ void attn_chunk(LAS unsigned char* lds, const bf16x8 (&qf)[4], AttnState& st, int lane, int t0, BF bias) {
    const int g = lane >> 4, c = lane & 15;
    f32x4 sc[NKS][2];
#pragma unroll
    for (int i = 0; i < NKS; ++i) { const int T0 = LOCAL ? 4 * i + t0 : 2 * i;
#pragma unroll
        for (int a = 0; a < 2; ++a) { f32x4 acc = {0.f, 0.f, 0.f, 0.f};
#pragma unroll
            for (int s = 0; s < 4; ++s) { const bf16x8 kfr = *(const LAS bf16x8*)(lds + A_K_OFF + (16 * (T0 + a) + c) * AK_STRIDE + 64 * s + 16 * g);
                acc = __builtin_amdgcn_mfma_f32_16x16x32_bf16(kfr, qf[s], acc, 0, 0, 0); }
            sc[i][a] = acc; } }
    float mx = -3.0e38f;
#pragma unroll
    for (int i = 0; i < NKS; ++i) { const int T0 = LOCAL ? 4 * i + t0 : 2 * i;
#pragma unroll
        for (int a = 0; a < 2; ++a)
#pragma unroll
            for (int r = 0; r < 4; ++r) { float s = sc[i][a][r] * NA_SCALE; if (LOCAL) s = bias(16 * (T0 + a) + 4 * g + r, s); sc[i][a][r] = s; mx = fmaxf(mx, s); } }
    mx = fmaxf(mx, __shfl_xor(mx, 16)); mx = fmaxf(mx, __shfl_xor(mx, 32));
    const float mnew = fmaxf(st.m, mx), alpha = __expf(st.m - mnew); float sum = 0.f;
#pragma unroll
    for (int i = 0; i < NKS; ++i)
#pragma unroll
        for (int a = 0; a < 2; ++a)
#pragma unroll
            for (int r = 0; r < 4; ++r) { const float p = __expf(sc[i][a][r] - mnew); sc[i][a][r] = p; sum += p; }
    sum += __shfl_xor(sum, 16); sum += __shfl_xor(sum, 32);
    st.l = st.l * alpha + sum; st.m = mnew;
#pragma unroll
    for (int dt = 0; dt < 8; ++dt) st.ot[dt] = st.ot[dt] * alpha;
#pragma unroll
    for (int i = 0; i < NKS; ++i) { const int T0 = LOCAL ? 4 * i + t0 : 2 * i;
        v4u pb; pb.x = pk2(sc[i][0][0], sc[i][0][1]); pb.y = pk2(sc[i][0][2], sc[i][0][3]); pb.z = pk2(sc[i][1][0], sc[i][1][1]); pb.w = pk2(sc[i][1][2], sc[i][1][3]);
        const bf16x8 pfr = __builtin_bit_cast(bf16x8, pb);
#pragma unroll
        for (int dt = 0; dt < 8; ++dt) { const LAS unsigned char* vp = lds + A_V_OFF + (16 * dt + c) * AV_STRIDE + (16 * T0 + 4 * g) * 2;
            const v2u lo = *(const LAS v2u*)vp, hi = *(const LAS v2u*)(vp + 32); v4u av; av.x = lo.x; av.y = lo.y; av.z = hi.x; av.w = hi.y;
            st.ot[dt] = __builtin_amdgcn_mfma_f32_16x16x32_bf16(__builtin_bit_cast(bf16x8, av), pfr, st.ot[dt], 0, 0, 0); } }
}
__device__ __forceinline__ void attn_load_q(const bf16* qrow, int g, bf16x8 (&qf)[4]) {
#pragma unroll
    for (int s = 0; s < 4; ++s) qf[s] = *(const bf16x8*)(qrow + 32 * s + 8 * g);
}
__device__ __forceinline__ void attn_store(const AttnState& st, bf16* orow, int g) {
    const float inv = 1.0f / st.l;
#pragma unroll
    for (int dt = 0; dt < 8; ++dt) { v2u o; o.x = pk2(st.ot[dt][0] * inv, st.ot[dt][1] * inv); o.y = pk2(st.ot[dt][2] * inv, st.ot[dt][3] * inv); *(v2u*)(orow + 16 * dt + 4 * g) = o; }
}
__device__ __forceinline__ void attn_ctx_unit(const Frame& F_, const Args& A, int u) {
    Frame F = F_; F.tid = opq(F_.tid); F.lane = F.tid & 63;
    const int b = u >> 4, h = (u >> 1) & 7, qh = u & 1, g = F.lane >> 4, c = F.lane & 15;
    const bf16* QB = (const bf16*)(A.ws + WS_QB); const bf16* KB = (const bf16*)(A.ws + WS_KB); const bf16* VT = (const bf16*)(A.ws + WS_VT);
    const int row = b * SEQ + qh * 128 + 16 * F.wave + c;
    bf16x8 qf[4];
#if PROBE_QKV32
    { const float* Z3 = (const float*)(A.ws + 736 * MiB); const float* zb = Z3 + (size_t)(b * SEQ) * 3072 + h * 128;
      attn_stage32(F.lds, F.tid, [&](int k) { return zb + (size_t)k * 3072 + 1024; }, [&](int k) { return zb + (size_t)k * 3072 + 2048; });
      attn_load_q32(Z3 + (size_t)row * 3072 + h * 128, g, qf); }
#else
    attn_stage(F.lds, F.tid, KB + (size_t)(b * SEQ) * 1024 + h * 128, 1024, VT + (size_t)(b * 8 + h) * 128 * 256, 256);
    attn_load_q(QB + (size_t)row * 1024 + h * 128, g, qf);
#endif
    AttnState st; st.m = -3.0e38f; st.l = 0.f;
#pragma unroll
    for (int dt = 0; dt < 8; ++dt) st.ot[dt] = (f32x4){0.f, 0.f, 0.f, 0.f};
    __syncthreads();
    attn_chunk<8, false>(F.lds, qf, st, F.lane, 0, [](int, float s) { return s; });
    attn_store(st, (bf16*)(A.ws + WS_OB) + (size_t)row * 1024 + h * 128, g);
}
__device__ __forceinline__ void attn_na_unit(const Frame& F_, const Args& A, int u, int layer) {
    Frame F = F_; F.tid = opq(F_.tid); F.lane = F.tid & 63;
    const int b = u >> 7, h = (u >> 4) & 7, r = u & 15, g = F.lane >> 4, c = F.lane & 15, w = F.wave;
    const bf16* QB = (const bf16*)(A.ws + WS_QB); const bf16* KB = (const bf16*)(A.ws + WS_KB); const bf16* VT = (const bf16*)(A.ws + WS_VT);
    const int kr0 = min(max(r - 4, 0), 8);
    const int qc = 8 * w + (c & 7), row = NCTX + b * DSEQ + r * 64 + qc;
    const int wstart = min(max(qc - 8, 0), 48), t0 = min(max(8 * w - 8, 0), 40) >> 4;
    const float* rpb = A.in[I_RPB] + (size_t)(layer * 8 + h) * 15 * 31;
    bf16x8 qf[4];
#if PROBE_QKV32
    attn_load_q32((const float*)(A.ws + 736 * MiB) + (size_t)row * 3072 + h * 128, g, qf);
#else
    attn_load_q(QB + (size_t)row * 1024 + h * 128, g, qf);
#endif
    AttnState st; st.m = -3.0e38f; st.l = 0.f;
#pragma unroll
    for (int dt = 0; dt < 8; ++dt) st.ot[dt] = (f32x4){0.f, 0.f, 0.f, 0.f};
#if PROBE_QKV32
    const float* Z3 = (const float*)(A.ws + 736 * MiB); const float* zl = Z3 + (size_t)(NCTX + b * DSEQ) * 3072 + h * 128;
    for (int ci = 0; ci < 2; ++ci) {
        const int krow = kr0 + 4 * ci;
        if (ci) __syncthreads();
        attn_stage32(F.lds, F.tid, [&](int k) { return zl + (size_t)(krow * 64 + k) * 3072 + 1024; }, [&](int k) { return zl + (size_t)(krow * 64 + k) * 3072 + 2048; });
        __syncthreads();
        attn_chunk<4, true>(F.lds, qf, st, F.lane, t0, [&](int kk, float s) {
            const int ky = krow + (kk >> 6), kx = kk & 63; const bool ok = kx >= wstart && kx < wstart + 16;
            const int dy = ky - r + 7, dx = min(max(kx - qc + 15, 0), 30);
            return ok ? s + rpb[dy * 31 + dx] : -1.0e30f; });
    }
    const float* ck = A.in[I_CK] + ((size_t)(b * 2 + layer) * 512 * 8 + h) * 128; const float* cv = A.in[I_CV] + ((size_t)(b * 2 + layer) * 512 * 8 + h) * 128;
    for (int ci = 0; ci < 2; ++ci) {
        __syncthreads();
        attn_stage32(F.lds, F.tid, [&](int k) { return ck + (size_t)(ci * 256 + k) * 1024; }, [&](int k) { return cv + (size_t)(ci * 256 + k) * 1024; });
        __syncthreads();
        attn_chunk<8, false>(F.lds, qf, st, F.lane, 0, [](int, float s) { return s; });
    }
#else
    const bf16* kl = KB + (size_t)(NCTX + b * DSEQ) * 1024 + h * 128; const bf16* vl = VT + (size_t)4096 * 1024 + (size_t)(b * 8 + h) * 128 * 1024;
    for (int ci = 0; ci < 2; ++ci) {
        const int krow = kr0 + 4 * ci;
        if (ci) __syncthreads();
        attn_stage(F.lds, F.tid, kl + (size_t)(krow * 64) * 1024, 1024, vl + krow * 64, 1024);
        __syncthreads();
        attn_chunk<4, true>(F.lds, qf, st, F.lane, t0, [&](int kk, float s) {
            const int ky = krow + (kk >> 6), kx = kk & 63; const bool ok = kx >= wstart && kx < wstart + 16;
            const int dy = ky - r + 7, dx = min(max(kx - qc + 15, 0), 30);
            return ok ? s + rpb[dy * 31 + dx] : -1.0e30f; });
    }
    const bf16* ck = (const bf16*)(A.ws + WS_CKB) + (size_t)(b * 2 + layer) * 512 * 1024 + h * 128; const bf16* cv = (const bf16*)(A.ws + WS_CVT) + (size_t)((b * 2 + layer) * 8 + h) * 128 * 512;
    for (int ci = 0; ci < 2; ++ci) {
        __syncthreads();
        attn_stage(F.lds, F.tid, ck + (size_t)(ci * 256) * 1024, 1024, cv + ci * 256, 512);
        __syncthreads();
        attn_chunk<8, false>(F.lds, qf, st, F.lane, 0, [](int, float s) { return s; });
    }
#endif
    if (c < 8) attn_store(st, (bf16*)(A.ws + WS_OB) + (size_t)row * 1024 + h * 128, g);
}

__device__ __forceinline__ int hg_slot(int s, int h, int dir, int c) { return s < 16 ? s * 32 + c * 8 + h * 2 + dir : 512 + (s - 16) * 128 + c * 8 + h * 2 + dir; }
template <int CTRL> __device__ __forceinline__ float dpp_xor(float v) { return __builtin_bit_cast(float, __builtin_amdgcn_update_dpp(0, __builtin_bit_cast(int, v), CTRL, 0xf, 0xf, true)); }
__device__ __forceinline__ void hgrn_local_unit(const Frame& F_, const Args& A, int u, int layer) {
    Frame F = F_; F.tid = opq(F_.tid); F.lane = F.tid & 63;
    int s, c, hd;
    if (u < 512) { s = u >> 5; c = (u >> 3) & 3; hd = u & 7; } else { const int v = u - 512; s = 16 + (v >> 7); c = (v >> 3) & 15; hd = v & 7; }
    const int h = hd >> 1, dir = hd & 1, tokbase = s < 16 ? s * SEQ : NCTX + (s - 16) * DSEQ, g = F.lane >> 4, c15 = F.lane & 15, w = F.wave;
    const float* Z = (const float*)(A.ws + WS_ZF);
    constexpr int LS = 132, AS = 68;
    LAS float* Qt = (LAS float*)F.lds; LAS float* Kt = Qt + 64 * LS; LAS float* Vs = Kt + 64 * LS; LAS float* Bs = Vs + 64 * LS; LAS float* SC = Bs + 64 * LS; LAS float* As = Bs;
    const int d = F.tid & 127, I4 = F.tid >> 7;
    {   float lbv = 0.f;
        if (layer == 1) { const float* lg = A.in[I_LBL]; lbv = sigmoid_f(lg[1024 + dir * 512 + h * 128 + d] - lg[dir * 512 + h * 128 + d]); }
        float zq[16], zf[16], zv[16];
#pragma unroll
        for (int k = 0; k < 16; ++k) { const int i = 16 * I4 + k, t = dir ? 64 * c + 63 - i : 64 * c + i; const float* zr = Z + (size_t)(tokbase + t) * ZFW + h * 128 + d;
            zq[k] = zr[ZQ]; zf[k] = zr[dir ? ZFB : ZFF]; zv[k] = zr[ZI]; }
        float b = 0.f;
#pragma unroll
        for (int k = 0; k < 16; ++k) { const int i = 16 * I4 + k; const float f = lbv + (1.f - lbv) * sigmoid_f(zf[k]);
            b += __logf(fmaxf(f, 1e-30f));
            Qt[i * LS + d] = silu_f(zq[k]); Kt[i * LS + d] = (1.f - lbv) * sigmoid_f(-zf[k]); Vs[i * LS + d] = zv[k]; Bs[i * LS + d] = b; }
    }
    __syncthreads();
    {
        float* QD = (float*)(A.ws + WS_HQD);
        const float t0 = Bs[15 * LS + d], t1 = Bs[31 * LS + d], t2 = Bs[47 * LS + d], t3 = Bs[63 * LS + d];
        const float bsI = I4 == 0 ? 0.f : I4 == 1 ? t0 : I4 == 2 ? t0 + t1 : t0 + t1 + t2, totI = I4 == 0 ? t0 : I4 == 1 ? t1 : I4 == 2 ? t2 : t3;
#pragma unroll
        for (int k = 0; k < 16; ++k) { const int i = 16 * I4 + k, t = dir ? 64 * c + 63 - i : 64 * c + i;
            const float bl = Bs[i * LS + d], q = Qt[i * LS + d], kk = Kt[i * LS + d], e1 = __expf(bl);
            QD[((size_t)(tokbase + t) * 2 + dir) * 512 + h * 128 + d] = q * e1 * __expf(bsI);
            Qt[i * LS + d] = q * e1; Kt[i * LS + d] = kk * __expf(totI - bl); }
        for (int idx = F.tid; idx < 14 * 128; idx += NTHREADS) { const int v = idx >> 7, dd = idx & 127;
            const float u0 = Bs[15 * LS + dd], u1 = Bs[31 * LS + dd], u2 = Bs[47 * LS + dd], u3 = Bs[63 * LS + dd];
            float x;
            if (v < 6) x = v == 0 ? 0.f : v == 1 ? u1 : v == 2 ? 0.f : v == 3 ? u1 + u2 : v == 4 ? u2 : 0.f;
            else if (v < 10) x = -(v == 6 ? u0 : v == 7 ? u1 : v == 8 ? u2 : u3);
            else x = v == 10 ? u1 + u2 + u3 : v == 11 ? u2 + u3 : v == 12 ? u3 : 0.f;
            SC[idx] = __expf(x);
            if (v == 13) ((float*)(A.ws + WS_HDEC))[(size_t)u * 128 + dd] = __expf(u0 + u1 + u2 + u3); }
    }
    __syncthreads();
    {
        float av[16];
#pragma unroll
        for (int ks = 0; ks < 16; ++ks) { const int j = 4 * ks + g; av[ks] = Kt[j * LS + 16 * w + c15] * SC[(10 + (j >> 4)) * 128 + 16 * w + c15]; }
        float* SL = (float*)(A.ws + WS_HSL) + (size_t)u * 16384;
        for (int et = 0; et < 8; ++et) { f32x4 acc = {0.f, 0.f, 0.f, 0.f};
#pragma unroll
            for (int ks = 0; ks < 16; ++ks) acc = __builtin_amdgcn_mfma_f32_16x16x4f32(av[ks], Vs[(4 * ks + g) * LS + 16 * et + c15], acc, 0, 0, 0);
#pragma unroll
            for (int r = 0; r < 4; ++r) SL[(16 * w + 4 * g + r) * 128 + 16 * et + c15] = acc[r]; }
    }
    for (int tl = w; tl < 10; tl += 8) {
        int I, J, sv;
        if (tl < 4) { I = tl; J = tl; sv = 6 + tl; } else { const int v = tl - 4; I = v < 1 ? 1 : (v < 3 ? 2 : 3); J = v < 1 ? 0 : (v < 3 ? v - 1 : v - 3); sv = v; }
        f32x4 acc = {0.f, 0.f, 0.f, 0.f};
#pragma unroll 8
        for (int ks = 0; ks < 32; ++ks) { const int dd = 4 * ks + g;
            acc = __builtin_amdgcn_mfma_f32_16x16x4f32(Qt[(16 * I + c15) * LS + dd] * SC[sv * 128 + dd], Kt[(16 * J + c15) * LS + dd], acc, 0, 0, 0); }
#pragma unroll
        for (int r = 0; r < 4; ++r) As[(16 * I + 4 * g + r) * AS + 16 * J + c15] = (I == J && c15 > 4 * g + r) ? 0.f : acc[r];
    }
    __syncthreads();
    {   float* OL = (float*)(A.ws + WS_HOL);
#pragma unroll
        for (int I = 0; I < 4; ++I) { f32x4 acc = {0.f, 0.f, 0.f, 0.f};
            for (int ks = 0; ks < 4 * (I + 1); ++ks) acc = __builtin_amdgcn_mfma_f32_16x16x4f32(As[(16 * I + c15) * AS + 4 * ks + g], Vs[(4 * ks + g) * LS + 16 * w + c15], acc, 0, 0, 0);
#pragma unroll
            for (int r = 0; r < 4; ++r) { const int i = 16 * I + 4 * g + r, t = dir ? 64 * c + 63 - i : 64 * c + i; OL[((size_t)(tokbase + t) * 2 + dir) * 512 + h * 128 + 16 * w + c15] = acc[r]; } }
    }
}
__device__ __forceinline__ void hgrn_final_unit(const Frame& F_, const Args& A, int u, int layer) {
    Frame F = F_; F.tid = opq(F_.tid); F.lane = F.tid & 63;
    int s, c, h, nC;
    if (u < 128) { s = 16 + (u >> 6); c = (u >> 2) & 15; h = u & 3; nC = 16; } else { const int v = u - 128; s = v >> 4; c = (v >> 2) & 3; h = v & 3; nC = 4; }
    const int tokbase = s < 16 ? s * SEQ : NCTX + (s - 16) * DSEQ, g = F.lane >> 4, c15 = F.lane & 15, w = F.wave;
    constexpr int LS = 132;
    LAS float* Ss = (LAS float*)F.lds; LAS float* Qd = Ss + 128 * LS; LAS float* Os = Qd + 64 * LS;
    const float* HSL = (const float*)(A.ws + WS_HSL); const float* HDEC = (const float*)(A.ws + WS_HDEC); const float* QD = (const float*)(A.ws + WS_HQD);
    f32x4 acc[4];
#pragma unroll
    for (int tt = 0; tt < 4; ++tt) acc[tt] = (f32x4){0.f, 0.f, 0.f, 0.f};
    for (int dir = 0; dir < 2; ++dir) {
        f32x4 S[8];
        if (s >= 16) { const float* s0 = A.in[I_SHG] + ((size_t)(((s - 16) * 2 + layer) * 2 + dir) * 4 + h) * 16384;
#pragma unroll
            for (int j = 0; j < 8; ++j) S[j] = *(const f32x4*)(s0 + 4 * (F.tid + 512 * j)); }
        else {
#pragma unroll
            for (int j = 0; j < 8; ++j) S[j] = (f32x4){0.f, 0.f, 0.f, 0.f}; }
        const int nprev = dir ? nC - 1 - c : c;
        if (nprev > 0) {
            f32x4 cur[8]; float dcur[8];
            { const int sl = hg_slot(s, h, dir, dir ? nC - 1 : 0);
#pragma unroll
              for (int j = 0; j < 8; ++j) { const int idx4 = F.tid + 512 * j; dcur[j] = HDEC[(size_t)sl * 128 + (idx4 >> 5)]; cur[j] = *(const f32x4*)(HSL + (size_t)sl * 16384 + 4 * idx4); } }
            for (int q = 0; q < nprev; ++q) {
                f32x4 nxt[8]; float dnx[8];
                const int qn = q + 1 < nprev ? q + 1 : q, sl = hg_slot(s, h, dir, dir ? nC - 1 - qn : qn);
#pragma unroll
                for (int j = 0; j < 8; ++j) { const int idx4 = F.tid + 512 * j; dnx[j] = HDEC[(size_t)sl * 128 + (idx4 >> 5)]; nxt[j] = *(const f32x4*)(HSL + (size_t)sl * 16384 + 4 * idx4); }
#pragma unroll
                for (int j = 0; j < 8; ++j) { S[j] = S[j] * dcur[j] + cur[j]; cur[j] = nxt[j]; dcur[j] = dnx[j]; }
            }
        }
        if (s < 16 && (dir ? c == 0 : c == nC - 1)) {
            const int sl = hg_slot(s, h, dir, c); float* so = A.out + OUT_SH + ((size_t)((s * 2 + layer) * 2 + dir) * 4 + h) * 16384;
#pragma unroll
            for (int j = 0; j < 8; ++j) { const int idx4 = F.tid + 512 * j; const float dc = HDEC[(size_t)sl * 128 + (idx4 >> 5)];
                *(f32x4*)(so + 4 * idx4) = S[j] * dc + *(const f32x4*)(HSL + (size_t)sl * 16384 + 4 * idx4); } }
        if (dir) __syncthreads();
#pragma unroll
        for (int j = 0; j < 8; ++j) { const int idx4 = F.tid + 512 * j; *(LAS f32x4*)(Ss + (idx4 >> 5) * LS + 4 * (idx4 & 31)) = S[j]; }
#pragma unroll
        for (int j = 0; j < 4; ++j) { const int idx4 = F.tid + 512 * j, i = idx4 >> 5;
            *(LAS f32x4*)(Qd + i * LS + 4 * (idx4 & 31)) = *(const f32x4*)(QD + ((size_t)(tokbase + 64 * c + i) * 2 + dir) * 512 + h * 128 + 4 * (idx4 & 31)); }
        __syncthreads();
        for (int ks = 0; ks < 32; ++ks) { const float bv = Ss[(4 * ks + g) * LS + 16 * w + c15];
#pragma unroll
            for (int tt = 0; tt < 4; ++tt) acc[tt] = __builtin_amdgcn_mfma_f32_16x16x4f32(Qd[(16 * tt + c15) * LS + 4 * ks + g], bv, acc[tt], 0, 0, 0); }
    }
    const float* OL = (const float*)(A.ws + WS_HOL);
#pragma unroll
    for (int tt = 0; tt < 4; ++tt)
#pragma unroll
        for (int r = 0; r < 4; ++r) { const int t = 16 * tt + 4 * g + r; const float* ol = OL + (size_t)(tokbase + 64 * c + t) * 1024 + h * 128 + 16 * w + c15;
            Os[t * LS + 16 * w + c15] = acc[tt][r] + ol[0] + ol[512]; }
    __syncthreads();
    {
        const int t = F.tid >> 3, seg = F.tid & 7; const size_t row = (size_t)(tokbase + 64 * c + t);
        f32x4 o[4]; float ss = 0.f;
#pragma unroll
        for (int j = 0; j < 4; ++j) { o[j] = *(const LAS f32x4*)(Os + t * LS + 16 * seg + 4 * j); ss += (o[j].x * o[j].x + o[j].y * o[j].y) + (o[j].z * o[j].z + o[j].w * o[j].w); }
        ss += __shfl_xor(ss, 1); ss += __shfl_xor(ss, 2); ss += __shfl_xor(ss, 4);
        const float rstd = 1.0f / sqrtf(ss * (1.0f / 128.f) + 1e-6f);
        const float* gn = A.in[I_HGN] + (size_t)(layer * 4 + h) * 128 + 16 * seg; const float* zo = (const float*)(A.ws + WS_ZF) + row * ZFW + ZO + h * 128 + 16 * seg;
        unsigned pk[8];
#pragma unroll
        for (int j = 0; j < 4; ++j) { const f32x4 gg = *(const f32x4*)(gn + 4 * j), zz = *(const f32x4*)(zo + 4 * j);
            pk[2 * j] = pk2(o[j].x * rstd * gg.x * silu_f(zz.x), o[j].y * rstd * gg.y * silu_f(zz.y)); pk[2 * j + 1] = pk2(o[j].z * rstd * gg.z * silu_f(zz.z), o[j].w * rstd * gg.w * silu_f(zz.w)); }
        bf16* oa = (bf16*)(A.ws + WS_OA) + row * 512 + h * 128 + 16 * seg;
        *(v4u*)oa = (v4u){pk[0], pk[1], pk[2], pk[3]}; *(v4u*)(oa + 8) = (v4u){pk[4], pk[5], pk[6], pk[7]};
    }
}

__device__ __forceinline__ float neg_expm1(float x) {
    return x > -0.03f ? -x * (1.f + x * (0.5f + x * (0.16666667f + x * 0.041666668f))) : 1.f - __expf(x);
}
__device__ __forceinline__ void lru_gate_unit(const Frame& F_, const Args& A, int u, int layer) {
    Frame F = F_; F.tid = opq(F_.tid); F.lane = F.tid & 63;
    const int k = u & 7, tt = (u >> 3) * 8 + F.wave, lane = F.lane, g = lane >> 4, c15 = lane & 15, r0 = 16 * tt;
    const int sstart = r0 < NCTX ? (r0 & ~255) : NCTX + ((r0 - NCTX) & ~1023), send = sstart + (r0 < NCTX ? SEQ : DSEQ);
    const float* Z = (const float*)(A.ws + WS_ZF);
    constexpr int WS_ = 68;
    LAS float* xs = (LAS float*)(F.lds + F.wave * 12544); LAS float* au = xs + 1088;
    LAS float* Wa = (LAS float*)(F.lds + 8 * 12544); LAS float* Wx = Wa + 64 * WS_;
    {   const int ch = 64 * k + lane; const float* cw = A.in[I_CONVW] + (size_t)layer * 4 * 512 + ch; const float w0 = cw[0], w1 = cw[512], w2 = cw[1024], w3 = cw[1536], cb = A.in[I_CONVB][layer * 512 + ch];
        float lx[19];
#pragma unroll
        for (int j = 0; j < 19; ++j) { const int row = r0 - 2 + j; lx[j] = (row >= sstart && row < send) ? Z[(size_t)row * ZFW + ZLX + ch] : 0.f; }
#pragma unroll
        for (int j = 0; j < 16; ++j) xs[j * 65 + lane] = cb + w0 * lx[j] + w1 * lx[j + 1] + w2 * lx[j + 2] + w3 * lx[j + 3]; }
    float* LHL = (float*)(A.ws + WS_LHL); float* LPP = (float*)(A.ws + WS_LPP);
    for (int dir = 0; dir < 2; ++dir) {
        if (dir) __syncthreads();
        {   const float* wsa = A.in[I_LWA] + (size_t)((layer * 2 + dir) * 8 + k) * 4096; const float* wsx = A.in[I_LWX] + (size_t)((layer * 2 + dir) * 8 + k) * 4096;
#pragma unroll
            for (int j = 0; j < 2; ++j) { const int r4 = F.tid + 512 * j;
                *(LAS f32x4*)(Wa + (r4 >> 4) * WS_ + 4 * (r4 & 15)) = *(const f32x4*)(wsa + 4 * r4); *(LAS f32x4*)(Wx + (r4 >> 4) * WS_ + 4 * (r4 & 15)) = *(const f32x4*)(wsx + 4 * r4); } }
        __syncthreads();
        f32x4 aa[4], ax[4];
#pragma unroll
        for (int jt = 0; jt < 4; ++jt) { aa[jt] = (f32x4){0.f, 0.f, 0.f, 0.f}; ax[jt] = aa[jt]; }
#pragma unroll 4
        for (int ks = 0; ks < 16; ++ks) { const float a = xs[c15 * 65 + 4 * ks + g];
#pragma unroll
            for (int jt = 0; jt < 4; ++jt) { const int wi = (4 * ks + g) * WS_ + 16 * jt + c15;
                aa[jt] = __builtin_amdgcn_mfma_f32_16x16x4f32(a, Wa[wi], aa[jt], 0, 0, 0); ax[jt] = __builtin_amdgcn_mfma_f32_16x16x4f32(a, Wx[wi], ax[jt], 0, 0, 0); } }
        const int pb = (layer * 2 + dir) * 512 + 64 * k;
#pragma unroll
        for (int jt = 0; jt < 4; ++jt) { const int chl = 16 * jt + c15; const float ba = A.in[I_LBA][pb + chl], bx = A.in[I_LBX][pb + chl], sp = log1pf(__expf(-A.in[I_LAM][pb + chl]));
#pragma unroll
            for (int r = 0; r < 4; ++r) { const int j = 4 * g + r; const float rg = sigmoid_f(aa[jt][r] + ba), ig = sigmoid_f(ax[jt][r] + bx);
                const float la = -8.0f * rg * sp, av = __expf(la), mult = __builtin_amdgcn_sqrtf(neg_expm1(2.0f * la)), uv = mult * ig * xs[j * 65 + chl];
                au[(j * 64 + chl) * 2] = av; au[(j * 64 + chl) * 2 + 1] = uv; } }
        LDS_WAIT(); asm volatile("" ::: "memory");
        float hh = 0.f, P = 1.f;
#pragma unroll
        for (int jj = 0; jj < 16; ++jj) { const int j = dir ? 15 - jj : jj; const float av = au[(j * 64 + lane) * 2], uv = au[(j * 64 + lane) * 2 + 1];
            hh = av * hh + uv; P *= av; const size_t o = ((size_t)(r0 + j) * 2 + dir) * 512 + 64 * k + lane; LHL[o] = hh; LPP[o] = P; }
        LDS_WAIT(); asm volatile("" ::: "memory");
    }
}
__device__ __forceinline__ float gelu_tanh(float x) { const float t = 0.7978845608028654f * (x + 0.044715f * x * x * x); return 0.5f * x * (1.0f + tanhf(t)); }
__device__ __forceinline__ void lru_final_unit(const Frame& F_, const Args& A, int tt, int layer) {
    Frame F = F_; F.tid = opq(F_.tid); F.lane = F.tid & 63;
    const int ch = F.tid, r0 = 16 * tt;
    const int s = r0 < NCTX ? r0 >> 8 : 16 + ((r0 - NCTX) >> 10), f0 = (r0 < NCTX ? (r0 & ~255) : NCTX + ((r0 - NCTX) & ~1023)) >> 4, nt = r0 < NCTX ? 16 : 64;
    const float* LHL = (const float*)(A.ws + WS_LHL); const float* LPP = (const float*)(A.ws + WS_LPP); const float* Z = (const float*)(A.ws + WS_ZF);
    float cf = 0.f, cb = 0.f;
    if (s >= 16) { const float* h0 = A.in[I_SLRU] + (size_t)((s - 16) * 2 + layer) * 1024; cf = h0[ch]; cb = h0[512 + ch]; }
    {   int j = f0;
        for (; j + 8 <= tt; j += 8) { float hv[8], pv[8];
#pragma unroll
            for (int q = 0; q < 8; ++q) { const size_t o = ((size_t)(16 * (j + q) + 15) * 2 + 0) * 512 + ch; hv[q] = LHL[o]; pv[q] = LPP[o]; }
#pragma unroll
            for (int q = 0; q < 8; ++q) cf = hv[q] + pv[q] * cf; }
        for (; j < tt; ++j) { const size_t o = ((size_t)(16 * j + 15) * 2 + 0) * 512 + ch; cf = LHL[o] + LPP[o] * cf; } }
    {   int j = f0 + nt - 1;
        for (; j - 8 >= tt; j -= 8) { float hv[8], pv[8];
#pragma unroll
            for (int q = 0; q < 8; ++q) { const size_t o = ((size_t)(16 * (j - q)) * 2 + 1) * 512 + ch; hv[q] = LHL[o]; pv[q] = LPP[o]; }
#pragma unroll
            for (int q = 0; q < 8; ++q) cb = hv[q] + pv[q] * cb; }
        for (; j > tt; --j) { const size_t o = ((size_t)(16 * j) * 2 + 1) * 512 + ch; cb = LHL[o] + LPP[o] * cb; } }
    bf16* OC = (bf16*)(A.ws + WS_OC);
#pragma unroll 4
    for (int i = 0; i < 16; ++i) { const size_t row = (size_t)(r0 + i), o0 = (row * 2) * 512 + ch, o1 = o0 + 512;
        const float hf = LHL[o0] + LPP[o0] * cf, hb = LHL[o1] + LPP[o1] * cb, y = (hf + hb) * gelu_tanh(Z[row * ZFW + ZLG + ch]);
        OC[row * 512 + ch] = (bf16)f2bf(y);
        if (s < 16) { if (i == 15 && tt == f0 + nt - 1) A.out[OUT_SL + (size_t)((s * 2 + layer) * 2 + 0) * 512 + ch] = hf;
                      if (i == 0 && tt == f0) A.out[OUT_SL + (size_t)((s * 2 + layer) * 2 + 1) * 512 + ch] = hb; } }
}

#ifndef DUP_P0C
#define DUP_P0C 0
#endif
#ifndef DUP_P0M
#define DUP_P0M 0
#endif
#ifndef DUP_H1
#define DUP_H1 0
#endif
#ifndef DUP_UP1
#define DUP_UP1 0
#endif
#ifndef DUP_NA
#define DUP_NA 0
#endif
#ifndef DUP_CA
#define DUP_CA 0
#endif
#ifndef DUP_L1
#define DUP_L1 0
#endif
#ifndef DUP_H3
#define DUP_H3 0
#endif
#ifndef DUP_L2
#define DUP_L2 0
#endif
#ifndef DUP_NORM
#define DUP_NORM 0
#endif
#ifndef PROBE_NOCACHE
#define PROBE_NOCACHE 0
#endif
#ifndef PROBE_MEMSET
#define PROBE_MEMSET 0
#endif
#ifndef MK_N_LAUNCHES
#define MK_N_LAUNCHES 1
#endif
constexpr int N_PHASES = 3 + 12 * DEPTH;
constexpr int MT_N2K = 3;
__global__ void __launch_bounds__(NTHREADS, 2) trunk_fwd(Args A) {
    extern __shared__ __attribute__((aligned(16))) unsigned char lds_raw[];
    Frame F; F.lds = (LAS unsigned char*)lds_raw; F.tid = threadIdx.x; F.lane = F.tid & 63; F.wave = __builtin_amdgcn_readfirstlane(F.tid >> 6);
    F.G = gridDim.x; F.gw = blockIdx.x * NWAVES + F.wave; F.NGW = F.G * NWAVES;
    volatile LAS unsigned* MISC = (volatile LAS unsigned*)(F.lds + LDSCTL_OFF);
    for (int u = F.tid; u < (LDS_BYTES - LDSCTL_OFF) / 4; u += NTHREADS) MISC[u] = 0u;
    __syncthreads();
    gu32* ctl = (gu32*)(A.ws + WS_CTL);
    XcdBarrier bar; bar.bar = (unsigned*)(ctl + CW_BAR); bar.x = 0; bar.st = nullptr;
    if (MK_N_LAUNCHES == 1) bar = xcd_barrier_post((unsigned*)(ctl + CW_BAR), MISC + 8);
    const int lo = A.ph_lo, hi = A.ph_hi;
#define IN(k) (lo <= (k) && (k) < hi)
#define SEAM(k) do { if (IN(k) && IN((k) + 1)) { XcdBarrier b2_ = bar; asm volatile("" : "+s"(b2_.bar)); xcd_barrier(b2_); } } while (0)
    gu32* cvq = ctl + CW_Q + 30 * 64;
#define CV_END(l_, j_, gemm_) do { if (CV_BACKGROUND && IN(3 + 12 * (l_) + (j_))) cv_until(F, A, cvq, cv_need((l_), (j_)), (gemm_) ? ctl + CW_Q + (32 + 12 * (l_) + (j_)) * 64 : (gu32*)nullptr, MISC + 20); } while (0)
    unsigned char* ws = A.ws;
    float* X = (float*)(ws + WS_X); bf16* H = (bf16*)(ws + WS_H); bf16* HID = (bf16*)(ws + WS_HID);
    float* MODS = (float*)(ws + WS_MODS);
    LAS unsigned char* ring = F.lds;

#ifndef NO_P0
    if (IN(0)) { p0_convert(F, A); p0_mods_partial(F, A);
#if !PROBE_NOCACHE
        p0_cache(F, A);
#endif
    }
#if DUP_P0C
    if (IN(0)) { __syncthreads(); p0_convert(F, A); }
#endif
#if DUP_P0M
    if (IN(0)) { __syncthreads(); p0_mods_partial(F, A); }
#endif
    #endif
        SEAM(0);
#ifndef NO_P1
    if (IN(1)) p0_mods_reduce(F, A);
    #endif
        SEAM(1);
#ifndef NO_P2
    if (IN(2)) norm_rows<0>(F, A.in[I_XP], A.in[I_XS], X, A.in[I_NORMG], MODS, 0, H, nullptr);
    #endif
        SEAM(2);

    for (int l = 0; l < DEPTH; ++l) {
        const int pb = 3 + 12 * l;
        unsigned char* wl = ws + WS_W + (size_t)l * W_LAYER;
        const float* mods_l = MODS + (size_t)l * 3 * 9 * DM;
        const float* ng = A.in[I_NORMG] + (size_t)l * 3 * DM;
#ifndef NO_G0
        if (IN(pb + 0)) { pg8::Gemm g{H, (const bf16*)(wl + WO_UP1), MTOK, 2 * DFF, DM}; pg8::StaticOrder S; S.init(MTOK, 2 * DFF, F.G, (int)blockIdx.x);
            pg8::EpiSwiglu E{HID, DFF}; pg8::gemm_phase<pg8::EpiSwiglu, pg8::StaticOrder, true, true>(ring, g, S, E);
#if DUP_UP1
            __syncthreads(); pg8::gemm_phase<pg8::EpiSwiglu, pg8::StaticOrder, true, true>(ring, g, S, E);
#endif
        }
        #endif
        CV_END(l, 0, 1);
        SEAM(pb + 0);
#ifndef NO_G1
        if (IN(pb + 1)) { pg8::Gemm g{HID, (const bf16*)(wl + WO_DN1), MTOK, DM, DFF}; pg8::StaticOrder S; S.init(MTOK, DM, F.G, (int)blockIdx.x, 64 * MT_N2K);
            pg8::EpiResid E{X, DM, mods_l, 0, 0.5f}; pg8::gemm_phase<pg8::EpiResid, pg8::StaticOrder, true, true, MT_N2K>(ring, g, S, E); }
        #endif
        CV_END(l, 1, 1);
        SEAM(pb + 1);
#ifndef NO_N2
        if (IN(pb + 2)) norm_rows<0>(F, X, X + (size_t)NCTX * DM, nullptr, ng + DM, mods_l, 1, H, nullptr);
#if DUP_NORM
        if (IN(pb + 2)) norm_rows<0>(F, X, X + (size_t)NCTX * DM, nullptr, ng + DM, mods_l, 1, H, nullptr);
#endif
        #endif
        CV_END(l, 2, 0);
        SEAM(pb + 2);
#ifndef NO_G3
        if (IN(pb + 3)) { pg8::Gemm g{H, (const bf16*)(wl + WO_IN), MTOK, DIN, DM}; pg8::StaticOrder S; S.init(MTOK, DIN, F.G, (int)blockIdx.x);
            pg8::EpiZ E{(float*)(ws + WS_ZF), (bf16*)(ws + WS_QB), (bf16*)(ws + WS_KB), (bf16*)(ws + WS_VT), (bf16*)(ws + WS_GB), A.out + OUT_K, A.out + OUT_V, l, (float*)(ws + 736 * MiB)}; pg8::gemm_phase<pg8::EpiZ, pg8::StaticOrder, true, true>(ring, g, S, E); }
        #endif
        CV_END(l, 3, 1);
        SEAM(pb + 3);
        if (IN(pb + 4)) {
            gu32* q = ctl + CW_Q + (l * 8) * 64;
            #ifndef NO_H1
            for (int u; (u = next_unit(q + 0 * 64, MISC + 16)) < 768;) hgrn_local_unit(F, A, u, l);
#endif
#if DUP_H1
            for (int u; (u = next_unit(q + 6 * 64, MISC + 16)) < 768;) hgrn_local_unit(F, A, u, l);
#endif
            #ifndef NO_NA
            for (int u; (u = next_unit(q + 1 * 64, MISC + 16)) < 256;) attn_na_unit(F, A, u, l);
#endif
#if DUP_NA
            for (int u; (u = next_unit(q + 6 * 64, MISC + 16)) < 256;) attn_na_unit(F, A, u, l);
#endif
            #ifndef NO_CA
            for (int u; (u = next_unit(q + 2 * 64, MISC + 16)) < 256;) attn_ctx_unit(F, A, u);
#endif
#if DUP_CA
            for (int u; (u = next_unit(q + 6 * 64, MISC + 16)) < 256;) attn_ctx_unit(F, A, u);
#endif
            #ifndef NO_L1
            for (int u; (u = next_unit(q + 3 * 64, MISC + 16)) < 384;) lru_gate_unit(F, A, u, l);
#endif
#if DUP_L1
            for (int u; (u = next_unit(q + 6 * 64, MISC + 16)) < 384;) lru_gate_unit(F, A, u, l);
#endif
        }
        CV_END(l, 4, 0);
        SEAM(pb + 4);
        if (IN(pb + 5)) {
            gu32* q = ctl + CW_Q + (l * 8) * 64;
            #ifndef NO_H3
            for (int u; (u = next_unit(q + 4 * 64, MISC + 16)) < 384;) hgrn_final_unit(F, A, u, l);
#endif
#if DUP_H3
            for (int u; (u = next_unit(q + 7 * 64, MISC + 16)) < 384;) hgrn_final_unit(F, A, u, l);
#endif
            #ifndef NO_L2
            for (int u; (u = next_unit(q + 5 * 64, MISC + 16)) < 384;) lru_final_unit(F, A, u, l);
#endif
#if DUP_L2
            for (int u; (u = next_unit(q + 7 * 64, MISC + 16)) < 384;) lru_final_unit(F, A, u, l);
#endif
        }
        CV_END(l, 5, 0);
        SEAM(pb + 5);
#ifndef NO_G6
        if (IN(pb + 6)) {
            __syncthreads();
            float* MACC = (float*)(ws + WS_MACC); bf16* MB = (bf16*)(ws + WS_MB);
            { pg8::Gemm g{(const bf16*)(ws + WS_OA), (const bf16*)(wl + WO_PA), MTOK, DM, 512}; pg8::StaticOrder S; S.init(MTOK, DM, F.G, (int)blockIdx.x, 64 * MT_N2K);
              pg8::EpiMerge E{(const bf16*)(ws + WS_GB), MACC, MB, 0}; pg8::gemm_phase<pg8::EpiMerge, pg8::StaticOrder, true, true, MT_N2K>(ring, g, S, E); }
            { pg8::Gemm g{(const bf16*)(ws + WS_OB), (const bf16*)(wl + WO_PB), MTOK, DM, 1024}; pg8::StaticOrder S; S.init(MTOK, DM, F.G, (int)blockIdx.x, 64 * MT_N2K);
              pg8::EpiMerge E{(const bf16*)(ws + WS_GB) + DM, MACC, MB, 1}; pg8::gemm_phase<pg8::EpiMerge, pg8::StaticOrder, true, true, MT_N2K>(ring, g, S, E); }
            { pg8::Gemm g{(const bf16*)(ws + WS_OC), (const bf16*)(wl + WO_PC), MTOK, DM, 512}; pg8::StaticOrder S; S.init(MTOK, DM, F.G, (int)blockIdx.x, 64 * MT_N2K);
              pg8::EpiMerge E{(const bf16*)(ws + WS_GB) + 2 * DM, MACC, MB, 2}; pg8::gemm_phase<pg8::EpiMerge, pg8::StaticOrder, true, true, MT_N2K>(ring, g, S, E); }
        }
        #endif
        CV_END(l, 6, 1);
        SEAM(pb + 6);
#ifndef NO_G7
        if (IN(pb + 7)) { pg8::Gemm g{(const bf16*)(ws + WS_MB), (const bf16*)(wl + WO_OUT), MTOK, DM, DM}; pg8::StaticOrder S; S.init(MTOK, DM, F.G, (int)blockIdx.x, 64 * MT_N2K);
            pg8::EpiResid E{X, DM, mods_l, 1, 1.0f}; pg8::gemm_phase<pg8::EpiResid, pg8::StaticOrder, true, true, MT_N2K>(ring, g, S, E); }
        #endif
        CV_END(l, 7, 1);
        SEAM(pb + 7);
#ifndef NO_N8
        if (IN(pb + 8)) norm_rows<0>(F, X, X + (size_t)NCTX * DM, nullptr, ng + 2 * DM, mods_l, 2, H, nullptr);
        #endif
        CV_END(l, 8, 0);
        SEAM(pb + 8);
#ifndef NO_G9
        if (IN(pb + 9)) { pg8::Gemm g{H, (const bf16*)(wl + WO_UP2), MTOK, 2 * DFF, DM}; pg8::StaticOrder S; S.init(MTOK, 2 * DFF, F.G, (int)blockIdx.x);
            pg8::EpiSwiglu E{HID, DFF}; pg8::gemm_phase<pg8::EpiSwiglu, pg8::StaticOrder, true, true>(ring, g, S, E); }
        #endif
        CV_END(l, 9, 1);
        SEAM(pb + 9);
#ifndef NO_G10
        if (IN(pb + 10)) { pg8::Gemm g{HID, (const bf16*)(wl + WO_DN2), MTOK, DM, DFF}; pg8::StaticOrder S; S.init(MTOK, DM, F.G, (int)blockIdx.x, 64 * MT_N2K);
            pg8::EpiResid E{X, DM, mods_l, 2, 0.5f}; pg8::gemm_phase<pg8::EpiResid, pg8::StaticOrder, true, true, MT_N2K>(ring, g, S, E); }
        #endif
        CV_END(l, 10, 1);
        SEAM(pb + 10);
#ifndef NO_N11
        if (IN(pb + 11)) {
            if (l + 1 < DEPTH) norm_rows<0>(F, X, X + (size_t)NCTX * DM, nullptr, ng + 3 * DM, mods_l + 3 * 9 * DM, 0, H, nullptr);
            else norm_rows<1>(F, X, X + (size_t)NCTX * DM, nullptr, A.in[I_FNG], nullptr, 0, nullptr, A.out + OUT_Y);
        }
        #endif
        CV_END(l, 11, 0);
        SEAM(pb + 11);
    }
#undef IN
#undef SEAM
}

extern "C" void kernel_launch(void* const* d_in, const int* in_sizes, int n_in, void* d_out, int out_size, void* d_ws, size_t ws_size, hipStream_t stream) {
    static int grid = 0;
    if (grid == 0) {
        if (n_in != 31 || out_size != 33587200 || ws_size < WS_END) { fprintf(stderr, "kernel_launch: unexpected shapes (n_in %d, out %d, ws %zu); nothing launched\n", n_in, out_size, ws_size); grid = -1; return; }
        int dev = 0, cus = 0, per_cu = 0;
        if (hipGetDevice(&dev) != hipSuccess || hipDeviceGetAttribute(&cus, hipDeviceAttributeMultiprocessorCount, dev) != hipSuccess) { grid = -1; return; }
        if (hipFuncSetAttribute((const void*)trunk_fwd, hipFuncAttributeMaxDynamicSharedMemorySize, LDS_BYTES) != hipSuccess) { fprintf(stderr, "kernel_launch: hipFuncSetAttribute failed\n"); grid = -1; return; }
        if (hipOccupancyMaxActiveBlocksPerMultiprocessor(&per_cu, (const void*)trunk_fwd, NTHREADS, LDS_BYTES) != hipSuccess || per_cu < 1) { fprintf(stderr, "kernel_launch: occupancy query says %d blocks per CU\n", per_cu); (void)hipGetLastError(); grid = -1; return; }
        grid = cus;
    }
    if (grid < 0) return;
    if (hipMemsetAsync((char*)d_ws + WS_CTL, 0, CTL_ZERO_BYTES, stream) != hipSuccess) return;
#if PROBE_MEMSET
    (void)hipMemsetAsync((char*)d_ws + PROBE_MS_LO * MiB, 0, (PROBE_MS_HI - PROBE_MS_LO) * MiB, stream);
#endif
    Args a{};
    for (int i = 0; i < 31; ++i) a.in[i] = (const float*)d_in[i];
    a.out = (float*)d_out; a.ws = (unsigned char*)d_ws;
#if MK_N_LAUNCHES == 1
    a.ph_lo = 0; a.ph_hi = N_PHASES;
    hipLaunchKernelGGL(trunk_fwd, dim3(grid), dim3(NTHREADS), LDS_BYTES, stream, a);
#else
    for (int p = 0; p < N_PHASES; ++p) { a.ph_lo = p; a.ph_hi = p + 1; hipLaunchKernelGGL(trunk_fwd, dim3(grid), dim3(NTHREADS), LDS_BYTES, stream, a); }
#endif
}
```

```cpp
#include <hip/hip_runtime.h>
#include <cstdio>
#include <cstdint>
namespace pg8 {
#define PG8_LAS __attribute__((address_space(3)))
typedef unsigned short bf16_t;
typedef short bf16x8 __attribute__((ext_vector_type(8)));
typedef float f32x4 __attribute__((ext_vector_type(4)));
typedef unsigned u32x4 __attribute__((ext_vector_type(4)));
constexpr int BM = 256, BK = 64, HALF = 128, HTB = HALF * BK * 2  , STAGE_BYTES = 8 * HTB, NXCD = 8, WGM = 8;

__host__ __device__ __forceinline__ int lds_byte(int r, int c) { const int st = (r >> 4) * 2 + (c >> 5), rr = r & 15, cc = c & 31, ob = rr * 64 + cc * 2; return st * 1024 + (ob ^ (((ob >> 9) & 1) << 5)); }
__host__ __device__ __forceinline__ void stage_rc(int b, int& R, int& C) { const int st = b / 1024, sb = b % 1024, swz = sb ^ (((sb >> 9) & 1) << 5); R = (st >> 1) * 16 + swz / 64; C = (st & 1) * 32 + (swz % 64) / 2; }
__host__ __device__ __forceinline__ int perm32(int rho) { const int n = rho >> 4, i = rho & 15; return 8 * (i >> 2) + 4 * n + (i & 3); }

struct Unit { int pm, pn; };
struct Gemm { const bf16_t* A; const bf16_t* Bt; int M, N, K; };

struct StaticOrder {
    int nM, nN, nwg, G, c;
    __host__ __device__ void init(int M, int N, int G_, int c_, int bm = BM) { nM = M / bm; nN = N / BM; nwg = nM * nN; G = G_; c = c_; }
    __host__ __device__ bool next(int i, Unit& u) const {
        const long L = (long)i * G + c; if (L >= nwg) return false;
        int wgid = (int)L; { const int q = nwg / NXCD, r = nwg % NXCD, xcd = wgid % NXCD, off = wgid / NXCD; wgid = (xcd < r ? xcd * (q + 1) : r * (q + 1) + (xcd - r) * q) + off; }
        const int nig = WGM * nN, gid = wgid / nig, fm = gid * WGM, gsz = (nM - fm) < WGM ? (nM - fm) : WGM;
        u.pm = fm + ((wgid % nig) % gsz); u.pn = (wgid % nig) / gsz; return true;
    }
    __device__ __forceinline__ void a_ready(const Unit&) const {}
    __device__ __forceinline__ void done(const Unit&) const {}
};
struct SplitOrder {
    int nM, nN, nwg, G, c, fullr, rem, c_lo;
    __host__ __device__ void init(int M, int N, int G_, int c_, int bm, int c_lo_) { nM = M / bm; nN = N / BM; nwg = nM * nN; G = G_; c = c_; fullr = nwg / G; rem = nwg % G; c_lo = c_lo_; }
    __host__ __device__ bool next(int i, Unit& u) const {
        int wgid;
        if (i < fullr) wgid = i * G + c; else if (i == fullr && c >= c_lo && c - c_lo < rem) wgid = fullr * G + c - c_lo; else return false;
        { const int q = nwg / NXCD, r = nwg % NXCD, xcd = wgid % NXCD, off = wgid / NXCD; wgid = (xcd < r ? xcd * (q + 1) : r * (q + 1) + (xcd - r) * q) + off; }
        const int nig = WGM * nN, gid = wgid / nig, fm = gid * WGM, gsz = (nM - fm) < WGM ? (nM - fm) : WGM;
        u.pm = fm + ((wgid % nig) % gsz); u.pn = (wgid % nig) / gsz; return true;
    }
    __device__ __forceinline__ void a_ready(const Unit&) const {}
    __device__ __forceinline__ void done(const Unit&) const {}
};
typedef float f32x2_cv __attribute__((ext_vector_type(2)));
typedef __bf16 bf16x2_cv __attribute__((ext_vector_type(2)));
__device__ __forceinline__ unsigned cvt_pk_bf16(float lo, float hi) { const f32x2_cv v = {lo, hi}; return __builtin_bit_cast(unsigned, __builtin_convertvector(v, bf16x2_cv)); }
typedef float f32x2 __attribute__((ext_vector_type(2)));

typedef unsigned u32x2 __attribute__((ext_vector_type(2)));
#ifndef PROBE_NOGATE
#define PROBE_NOGATE 0
#endif
#ifndef PROBE_GCONST
#define PROBE_GCONST 0
#endif
#ifndef PROBE_GRAW
#define PROBE_GRAW 0
#endif
#ifndef PROBE_QKV32
#define PROBE_QKV32 0
#endif
__device__ __forceinline__ float silu_f(float a) { return a * __builtin_amdgcn_rcpf(1.0f + __expf(-a)); }
__device__ __forceinline__ float sigmoid_f(float a) { return __builtin_amdgcn_rcpf(1.0f + __expf(-a)); }
__device__ __forceinline__ int opq_(int v) { asm volatile("" : "+v"(v)); return v; }

struct EpiSwiglu {
    static constexpr bool PERM = true, AFTER_DRAIN = false;
    bf16_t* O; int ldo;
    template <int MT>
    __device__ __forceinline__ void operator()(const f32x4 (&acc)[2][2][MT][2], const Unit& u, int wr, int wc, int fr_, int fq_) const {
        const int fr = opq_(fr_), fq = opq_(fq_);
        constexpr int TM = 64 * MT, HM = 32 * MT, WM = 16 * MT;
        const int row0 = u.pm * TM + wr * WM + fr, col0 = u.pn * HALF + wc * 32 + 8 * fq;
#pragma unroll
        for (int ai = 0; ai < 2; ++ai)
#pragma unroll
            for (int m = 0; m < MT; ++m) { bf16_t* rowp = O + (size_t)(row0 + ai * HM + m * 16) * ldo + col0;
                const f32x4 a0 = acc[ai][0][m][0], a1 = acc[ai][0][m][1], u0 = acc[ai][1][m][0], u1 = acc[ai][1][m][1];
                f32x4 v0, v1;
#pragma unroll
                for (int j = 0; j < 4; ++j) { v0[j] = silu_f(a0[j]) * u0[j]; v1[j] = silu_f(a1[j]) * u1[j]; }
                u32x4 w; w.x = cvt_pk_bf16(v0[0], v0[1]); w.y = cvt_pk_bf16(v0[2], v0[3]); w.z = cvt_pk_bf16(v1[0], v1[1]); w.w = cvt_pk_bf16(v1[2], v1[3]);
                *(u32x4*)rowp = w; }
    }
};
struct EpiResid {
    static constexpr bool PERM = false, AFTER_DRAIN = false;
    float* X; int ldx; const float* mods_l; int slot; float coef;
    template <int MT>
    __device__ __forceinline__ void operator()(const f32x4 (&acc)[2][2][MT][2], const Unit& u, int wr, int wc, int fr_, int fq_) const {
        const int fr = opq_(fr_), fq = opq_(fq_);
        constexpr int TM = 64 * MT, HM = 32 * MT, WM = 16 * MT;
        const int row0 = u.pm * TM + wr * WM + fr, col0 = u.pn * BM + wc * 32 + 4 * fq;
        if constexpr (MT == 4) {
            const int cidx = u.pm < 16 ? 0 : 1 + ((u.pm - 16) >> 2);
            const float* g = mods_l + (size_t)(cidx * 9 + 3 * slot + 2) * 2048 + col0;
            f32x4 gv[2][2];
#pragma unroll
            for (int bj = 0; bj < 2; ++bj)
#pragma unroll
                for (int n = 0; n < 2; ++n) gv[bj][n] = *(const f32x4*)(g + bj * HALF + n * 16) * coef;
#pragma unroll
            for (int ai = 0; ai < 2; ++ai)
#pragma unroll
                for (int m = 0; m < 4; ++m) { float* rowp = X + (size_t)(row0 + ai * HALF + m * 16) * ldx + col0;
#pragma unroll
                    for (int bj = 0; bj < 2; ++bj)
#pragma unroll
                        for (int n = 0; n < 2; ++n) { f32x4* p = (f32x4*)(rowp + bj * HALF + n * 16); *p = *p + gv[bj][n] * acc[ai][bj][m][n]; } }
        } else {
#pragma unroll
            for (int ai = 0; ai < 2; ++ai)
#pragma unroll
                for (int m = 0; m < MT; ++m) { const int rg = u.pm * TM + ai * HM + wr * WM + m * 16, cidx = rg < 4096 ? 0 : 1 + ((rg - 4096) >> 10);
                    const float* g = mods_l + (size_t)(cidx * 9 + 3 * slot + 2) * 2048 + col0;
                    float* rowp = X + (size_t)(row0 + ai * HM + m * 16) * ldx + col0;
#pragma unroll
                    for (int bj = 0; bj < 2; ++bj)
#pragma unroll
                        for (int n = 0; n < 2; ++n) { f32x4* p = (f32x4*)(rowp + bj * HALF + n * 16); *p = *p + (*(const f32x4*)(g + bj * HALF + n * 16) * coef) * acc[ai][bj][m][n]; } }
        }
    }
};
struct EpiZ {
    static constexpr bool PERM = false, AFTER_DRAIN = false;
    float* ZF; bf16_t* QB; bf16_t* KB; bf16_t* VT; bf16_t* GB; float* outk; float* outv; int layer; float* Q32;
    __device__ __forceinline__ void operator()(const f32x4 (&acc)[2][2][4][2], const Unit& u, int wr, int wc, int fr_, int fq_) const {
        const int fr = opq_(fr_), fq = opq_(fq_);
        const int rl0 = wr * 64 + fr, ct0 = wc * 32 + 4 * fq, pn = u.pn;
#if PROBE_QKV32
        if (pn >= 10 && pn < 22) { float* base = Q32 + (size_t)(u.pm * BM + rl0) * 3072 + (pn - 10) * 256 + ct0;
#pragma unroll
            for (int ai = 0; ai < 2; ++ai)
#pragma unroll
                for (int m = 0; m < 4; ++m) { float* rowp = base + (size_t)(ai * HALF + m * 16) * 3072;
#pragma unroll
                    for (int bj = 0; bj < 2; ++bj)
#pragma unroll
                        for (int n = 0; n < 2; ++n) *(f32x4*)(rowp + bj * HALF + n * 16) = acc[ai][bj][m][n]; } }
#endif
        if (pn < 10 || (pn >= 22 && pn < 26)) {
            float* base = ZF + (size_t)(u.pm * BM + rl0) * 3584 + (pn < 10 ? pn * 256 : 2560 + (pn - 22) * 256) + ct0;
#pragma unroll
            for (int ai = 0; ai < 2; ++ai)
#pragma unroll
                for (int m = 0; m < 4; ++m) { float* rowp = base + (size_t)(ai * HALF + m * 16) * 3584;
#pragma unroll
                    for (int bj = 0; bj < 2; ++bj)
#pragma unroll
                        for (int n = 0; n < 2; ++n) *(f32x4*)(rowp + bj * HALF + n * 16) = acc[ai][bj][m][n]; }
        } else if (pn < 18) {
            bf16_t* dst = (pn < 14 ? QB + (pn - 10) * 256 : KB + (pn - 14) * 256) + (size_t)(u.pm * BM + rl0) * 1024 + ct0;
            float* ko = (pn >= 14 && u.pm < 16) ? outk + ((size_t)(u.pm * 2 + layer) * 256 + rl0) * 1024 + (pn - 14) * 256 + ct0 : nullptr;
#pragma unroll
            for (int ai = 0; ai < 2; ++ai)
#pragma unroll
                for (int m = 0; m < 4; ++m) { const size_t ro = (size_t)(ai * HALF + m * 16) * 1024;
#pragma unroll
                    for (int bj = 0; bj < 2; ++bj)
#pragma unroll
                        for (int n = 0; n < 2; ++n) { const f32x4 v = acc[ai][bj][m][n]; u32x2 w; w.x = cvt_pk_bf16(v[0], v[1]); w.y = cvt_pk_bf16(v[2], v[3]);
                            *(u32x2*)(dst + ro + bj * HALF + n * 16) = w; if (ko) *(f32x4*)(ko + ro + bj * HALF + n * 16) = v; } }
        } else if (pn < 22) {
            const bool ctx = u.pm < 16; const int L = ctx ? 256 : 1024, t0 = (ctx ? 0 : ((u.pm - 16) & 3) * 256) + rl0;
            bf16_t* vb = ctx ? VT + (size_t)u.pm * 8 * 128 * 256 : VT + (size_t)4096 * 1024 + (size_t)((u.pm - 16) >> 2) * 8 * 128 * 1024;
            vb += (size_t)(2 * (pn - 18)) * 128 * L + (size_t)ct0 * L + t0;
            float* vo = ctx ? outv + ((size_t)(u.pm * 2 + layer) * 256 + rl0) * 1024 + (pn - 18) * 256 + ct0 : nullptr;
#pragma unroll
            for (int ai = 0; ai < 2; ++ai)
#pragma unroll
                for (int m = 0; m < 4; ++m) { const int tr = ai * HALF + m * 16;
#pragma unroll
                    for (int bj = 0; bj < 2; ++bj)
#pragma unroll
                        for (int n = 0; n < 2; ++n) { const f32x4 v = acc[ai][bj][m][n]; bf16_t* p = vb + (size_t)(bj * 128 + n * 16) * L + tr;
                            const unsigned w0 = cvt_pk_bf16(v[0], v[1]), w1 = cvt_pk_bf16(v[2], v[3]);
                            p[0] = (bf16_t)(w0 & 0xffffu); p[L] = (bf16_t)(w0 >> 16); p[2 * L] = (bf16_t)(w1 & 0xffffu); p[3 * L] = (bf16_t)(w1 >> 16);
                            if (vo) *(f32x4*)(vo + (size_t)tr * 1024 + bj * HALF + n * 16) = v; } }
        } else {
            bf16_t* dst = GB + (size_t)(u.pm * BM + rl0) * 6144 + (pn - 26) * 256 + ct0;
#pragma unroll
            for (int ai = 0; ai < 2; ++ai)
#pragma unroll
                for (int m = 0; m < 4; ++m) { const size_t ro = (size_t)(ai * HALF + m * 16) * 6144;
#pragma unroll
                    for (int bj = 0; bj < 2; ++bj)
#pragma unroll
                        for (int n = 0; n < 2; ++n) { const f32x4 v = acc[ai][bj][m][n]; u32x2 w; w.x = cvt_pk_bf16(sigmoid_f(v[0]), sigmoid_f(v[1])); w.y = cvt_pk_bf16(sigmoid_f(v[2]), sigmoid_f(v[3]));
#if PROBE_GCONST
                            w.x = 0x3f003f00u; w.y = 0x3f003f00u;
#endif
#if PROBE_GRAW
                            w.x = cvt_pk_bf16(v[0] * 0.01f, v[1] * 0.01f); w.y = cvt_pk_bf16(v[2] * 0.01f, v[3] * 0.01f);
#endif
                            *(u32x2*)(dst + ro + bj * HALF + n * 16) = w; } }
        }
    }
};
struct EpiMerge {
    static constexpr bool PERM = false, AFTER_DRAIN = false;
    const bf16_t* Gg; float* MACC; bf16_t* MB; int mode;
    template <int MT>
    __device__ __forceinline__ void operator()(const f32x4 (&acc)[2][2][MT][2], const Unit& u, int wr, int wc, int fr_, int fq_) const {
        const int fr = opq_(fr_), fq = opq_(fq_);
        constexpr int TM = 64 * MT, HM = 32 * MT, WM = 16 * MT;
        const int row0 = u.pm * TM + wr * WM + fr, col0 = u.pn * BM + wc * 32 + 4 * fq;
#pragma unroll
        for (int ai = 0; ai < 2; ++ai)
#pragma unroll
            for (int m = 0; m < MT; ++m) { const size_t row = (size_t)(row0 + ai * HM + m * 16);
#pragma unroll
                for (int bj = 0; bj < 2; ++bj)
#pragma unroll
                    for (int n = 0; n < 2; ++n) { const int c = col0 + bj * HALF + n * 16;
#if PROBE_NOGATE
                        const u32x2 gw = {0x3f003f00u, 0x3f003f00u}; f32x4 v = acc[ai][bj][m][n];
#else
                        const u32x2 gw = *(const u32x2*)(Gg + row * 6144 + c); f32x4 v = acc[ai][bj][m][n];
#endif
                        v[0] *= __uint_as_float(gw.x << 16); v[1] *= __uint_as_float(gw.x & 0xffff0000u); v[2] *= __uint_as_float(gw.y << 16); v[3] *= __uint_as_float(gw.y & 0xffff0000u);
                        f32x4* mp = (f32x4*)(MACC + row * 2048 + c);
                        if (mode == 0) *mp = v;
                        else if (mode == 1) *mp = *mp + v;
                        else { v = *mp + v; u32x2 w; w.x = cvt_pk_bf16(v[0], v[1]); w.y = cvt_pk_bf16(v[2], v[3]); *(u32x2*)(MB + row * 2048 + c) = w; } } }
    }
};
template <class Epi, class Sched, bool ALIGN_EPI = false, bool SP2 = false, int MT = 4>
__device__ __forceinline__ void gemm_phase(PG8_LAS unsigned char* lds, const Gemm g, const Sched& S, const Epi& E) {
    int tid_ = threadIdx.x; asm volatile("" : "+v"(tid_));
    const int tid = tid_, wid = __builtin_amdgcn_readfirstlane(tid >> 6), lane = tid & 63, wr = wid >> 2, wc = wid & 3, fr = lane & 15, fq = lane >> 4;
    const int K = g.K, nt = K / BK;
    unsigned voffA[2], voffB[2];
#pragma unroll
    for (int i = 0; i < 2; ++i) { int R, C; stage_rc(tid * 16 + i * 8192, R, C); const int Rb = Epi::PERM ? ((R & ~31) + perm32(R & 31)) : R;
        const int Ra = R < 32 * MT ? R : R - 32;
        voffA[i] = (unsigned)(Ra * K + C) * 2u; voffB[i] = (unsigned)(Rb * K + C) * 2u; }
    const size_t kstep = (size_t)(BK * 2);
    const size_t hstep = (size_t)HALF * K * 2;
    const size_t tstep = 2 * hstep;
    const size_t hstepA = (size_t)(32 * MT) * K * 2, tstepA = 2 * hstepA;
    const unsigned ldsw = (unsigned)wid * 1024u;
    const int aoff = lds_byte(wr * 16 * MT + fr, fq * 8), boff = lds_byte(wc * 32 + fr, fq * 8);
#define PG8_SA(b, h) (((b) * 2 + (h)) * HTB)
#define PG8_SB(b, h) ((4 + (b) * 2 + (h)) * HTB)
#define PG8_STAGE(bufoff, gbase, voff) do { _Pragma("unroll") for (int _i = 0; _i < 2; ++_i) \
        __builtin_amdgcn_global_load_lds((const unsigned*)((const char*)(gbase) + (voff)[_i]), (PG8_LAS unsigned*)(lds + (bufoff) + ldsw + _i * 8192), 16, 0, 0); } while (0)
#define PG8_LDA(dst, b, h) do { _Pragma("unroll") for (int m = 0; m < MT; ++m) _Pragma("unroll") for (int k = 0; k < 2; ++k) dst[m][k] = *(const PG8_LAS bf16x8*)(lds + PG8_SA(b, h) + aoff + m * 2048 + k * 1024); } while (0)
#define PG8_LDB(dst, b, h) do { _Pragma("unroll") for (int n = 0; n < 2; ++n) _Pragma("unroll") for (int k = 0; k < 2; ++k) dst[n][k] = *(const PG8_LAS bf16x8*)(lds + PG8_SB(b, h) + boff + n * 2048 + k * 1024); } while (0)
#define PG8_MMA(ai, bj, At, Bt) do { __builtin_amdgcn_s_setprio(1); _Pragma("unroll") for (int m = 0; m < MT; ++m) _Pragma("unroll") for (int n = 0; n < 2; ++n) _Pragma("unroll") for (int k = 0; k < 2; ++k) \
        acc[ai][bj][m][n] = __builtin_amdgcn_mfma_f32_16x16x32_bf16(Bt[n][k], At[m][k], acc[ai][bj][m][n], 0, 0, 0); __builtin_amdgcn_s_setprio(0); } while (0)
#define PG8_WAIT_V(n) asm volatile("s_waitcnt vmcnt(" #n ")" ::: "memory")
#define PG8_WAIT_L(n) asm volatile("s_waitcnt lgkmcnt(" #n ")" ::: "memory")
#define PG8_BAR __builtin_amdgcn_s_barrier()
#define PG8_SCHED __builtin_amdgcn_sched_barrier(0)
    Unit cur, nxt; int ui = 0;
    if (!S.next(0, cur)) return;
    f32x4 acc[2][2][MT][2];
#pragma unroll
    for (int a = 0; a < 2; ++a)
#pragma unroll
        for (int b = 0; b < 2; ++b)
#pragma unroll
            for (int m = 0; m < MT; ++m)
#pragma unroll
                for (int n = 0; n < 2; ++n) acc[a][b][m][n] = (f32x4){0.f, 0.f, 0.f, 0.f};
    bf16x8 At[MT][2], B0[2][2], B1[2][2];
    const char* cA = (const char*)g.A + (size_t)cur.pm * tstepA; const char* cB = (const char*)g.Bt + (size_t)cur.pn * tstep;
    S.a_ready(cur);
    if constexpr (SP2) {
        PG8_STAGE(PG8_SB(0, 0), cB, voffB); PG8_STAGE(PG8_SB(0, 1), cB + hstep, voffB); PG8_STAGE(PG8_SA(0, 0), cA, voffA); PG8_STAGE(PG8_SA(0, 1), cA + hstepA, voffA);
        if (wr == 1) PG8_BAR;
        PG8_WAIT_V(2); PG8_BAR;
        PG8_STAGE(PG8_SB(1, 0), cB + kstep, voffB); PG8_STAGE(PG8_SA(1, 0), cA + kstep, voffA); PG8_STAGE(PG8_SB(1, 1), cB + hstep + kstep, voffB);
        PG8_WAIT_V(6); PG8_BAR;
    } else {
        PG8_STAGE(PG8_SB(0, 0), cB, voffB); PG8_STAGE(PG8_SA(0, 0), cA, voffA); PG8_STAGE(PG8_SB(0, 1), cB + hstep, voffB); PG8_STAGE(PG8_SA(0, 1), cA + hstepA, voffA);
        if (wr == 1) PG8_BAR;
        PG8_WAIT_V(4); PG8_BAR;
        PG8_STAGE(PG8_SB(1, 0), cB + kstep, voffB); PG8_STAGE(PG8_SA(1, 0), cA + kstep, voffA); PG8_STAGE(PG8_SB(1, 1), cB + hstep + kstep, voffB);
        PG8_WAIT_V(6); PG8_BAR;
    }
    for (;;) {
        const bool has_next = S.next(ui + 1, nxt);
        const char* nA = has_next ? (const char*)g.A + (size_t)nxt.pm * tstepA : cA; const char* nB = has_next ? (const char*)g.Bt + (size_t)nxt.pn * tstep : cB;
        for (int t = 0; t < nt; t += 2) {
            const bool last = (t == nt - 2);
            const char* a1 = cA + (size_t)(t + 1) * kstep;
            const char* a2 = last ? nA : cA + (size_t)(t + 2) * kstep; const char* b2 = last ? nB : cB + (size_t)(t + 2) * kstep;
            const char* a3 = a2 + kstep; const char* b3 = b2 + kstep;
            if (last && has_next) S.a_ready(nxt);
            if constexpr (SP2) {
            PG8_LDB(B0, 0, 0); PG8_LDB(B1, 0, 1); PG8_SCHED; PG8_LDA(At, 0, 0); PG8_STAGE(PG8_SA(1, 1), a1 + hstepA, voffA);
            PG8_WAIT_V(8); PG8_WAIT_L(0); PG8_BAR; PG8_MMA(0, 0, At, B0); PG8_MMA(0, 1, At, B1); PG8_BAR; PG8_SCHED;
            PG8_LDA(At, 0, 1); PG8_STAGE(PG8_SB(0, 0), b2, voffB); PG8_STAGE(PG8_SB(0, 1), b2 + hstep, voffB); PG8_STAGE(PG8_SA(0, 0), a2, voffA);
            PG8_WAIT_V(8); PG8_WAIT_L(0); PG8_BAR; PG8_MMA(1, 0, At, B0); PG8_MMA(1, 1, At, B1); PG8_BAR; PG8_SCHED;
            PG8_LDB(B0, 1, 0); PG8_LDB(B1, 1, 1); PG8_SCHED; PG8_LDA(At, 1, 0); PG8_STAGE(PG8_SA(0, 1), a2 + hstepA, voffA);
            PG8_WAIT_V(8); PG8_WAIT_L(0); PG8_BAR; PG8_MMA(0, 0, At, B0); PG8_MMA(0, 1, At, B1); PG8_BAR; PG8_SCHED;
            PG8_LDA(At, 1, 1); PG8_STAGE(PG8_SB(1, 0), b3, voffB); PG8_STAGE(PG8_SB(1, 1), b3 + hstep, voffB); PG8_STAGE(PG8_SA(1, 0), a3, voffA);
            PG8_WAIT_V(8); PG8_WAIT_L(0); PG8_BAR; PG8_MMA(1, 0, At, B0); PG8_MMA(1, 1, At, B1); PG8_BAR; PG8_SCHED;
            } else {
            PG8_LDB(B0, 0, 0); PG8_SCHED; PG8_LDA(At, 0, 0); PG8_STAGE(PG8_SA(1, 1), a1 + hstepA, voffA);
            PG8_WAIT_L(8); PG8_BAR; PG8_WAIT_L(0); PG8_MMA(0, 0, At, B0); PG8_BAR; PG8_SCHED;
            PG8_LDB(B1, 0, 1); PG8_STAGE(PG8_SB(0, 0), b2, voffB);
            PG8_BAR; PG8_WAIT_L(0); PG8_MMA(0, 1, At, B1); PG8_BAR;
            PG8_LDA(At, 0, 1); PG8_STAGE(PG8_SA(0, 0), a2, voffA);
            PG8_BAR; PG8_WAIT_L(0); PG8_MMA(1, 0, At, B0); PG8_BAR; PG8_SCHED;
            PG8_STAGE(PG8_SB(0, 1), b2 + hstep, voffB);
            PG8_WAIT_V(6); PG8_BAR; PG8_MMA(1, 1, At, B1); PG8_BAR;
            PG8_LDB(B0, 1, 0); PG8_SCHED; PG8_LDA(At, 1, 0); PG8_STAGE(PG8_SA(0, 1), a2 + hstepA, voffA);
            PG8_WAIT_L(8); PG8_BAR; PG8_WAIT_L(0); PG8_MMA(0, 0, At, B0); PG8_BAR; PG8_SCHED;
            PG8_LDB(B1, 1, 1); PG8_STAGE(PG8_SB(1, 0), b3, voffB);
            PG8_BAR; PG8_WAIT_L(0); PG8_MMA(0, 1, At, B1); PG8_BAR;
            PG8_LDA(At, 1, 1); PG8_STAGE(PG8_SA(1, 0), a3, voffA);
            PG8_BAR; PG8_WAIT_L(0); PG8_MMA(1, 0, At, B0); PG8_BAR; PG8_SCHED;
            PG8_STAGE(PG8_SB(1, 1), b3 + hstep, voffB);
            PG8_WAIT_V(6); PG8_BAR; PG8_MMA(1, 1, At, B1); PG8_BAR;
            }
        }
        if constexpr (ALIGN_EPI) { if (wr == 0) PG8_BAR; }
        if constexpr (!Epi::AFTER_DRAIN) { E(acc, cur, wr, wc, fr, fq); S.done(cur); }
        if (!has_next) break;
#pragma unroll
        for (int a = 0; a < 2; ++a)
#pragma unroll
            for (int b = 0; b < 2; ++b)
#pragma unroll
                for (int m = 0; m < MT; ++m)
#pragma unroll
                    for (int n = 0; n < 2; ++n) acc[a][b][m][n] = (f32x4){0.f, 0.f, 0.f, 0.f};
        cur = nxt; cA = nA; cB = nB; ++ui;
        if constexpr (ALIGN_EPI) { if (wr == 1) PG8_BAR; }
    }
    PG8_WAIT_V(0);
    if constexpr (!ALIGN_EPI) { if (wr == 0) PG8_BAR; }
    PG8_BAR;
    if constexpr (Epi::AFTER_DRAIN) { E.fused(acc, cur, wr, wc, fr, fq, lds, wid, lane); S.done(cur); }
#undef PG8_SA
#undef PG8_SB
#undef PG8_STAGE
#undef PG8_LDA
#undef PG8_LDB
#undef PG8_MMA
#undef PG8_WAIT_V
#undef PG8_WAIT_L
#undef PG8_BAR
#undef PG8_SCHED
}
}

constexpr int DM = 2048, DFF = 5632, DIN = 12800, NCTX = 4096, NLAT = 2048, MTOK = 6144, DEPTH = 2;
constexpr int SEQ = 256, DSEQ = 1024, NSEQ = 18;
constexpr int ZQ = 0, ZFF = 512, ZFB = 1024, ZI = 1536, ZO = 2048, ZLX = 2560, ZLG = 3072, ZFW = 3584;
constexpr int NWAVES = 8, NTHREADS = 512;
constexpr size_t MiB = 1u << 20;
constexpr size_t WS_CTL = 0, CTL_ZERO_BYTES = 1 * MiB;
constexpr size_t WS_W = 2 * MiB, W_LAYER = 198 * MiB;
constexpr size_t WO_UP1 = 0, WO_DN1 = 44 * MiB, WO_UP2 = 66 * MiB, WO_DN2 = 110 * MiB, WO_IN = 132 * MiB, WO_PA = 182 * MiB, WO_PB = 184 * MiB, WO_PC = 188 * MiB, WO_OUT = 190 * MiB;
constexpr size_t WS_X = 398 * MiB;
constexpr size_t WS_H = 446 * MiB;
constexpr size_t WS_HID = 470 * MiB;
constexpr size_t WS_ZF = 536 * MiB;
constexpr size_t WS_QB = 620 * MiB;
constexpr size_t WS_KB = 632 * MiB;
constexpr size_t WS_VT = 644 * MiB;
constexpr size_t WS_GB = 656 * MiB;
constexpr size_t WS_CKB = 728 * MiB;
constexpr size_t WS_CVT = 732 * MiB;
constexpr size_t WS_OA = 836 * MiB, WS_OB = 842 * MiB, WS_OC = 854 * MiB;
constexpr size_t WS_MACC = 860 * MiB;
constexpr size_t WS_MB = 908 * MiB;
constexpr size_t WS_MODP = 932 * MiB;
constexpr size_t WS_MODS = 946 * MiB;
constexpr size_t WS_HOL = 947 * MiB;
constexpr size_t WS_HQD = 971 * MiB;
constexpr size_t WS_HSL = 995 * MiB;
constexpr size_t WS_HDEC = 1043 * MiB;
constexpr size_t WS_LHL = 1044 * MiB;
constexpr size_t WS_LPP = 1068 * MiB;
constexpr size_t WS_END = 1092 * MiB;
constexpr int CW_BAR = 4096;
constexpr int CW_Q = 16384;
constexpr int RING_BYTES = 131072, LDSCTL_OFF = 143360, LDS_BYTES = 147456;

#define GAS __attribute__((address_space(1)))
#define LAS __attribute__((address_space(3)))
typedef unsigned short bf16;
typedef unsigned v4u __attribute__((ext_vector_type(4)));
typedef unsigned v2u __attribute__((ext_vector_type(2)));
typedef float f32x4 __attribute__((ext_vector_type(4)));
typedef short bf16x8 __attribute__((ext_vector_type(8)));
typedef GAS unsigned gu32;
#define RLX_AGENT __ATOMIC_RELAXED, __HIP_MEMORY_SCOPE_AGENT
#define LDS_WAIT() asm volatile("s_waitcnt lgkmcnt(0)" ::: "memory")
#define VM_WAIT() asm volatile("s_waitcnt vmcnt(0)" ::: "memory")
__device__ __forceinline__ unsigned f2bf(float f) { unsigned u = __builtin_bit_cast(unsigned, f); return (u + 0x7fffu + ((u >> 16) & 1u)) >> 16; }
__device__ __forceinline__ unsigned pk2(float lo, float hi) { return pg8::cvt_pk_bf16(lo, hi); }
__device__ __forceinline__ float wave_sum(float v) {
#pragma unroll
    for (int o = 1; o < 64; o <<= 1) v += __shfl_xor(v, o);
    return v;
}
using pg8::silu_f; using pg8::sigmoid_f;
#define XB_TMO      128
#define XB_XCNT(j)  (256  + 64 * (j))
#define XB_XSUB(j)  (1280 + 64 * (j))
#define XB_XGEN(j)  (2304 + 64 * (j))
#define XB_TOP      3328
#define XB_TOPGEN   3392
#define XCD_BAR_WORDS 3456
#define XB_SPIN_CAP (1u << 18)

__device__ __forceinline__ unsigned xb_ld(unsigned* p)              { return __hip_atomic_load(p, __ATOMIC_RELAXED, __HIP_MEMORY_SCOPE_AGENT); }
__device__ __forceinline__ unsigned xb_add(unsigned* p, unsigned v) { return __hip_atomic_fetch_add(p, v, __ATOMIC_RELAXED, __HIP_MEMORY_SCOPE_AGENT); }
__device__ __forceinline__ unsigned xb_xcc_id() { return (unsigned)__builtin_amdgcn_s_getreg((3 << 11) | 20) & 0xFu; }
#define XB_SPIN(cond, bar) do { unsigned _sp = 0; while (cond) { __builtin_amdgcn_s_sleep(1); \
    if ((++_sp & 255u) == 0u) { if (xb_ld(&(bar)[XB_TMO])) break; if (_sp > XB_SPIN_CAP) { atomicAdd(&(bar)[XB_TMO], 1u); break; } } } } while (0)

struct XcdBarrier {
    unsigned* bar; unsigned x;
    volatile LAS unsigned* st;
};

__device__ __forceinline__ XcdBarrier xcd_barrier_post(unsigned* bar, volatile LAS unsigned* st) {
    XcdBarrier b; b.bar = bar; b.x = xb_xcc_id(); b.st = st;
    if (threadIdx.x == 0) (void)xb_add(&bar[XB_XCNT(b.x)], 1u);
    return b;
}
__device__ __forceinline__ void xcd_barrier_complete(unsigned* bar, unsigned x, unsigned& nloc, unsigned& nx) {
    const unsigned G = gridDim.x * gridDim.y * gridDim.z;
    unsigned sum, cnt, mine, sp = 0u;
    for (;;) {
        sum = 0u; cnt = 0u; mine = 0u;
#pragma unroll
        for (unsigned j = 0; j < 16; ++j) { const unsigned c = xb_ld(&bar[XB_XCNT(j)]); sum += c; cnt += (c > 0u) ? 1u : 0u; mine = (j == x) ? c : mine; }
        if (sum == G) break;
        __builtin_amdgcn_s_sleep(1);
        if ((++sp & 255u) == 0u) { if (xb_ld(&bar[XB_TMO])) break; if (sp > XB_SPIN_CAP) { atomicAdd(&bar[XB_TMO], 1u); break; } }
    }
    nloc = mine > 0u ? mine : 1u; nx = cnt > 0u ? cnt : 1u;
}

__device__ __forceinline__ void xcd_barrier(const XcdBarrier& b) {
    asm volatile("s_waitcnt vmcnt(0)" ::: "memory");
    __syncthreads();
    if (threadIdx.x == 0) {
        unsigned* bar = b.bar;
        __builtin_amdgcn_s_waitcnt(0);
        unsigned nloc = b.st[0], nx = b.st[1];
        if (nloc == 0u) { xcd_barrier_complete(bar, b.x, nloc, nx); b.st[0] = nloc; b.st[1] = nx; }
        const unsigned old = xb_add(&bar[XB_XSUB(b.x)], 1u);
        const unsigned gen = old / nloc;
        if (old + 1u == (gen + 1u) * nloc) {
            __builtin_amdgcn_fence(__ATOMIC_RELEASE, "agent");
            asm volatile("s_waitcnt vmcnt(0)" ::: "memory");
            const unsigned og = xb_add(&bar[XB_TOP], 1u);
            const unsigned tg = og / nx;
            if (og + 1u == (tg + 1u) * nx) xb_add(&bar[XB_TOPGEN], 1u);
            else XB_SPIN(xb_ld(&bar[XB_TOPGEN]) == tg, bar);
            __builtin_amdgcn_fence(__ATOMIC_ACQUIRE, "agent");
            xb_add(&bar[XB_XGEN(b.x)], 1u);
            asm volatile("s_waitcnt vmcnt(0)" ::: "memory");
        } else {
            XB_SPIN(xb_ld(&bar[XB_XGEN(b.x)]) == gen, bar);
            __builtin_amdgcn_fence(__ATOMIC_ACQUIRE, "agent");
            asm volatile("s_waitcnt vmcnt(0)" ::: "memory");
        }
    }
    __syncthreads();
}

struct Args { const float* in[31]; float* out; unsigned char* ws; int ph_lo, ph_hi; };
enum { I_XP = 0, I_XS, I_CK, I_CV, I_SHG, I_SLRU, I_C, I_CCTX, I_MODW, I_MODB, I_NORMG, I_F1UP, I_F1DN, I_F2UP, I_F2DN, I_WIN, I_LBL, I_HGN, I_RPB, I_CONVW, I_CONVB,
       I_LWA, I_LBA, I_LWX, I_LBX, I_LAM, I_PA, I_PB, I_PC, I_WOUT, I_FNG };
constexpr size_t OUT_Y = 0, OUT_K = 12582912, OUT_V = 20971520, OUT_SH = 29360128, OUT_SL = 33554432;

#ifndef PROBE_ZERO_YS
#define PROBE_ZERO_YS 0
#endif
#ifndef PROBE_ZERO_YP
#define PROBE_ZERO_YP 0
#endif
#ifndef CV_BACKGROUND
#define CV_BACKGROUND 0
#endif
struct Frame { LAS unsigned char* lds; int tid, lane, wave, G, gw, NGW; };
__device__ __forceinline__ int opq(int v) { asm volatile("" : "+v"(v)); return v; }

__device__ __forceinline__ int next_unit(gu32* head, volatile LAS unsigned* slot) {
    __syncthreads();
    if (threadIdx.x == 0) *slot = __hip_atomic_fetch_add(head, 1u, RLX_AGENT);
    __syncthreads();
    return (int)*slot;
}

__device__ __forceinline__ void cv_load(const float* W, int N, int k0, int n0, int lane, float (&v)[32]) {
#pragma unroll
    for (int i = 0; i < 32; ++i) v[i] = __builtin_nontemporal_load(W + (size_t)(k0 + 2 * i + (lane >> 5)) * N + n0 + (lane & 31));
}
__device__ __forceinline__ void cv_store(const float (&v)[32], int K, bf16* WT, int dst_row0, LAS float* scr, int k0, int lane) {
#pragma unroll
    for (int i = 0; i < 32; ++i) scr[(2 * i + (lane >> 5)) * 33 + (lane & 31)] = v[i];
    LDS_WAIT(); asm volatile("" ::: "memory");
    const int c = lane & 7;
#pragma unroll
    for (int j = 0; j < 4; ++j) { const int n = (lane >> 3) + 8 * j; const LAS float* s = scr + (8 * c) * 33 + n;
        v4u o; o.x = pk2(s[0 * 33], s[1 * 33]); o.y = pk2(s[2 * 33], s[3 * 33]); o.z = pk2(s[4 * 33], s[5 * 33]); o.w = pk2(s[6 * 33], s[7 * 33]);
        *(v4u*)(WT + (size_t)(dst_row0 + n) * K + k0 + 8 * c) = o; }
    LDS_WAIT(); asm volatile("" ::: "memory");
}
constexpr int CV_UP = 32 * 352, CV_DN = 88 * 64, CV_IN = 32 * 400, CV_A = 8 * 64, CV_B = 16 * 64, CV_O = 32 * 64, CV_PER_LAYER = 2 * CV_UP + 2 * CV_DN + CV_IN + 2 * CV_A + CV_B + CV_O;
constexpr int CV_CLAIM = 16, CV_CPL = CV_PER_LAYER / CV_CLAIM, CV_NCLAIM = DEPTH * CV_CPL, CV_STATIC = CV_UP / CV_CLAIM;
static_assert(CV_PER_LAYER % CV_CLAIM == 0 && CV_UP % CV_CLAIM == 0, "claims");
__device__ __forceinline__ int cv_need(int l, int j) {
    constexpr int T_DN1 = (CV_UP + CV_DN) / CV_CLAIM, T_IN = T_DN1 + CV_IN / CV_CLAIM, T_MRG = T_IN + (2 * CV_A + CV_B) / CV_CLAIM, T_OUT = T_MRG + CV_O / CV_CLAIM, T_UP2 = T_OUT + CV_UP / CV_CLAIM, T_DN2 = T_UP2 + CV_DN / CV_CLAIM;
    const int r = j == 0 ? T_DN1 : j <= 2 ? T_IN : j <= 5 ? T_MRG : j == 6 ? T_OUT : j <= 8 ? T_UP2 : j == 9 ? T_DN2 : T_DN2 + CV_STATIC;
    const int n = l * CV_CPL + r; return n < CV_NCLAIM ? n : CV_NCLAIM;
}
struct CvItem { const float* W; bf16* WT; int K, N, k0, n0, drow; };
__device__ __forceinline__ CvItem cv_decode(const Args& A, int it) {
    const int l = it / CV_PER_LAYER; int r = it % CV_PER_LAYER;
    unsigned char* wl = A.ws + WS_W + (size_t)l * W_LAYER;
    const float* W; int K, N; bf16* WT; int up = 0;
    if (r < CV_UP) { W = A.in[I_F1UP] + (size_t)l * DM * 2 * DFF; K = DM; N = 2 * DFF; WT = (bf16*)(wl + WO_UP1); up = 1; }
    else if ((r -= CV_UP) < CV_DN) { W = A.in[I_F1DN] + (size_t)l * DFF * DM; K = DFF; N = DM; WT = (bf16*)(wl + WO_DN1); }
    else if ((r -= CV_DN) < CV_IN) { W = A.in[I_WIN] + (size_t)l * DM * DIN; K = DM; N = DIN; WT = (bf16*)(wl + WO_IN); }
    else if ((r -= CV_IN) < CV_A) { W = A.in[I_PA] + (size_t)l * 512 * DM; K = 512; N = DM; WT = (bf16*)(wl + WO_PA); }
    else if ((r -= CV_A) < CV_B) { W = A.in[I_PB] + (size_t)l * 1024 * DM; K = 1024; N = DM; WT = (bf16*)(wl + WO_PB); }
    else if ((r -= CV_B) < CV_A) { W = A.in[I_PC] + (size_t)l * 512 * DM; K = 512; N = DM; WT = (bf16*)(wl + WO_PC); }
    else if ((r -= CV_A) < CV_O) { W = A.in[I_WOUT] + (size_t)l * DM * DM; K = DM; N = DM; WT = (bf16*)(wl + WO_OUT); }
    else if ((r -= CV_O) < CV_UP) { W = A.in[I_F2UP] + (size_t)l * DM * 2 * DFF; K = DM; N = 2 * DFF; WT = (bf16*)(wl + WO_UP2); up = 1; }
    else { r -= CV_UP; W = A.in[I_F2DN] + (size_t)l * DFF * DM; K = DFF; N = DM; WT = (bf16*)(wl + WO_DN2); }
    const int nblk = N / 32, kb = r / nblk, nb = r % nblk, n0 = 32 * nb;
    int drow = n0;
    if (up) { const int j0 = n0 < DFF ? n0 : n0 - DFF; drow = 256 * (j0 >> 7) + (j0 & 127) + (n0 < DFF ? 0 : 128); }
    CvItem c; c.W = W; c.WT = WT; c.K = K; c.N = N; c.k0 = 64 * kb; c.n0 = n0; c.drow = drow; return c;
}
__device__ __forceinline__ void p0_convert(const Frame& F_, const Args& A) {
    Frame F = F_; F.tid = opq(F_.tid); F.lane = F.tid & 63;
    LAS float* scr = (LAS float*)(F.lds + F.wave * 16384);
    for (int it = F.gw; it < (CV_BACKGROUND ? CV_UP : DEPTH * CV_PER_LAYER); it += F.NGW) { const CvItem c = cv_decode(A, it); float v[32]; cv_load(c.W, c.N, c.k0, c.n0, F.lane, v); cv_store(v, c.K, c.WT, c.drow, scr, c.k0, F.lane); }
}
__device__ __forceinline__ void cv_until(const Frame& F_, const Args& A, gu32* head, int need, gu32* fin, volatile LAS unsigned* slot) {
    Frame F = F_; F.tid = opq(F_.tid); F.lane = F.tid & 63;
    LAS float* scr = (LAS float*)(F.lds + F.wave * 16384);
    if (fin) { __syncthreads(); if (F.tid == 0) __hip_atomic_fetch_add(fin, 1u, RLX_AGENT); }
    for (;;) {
        __syncthreads();
        if (F.tid == 0) { const unsigned f = fin ? __hip_atomic_load(fin, RLX_AGENT) : 0xffffffffu, h = CV_STATIC + __hip_atomic_load(head, RLX_AGENT);
            slot[1] = f; slot[0] = (h >= (unsigned)need && f >= (unsigned)F.G) ? 0x7fffffffu : CV_STATIC + __hip_atomic_fetch_add(head, 1u, RLX_AGENT); }
        __syncthreads();
        const int c = (int)slot[0]; const bool others_done = slot[1] >= (unsigned)F.G;
        if (c >= CV_NCLAIM) break;
        { const CvItem c0 = cv_decode(A, c * CV_CLAIM + 2 * F.wave), c1 = cv_decode(A, c * CV_CLAIM + 2 * F.wave + 1); float v0[32], v1[32];
          cv_load(c0.W, c0.N, c0.k0, c0.n0, F.lane, v0); cv_load(c1.W, c1.N, c1.k0, c1.n0, F.lane, v1);
          cv_store(v0, c0.K, c0.WT, c0.drow, scr, c0.k0, F.lane); cv_store(v1, c1.K, c1.WT, c1.drow, scr, c1.k0, F.lane); }
        if (c >= need && others_done) break;
    }
}
__device__ __forceinline__ void p0_cache(const Frame& F_, const Args& A) {
    Frame F = F_; F.tid = opq(F_.tid); F.lane = F.tid & 63;
    const int gt = blockIdx.x * NTHREADS + F.tid, NT = F.G * NTHREADS;
    bf16* CKB = (bf16*)(A.ws + WS_CKB); bf16* CVT = (bf16*)(A.ws + WS_CVT);
    for (int i = gt; i < 2 * 2 * 512 * 1024 / 8; i += NT) { const float* p = A.in[I_CK] + (size_t)i * 8; const f32x4 a = *(const f32x4*)p, b = *(const f32x4*)(p + 4);
        v4u o; o.x = pk2(a.x, a.y); o.y = pk2(a.z, a.w); o.z = pk2(b.x, b.y); o.w = pk2(b.z, b.w); *(v4u*)(CKB + (size_t)i * 8) = o; }
    for (int i = gt; i < 2 * 2 * 64 * 1024; i += NT) {
        const int hd = i & 1023, jb = (i >> 10) & 63, bl = i >> 16; const float* p = A.in[I_CV] + ((size_t)(bl * 512 + jb * 8)) * 1024 + hd;
        v4u o; o.x = pk2(p[0], p[1024]); o.y = pk2(p[2048], p[3072]); o.z = pk2(p[4096], p[5120]); o.w = pk2(p[6144], p[7168]);
        *(v4u*)(CVT + ((size_t)(bl * 8 + (hd >> 7)) * 128 + (hd & 127)) * 512 + jb * 8) = o; }
}
__device__ __forceinline__ void p0_mods_partial(const Frame& F_, const Args& A) {
    Frame F = F_; F.tid = opq(F_.tid); F.lane = F.tid & 63;
    float* MODP = (float*)(A.ws + WS_MODP);
    const float* cc = A.in[I_CCTX]; const float* c1 = A.in[I_C];
    for (int task = F.gw; task < 2 * 32 * 72; task += F.NGW) {
        const int l = task / 2304, r = task % 2304, kc = r / 72, nb = r % 72, n = nb * 256 + F.lane * 4;
        const float* w = A.in[I_MODW] + ((size_t)l * DM + kc * 64) * 18432 + n;
        f32x4 a0 = {0.f, 0.f, 0.f, 0.f}, a1 = a0, a2 = a0;
#pragma unroll 16
        for (int k = 0; k < 64; ++k) { const f32x4 wv = __builtin_nontemporal_load((const f32x4*)(w + (size_t)k * 18432)); const int kk = kc * 64 + k;
            const float s0 = silu_f(cc[kk]), s1 = silu_f(c1[kk]), s2 = silu_f(c1[DM + kk]);
            a0 += wv * s0; a1 += wv * s1; a2 += wv * s2; }
        float* o = MODP + (size_t)kc * 110592 + (size_t)l * 55296 + n;
        *(f32x4*)(o) = a0; *(f32x4*)(o + 18432) = a1; *(f32x4*)(o + 2 * 18432) = a2;
    }
}
__device__ __forceinline__ void p0_mods_reduce(const Frame& F_, const Args& A) {
    Frame F = F_; F.tid = opq(F_.tid); F.lane = F.tid & 63;
    const float* MODP = (const float*)(A.ws + WS_MODP); float* MODS = (float*)(A.ws + WS_MODS);
    for (int idx = blockIdx.x * NTHREADS + F.tid; idx < 110592; idx += F.G * NTHREADS) {
        const int l = idx / 55296, n = idx % 18432; float s = A.in[I_MODB][l * 18432 + n];
#pragma unroll 8
        for (int kc = 0; kc < 32; ++kc) s += MODP[(size_t)kc * 110592 + idx];
        MODS[idx] = s;
    }
}
template <int MODE>
__device__ __forceinline__ void norm_rows(const Frame& F_, const float* x0, const float* x1, float* xcopy, const float* g, const float* mods_l, int slot, bf16* H, float* outf) {
    Frame F = F_; F.tid = opq(F_.tid); F.lane = F.tid & 63;
    for (int row = F.gw; row < MTOK; row += F.NGW) {
        const float* xr = row < NCTX ? x0 + (size_t)row * DM : x1 + (size_t)(row - NCTX) * DM;
        const int cidx = row < NCTX ? 0 : 1 + ((row - NCTX) >> 10);
        f32x4 v[8]; float ss = 0.f;
#pragma unroll
        for (int j = 0; j < 8; ++j) { v[j] = *(const f32x4*)(xr + 4 * F.lane + 256 * j); ss += (v[j].x * v[j].x + v[j].y * v[j].y) + (v[j].z * v[j].z + v[j].w * v[j].w); }
        const float rstd = 1.0f / sqrtf(wave_sum(ss) * (1.0f / DM) + 1e-6f);
        if (MODE == 0) {
            const float* sh = mods_l + (size_t)(cidx * 9 + 3 * slot) * DM; const float* sc = sh + DM;
#pragma unroll
            for (int j = 0; j < 8; ++j) { const int c = 4 * F.lane + 256 * j; const f32x4 gg = *(const f32x4*)(g + c), s1 = *(const f32x4*)(sc + c), s0 = *(const f32x4*)(sh + c);
                const f32x4 y = v[j] * rstd * gg * (s1 + 1.0f) + s0; v2u o; o.x = pk2(y.x, y.y); o.y = pk2(y.z, y.w);
                *(v2u*)(H + (size_t)row * DM + c) = o;
                if (xcopy) *(f32x4*)(xcopy + (size_t)row * DM + c) = v[j]; }
        } else {
#pragma unroll
            for (int j = 0; j < 8; ++j) { const int c = 4 * F.lane + 256 * j; const f32x4 gg = *(const f32x4*)(g + c);
                f32x4 yv = v[j] * rstd * gg;
#if PROBE_ZERO_YS
                if (row >= NCTX) yv = (f32x4){0.f, 0.f, 0.f, 0.f};
#endif
#if PROBE_ZERO_YP
                if (row < NCTX) yv = (f32x4){0.f, 0.f, 0.f, 0.f};
#endif
                *(f32x4*)(outf + (size_t)row * DM + c) = yv; }
        }
    }
}

constexpr int AK_STRIDE = 272, AV_STRIDE = 528, A_K_OFF = 0, A_V_OFF = 69632;
constexpr float NA_SCALE = 0.08838834764831845f;
__device__ __forceinline__ void attn_stage(LAS unsigned char* lds, int tid, const bf16* kbase, size_t kstride, const bf16* vbase, size_t vstride) {
    v4u kx[8], vx[8];
#pragma unroll
    for (int i = 0; i < 8; ++i) { const int idx = tid + 512 * i; kx[i] = *(const v4u*)(kbase + (size_t)(idx >> 4) * kstride + (idx & 15) * 8); }
#pragma unroll
    for (int i = 0; i < 8; ++i) { const int idx = tid + 512 * i; vx[i] = *(const v4u*)(vbase + (size_t)(idx >> 5) * vstride + (idx & 31) * 8); }
#pragma unroll
    for (int i = 0; i < 8; ++i) { const int idx = tid + 512 * i; *(LAS v4u*)(lds + A_K_OFF + (idx >> 4) * AK_STRIDE + (idx & 15) * 16) = kx[i]; }
#pragma unroll
    for (int i = 0; i < 8; ++i) { const int idx = tid + 512 * i; *(LAS v4u*)(lds + A_V_OFF + (idx >> 5) * AV_STRIDE + (idx & 31) * 16) = vx[i]; }
}
template <class KF, class VF>
__device__ __forceinline__ void attn_stage32(LAS unsigned char* lds, int tid, KF kf, VF vf) {
    { const int key = tid >> 1, half = tid & 1; const float* p = kf(key) + 64 * half; LAS unsigned char* dst = lds + A_K_OFF + key * AK_STRIDE + half * 128;
#pragma unroll
      for (int i = 0; i < 8; ++i) { const f32x4 a = *(const f32x4*)(p + 8 * i), b = *(const f32x4*)(p + 8 * i + 4);
          v4u o; o.x = pk2(a.x, a.y); o.y = pk2(a.z, a.w); o.z = pk2(b.x, b.y); o.w = pk2(b.z, b.w); *(LAS v4u*)(dst + 16 * i) = o; } }
    { const int kp = tid >> 2, dq = tid & 3; const float* p0 = vf(2 * kp) + 32 * dq; const float* p1 = vf(2 * kp + 1) + 32 * dq;
#pragma unroll
      for (int i = 0; i < 8; ++i) { const f32x4 a = *(const f32x4*)(p0 + 4 * i), b = *(const f32x4*)(p1 + 4 * i);
#pragma unroll
          for (int j = 0; j < 4; ++j) *(LAS unsigned*)(lds + A_V_OFF + (32 * dq + 4 * i + j) * AV_STRIDE + kp * 4) = pk2(a[j], b[j]); } }
}
__device__ __forceinline__ void attn_load_q32(const float* qrow, int g, bf16x8 (&qf)[4]) {
#pragma unroll
    for (int s = 0; s < 4; ++s) { const f32x4 a = *(const f32x4*)(qrow + 32 * s + 8 * g), b = *(const f32x4*)(qrow + 32 * s + 8 * g + 4);
        v4u o; o.x = pk2(a.x, a.y); o.y = pk2(a.z, a.w); o.z = pk2(b.x, b.y); o.w = pk2(b.z, b.w); qf[s] = __builtin_bit_cast(bf16x8, o); }
}
struct AttnState { float m, l; f32x4 ot[8]; };
template <int NKS, bool LOCAL, class BF>
__device__ __forceinline__ void attn_chunk(LAS unsigned char* lds, const bf16x8 (&qf)[4], AttnState& st, int lane, int t0, BF bias) {
    const int g = lane >> 4, c = lane & 15;
    f32x4 sc[NKS][2];
#pragma unroll
    for (int i = 0; i < NKS; ++i) { const int T0 = LOCAL ? 4 * i + t0 : 2 * i;
#pragma unroll
        for (int a = 0; a < 2; ++a) { f32x4 acc = {0.f, 0.f, 0.f, 0.f};
#pragma unroll
            for (int s = 0; s < 4; ++s) { const bf16x8 kfr = *(const LAS bf16x8*)(lds + A_K_OFF + (16 * (T0 + a) + c) * AK_STRIDE + 64 * s + 16 * g);
                acc = __builtin_amdgcn_mfma_f32_16x16x32_bf16(kfr, qf[s], acc, 0, 0, 0); }
            sc[i][a] = acc; } }
    float mx = -3.0e38f;
#pragma unroll
    for (int i = 0; i < NKS; ++i) { const int T0 = LOCAL ? 4 * i + t0 : 2 * i;
#pragma unroll
        for (int a = 0; a < 2; ++a)
#pragma unroll
            for (int r = 0; r < 4; ++r) { float s = sc[i][a][r] * NA_SCALE; if (LOCAL) s = bias(16 * (T0 + a) + 4 * g + r, s); sc[i][a][r] = s; mx = fmaxf(mx, s); } }
    mx = fmaxf(mx, __shfl_xor(mx, 16)); mx = fmaxf(mx, __shfl_xor(mx, 32));
    const float mnew = fmaxf(st.m, mx), alpha = __expf(st.m - mnew); float sum = 0.f;
#pragma unroll
    for (int i = 0; i < NKS; ++i)
#pragma unroll
        for (int a = 0; a < 2; ++a)
#pragma unroll
            for (int r = 0; r < 4; ++r) { const float p = __expf(sc[i][a][r] - mnew); sc[i][a][r] = p; sum += p; }
    sum += __shfl_xor(sum, 16); sum += __shfl_xor(sum, 32);
    st.l = st.l * alpha + sum; st.m = mnew;
#pragma unroll
    for (int dt = 0; dt < 8; ++dt) st.ot[dt] = st.ot[dt] * alpha;
#pragma unroll
    for (int i = 0; i < NKS; ++i) { const int T0 = LOCAL ? 4 * i + t0 : 2 * i;
        v4u pb; pb.x = pk2(sc[i][0][0], sc[i][0][1]); pb.y = pk2(sc[i][0][2], sc[i][0][3]); pb.z = pk2(sc[i][1][0], sc[i][1][1]); pb.w = pk2(sc[i][1][2], sc[i][1][3]);
        const bf16x8 pfr = __builtin_bit_cast(bf16x8, pb);
#pragma unroll
        for (int dt = 0; dt < 8; ++dt) { const LAS unsigned char* vp = lds + A_V_OFF + (16 * dt + c) * AV_STRIDE + (16 * T0 + 4 * g) * 2;
            const v2u lo = *(const LAS v2u*)vp, hi = *(const LAS v2u*)(vp + 32); v4u av; av.x = lo.x; av.y = lo.y; av.z = hi.x; av.w = hi.y;
            st.ot[dt] = __builtin_amdgcn_mfma_f32_16x16x32_bf16(__builtin_bit_cast(bf16x8, av), pfr, st.ot[dt], 0, 0, 0); } }
}
__device__ __forceinline__ void attn_load_q(const bf16* qrow, int g, bf16x8 (&qf)[4]) {
#pragma unroll
    for (int s = 0; s < 4; ++s) qf[s] = *(const bf16x8*)(qrow + 32 * s + 8 * g);
}
__device__ __forceinline__ void attn_store(const AttnState& st, bf16* orow, int g) {
    const float inv = 1.0f / st.l;
#pragma unroll
    for (int dt = 0; dt < 8; ++dt) { v2u o; o.x = pk2(st.ot[dt][0] * inv, st.ot[dt][1] * inv); o.y = pk2(st.ot[dt][2] * inv, st.ot[dt][3] * inv); *(v2u*)(orow + 16 * dt + 4 * g) = o; }
}
__device__ __forceinline__ void attn_ctx_unit(const Frame& F_, const Args& A, int u) {
    Frame F = F_; F.tid = opq(F_.tid); F.lane = F.tid & 63;
    const int b = u >> 4, h = (u >> 1) & 7, qh = u & 1, g = F.lane >> 4, c = F.lane & 15;
    const bf16* QB = (const bf16*)(A.ws + WS_QB); const bf16* KB = (const bf16*)(A.ws + WS_KB); const bf16* VT = (const bf16*)(A.ws + WS_VT);
    const int row = b * SEQ + qh * 128 + 16 * F.wave + c;
    bf16x8 qf[4];
#if PROBE_QKV32
    { const float* Z3 = (const float*)(A.ws + 736 * MiB); const float* zb = Z3 + (size_t)(b * SEQ) * 3072 + h * 128;
      attn_stage32(F.lds, F.tid, [&](int k) { return zb + (size_t)k * 3072 + 1024; }, [&](int k) { return zb + (size_t)k * 3072 + 2048; });
      attn_load_q32(Z3 + (size_t)row * 3072 + h * 128, g, qf); }
#else
    attn_stage(F.lds, F.tid, KB + (size_t)(b * SEQ) * 1024 + h * 128, 1024, VT + (size_t)(b * 8 + h) * 128 * 256, 256);
    attn_load_q(QB + (size_t)row * 1024 + h * 128, g, qf);
#endif
    AttnState st; st.m = -3.0e38f; st.l = 0.f;
#pragma unroll
    for (int dt = 0; dt < 8; ++dt) st.ot[dt] = (f32x4){0.f, 0.f, 0.f, 0.f};
    __syncthreads();
    attn_chunk<8, false>(F.lds, qf, st, F.lane, 0, [](int, float s) { return s; });
    attn_store(st, (bf16*)(A.ws + WS_OB) + (size_t)row * 1024 + h * 128, g);
}
__device__ __forceinline__ void attn_na_unit(const Frame& F_, const Args& A, int u, int layer) {
    Frame F = F_; F.tid = opq(F_.tid); F.lane = F.tid & 63;
    const int b = u >> 7, h = (u >> 4) & 7, r = u & 15, g = F.lane >> 4, c = F.lane & 15, w = F.wave;
    const bf16* QB = (const bf16*)(A.ws + WS_QB); const bf16* KB = (const bf16*)(A.ws + WS_KB); const bf16* VT = (const bf16*)(A.ws + WS_VT);
    const int kr0 = min(max(r - 4, 0), 8);
    const int qc = 8 * w + (c & 7), row = NCTX + b * DSEQ + r * 64 + qc;
    const int wstart = min(max(qc - 8, 0), 48), t0 = min(max(8 * w - 8, 0), 40) >> 4;
    const float* rpb = A.in[I_RPB] + (size_t)(layer * 8 + h) * 15 * 31;
    bf16x8 qf[4];
#if PROBE_QKV32
    attn_load_q32((const float*)(A.ws + 736 * MiB) + (size_t)row * 3072 + h * 128, g, qf);
#else
    attn_load_q(QB + (size_t)row * 1024 + h * 128, g, qf);
#endif
    AttnState st; st.m = -3.0e38f; st.l = 0.f;
#pragma unroll
    for (int dt = 0; dt < 8; ++dt) st.ot[dt] = (f32x4){0.f, 0.f, 0.f, 0.f};
#if PROBE_QKV32
    const float* Z3 = (const float*)(A.ws + 736 * MiB); const float* zl = Z3 + (size_t)(NCTX + b * DSEQ) * 3072 + h * 128;
    for (int ci = 0; ci < 2; ++ci) {
        const int krow = kr0 + 4 * ci;
        if (ci) __syncthreads();
        attn_stage32(F.lds, F.tid, [&](int k) { return zl + (size_t)(krow * 64 + k) * 3072 + 1024; }, [&](int k) { return zl + (size_t)(krow * 64 + k) * 3072 + 2048; });
        __syncthreads();
        attn_chunk<4, true>(F.lds, qf, st, F.lane, t0, [&](int kk, float s) {
            const int ky = krow + (kk >> 6), kx = kk & 63; const bool ok = kx >= wstart && kx < wstart + 16;
            const int dy = ky - r + 7, dx = min(max(kx - qc + 15, 0), 30);
            return ok ? s + rpb[dy * 31 + dx] : -1.0e30f; });
    }
    const float* ck = A.in[I_CK] + ((size_t)(b * 2 + layer) * 512 * 8 + h) * 128; const float* cv = A.in[I_CV] + ((size_t)(b * 2 + layer) * 512 * 8 + h) * 128;
    for (int ci = 0; ci < 2; ++ci) {
        __syncthreads();
        attn_stage32(F.lds, F.tid, [&](int k) { return ck + (size_t)(ci * 256 + k) * 1024; }, [&](int k) { return cv + (size_t)(ci * 256 + k) * 1024; });
        __syncthreads();
        attn_chunk<8, false>(F.lds, qf, st, F.lane, 0, [](int, float s) { return s; });
    }
#else
    const bf16* kl = KB + (size_t)(NCTX + b * DSEQ) * 1024 + h * 128; const bf16* vl = VT + (size_t)4096 * 1024 + (size_t)(b * 8 + h) * 128 * 1024;
    for (int ci = 0; ci < 2; ++ci) {
        const int krow = kr0 + 4 * ci;
        if (ci) __syncthreads();
        attn_stage(F.lds, F.tid, kl + (size_t)(krow * 64) * 1024, 1024, vl + krow * 64, 1024);
        __syncthreads();
        attn_chunk<4, true>(F.lds, qf, st, F.lane, t0, [&](int kk, float s) {
            const int ky = krow + (kk >> 6), kx = kk & 63; const bool ok = kx >= wstart && kx < wstart + 16;
            const int dy = ky - r + 7, dx = min(max(kx - qc + 15, 0), 30);
            return ok ? s + rpb[dy * 31 + dx] : -1.0e30f; });
    }
    const bf16* ck = (const bf16*)(A.ws + WS_CKB) + (size_t)(b * 2 + layer) * 512 * 1024 + h * 128; const bf16* cv = (const bf16*)(A.ws + WS_CVT) + (size_t)((b * 2 + layer) * 8 + h) * 128 * 512;
    for (int ci = 0; ci < 2; ++ci) {
        __syncthreads();
        attn_stage(F.lds, F.tid, ck + (size_t)(ci * 256) * 1024, 1024, cv + ci * 256, 512);
        __syncthreads();
        attn_chunk<8, false>(F.lds, qf, st, F.lane, 0, [](int, float s) { return s; });
    }
#endif
    if (c < 8) attn_store(st, (bf16*)(A.ws + WS_OB) + (size_t)row * 1024 + h * 128, g);
}

__device__ __forceinline__ int hg_slot(int s, int h, int dir, int c) { return s < 16 ? s * 32 + c * 8 + h * 2 + dir : 512 + (s - 16) * 128 + c * 8 + h * 2 + dir; }
template <int CTRL> __device__ __forceinline__ float dpp_xor(float v) { return __builtin_bit_cast(float, __builtin_amdgcn_update_dpp(0, __builtin_bit_cast(int, v), CTRL, 0xf, 0xf, true)); }
__device__ __forceinline__ void hgrn_local_unit(const Frame& F_, const Args& A, int u, int layer) {
    Frame F = F_; F.tid = opq(F_.tid); F.lane = F.tid & 63;
    int s, c, hd;
    if (u < 512) { s = u >> 5; c = (u >> 3) & 3; hd = u & 7; } else { const int v = u - 512; s = 16 + (v >> 7); c = (v >> 3) & 15; hd = v & 7; }
    const int h = hd >> 1, dir = hd & 1, tokbase = s < 16 ? s * SEQ : NCTX + (s - 16) * DSEQ, g = F.lane >> 4, c15 = F.lane & 15, w = F.wave;
    const float* Z = (const float*)(A.ws + WS_ZF);
    constexpr int LS = 132, AS = 68;
    LAS float* Qt = (LAS float*)F.lds; LAS float* Kt = Qt + 64 * LS; LAS float* Vs = Kt + 64 * LS; LAS float* Bs = Vs + 64 * LS; LAS float* SC = Bs + 64 * LS; LAS float* As = Bs;
    const int d = F.tid & 127, I4 = F.tid >> 7;
    {   float lbv = 0.f;
        if (layer == 1) { const float* lg = A.in[I_LBL]; lbv = sigmoid_f(lg[1024 + dir * 512 + h * 128 + d] - lg[dir * 512 + h * 128 + d]); }
        float zq[16], zf[16], zv[16];
#pragma unroll
        for (int k = 0; k < 16; ++k) { const int i = 16 * I4 + k, t = dir ? 64 * c + 63 - i : 64 * c + i; const float* zr = Z + (size_t)(tokbase + t) * ZFW + h * 128 + d;
            zq[k] = zr[ZQ]; zf[k] = zr[dir ? ZFB : ZFF]; zv[k] = zr[ZI]; }
        float b = 0.f;
#pragma unroll
        for (int k = 0; k < 16; ++k) { const int i = 16 * I4 + k; const float f = lbv + (1.f - lbv) * sigmoid_f(zf[k]);
            b += __logf(fmaxf(f, 1e-30f));
            Qt[i * LS + d] = silu_f(zq[k]); Kt[i * LS + d] = (1.f - lbv) * sigmoid_f(-zf[k]); Vs[i * LS + d] = zv[k]; Bs[i * LS + d] = b; }
    }
    __syncthreads();
    {
        float* QD = (float*)(A.ws + WS_HQD);
        const float t0 = Bs[15 * LS + d], t1 = Bs[31 * LS + d], t2 = Bs[47 * LS + d], t3 = Bs[63 * LS + d];
        const float bsI = I4 == 0 ? 0.f : I4 == 1 ? t0 : I4 == 2 ? t0 + t1 : t0 + t1 + t2, totI = I4 == 0 ? t0 : I4 == 1 ? t1 : I4 == 2 ? t2 : t3;
#pragma unroll
        for (int k = 0; k < 16; ++k) { const int i = 16 * I4 + k, t = dir ? 64 * c + 63 - i : 64 * c + i;
            const float bl = Bs[i * LS + d], q = Qt[i * LS + d], kk = Kt[i * LS + d], e1 = __expf(bl);
            QD[((size_t)(tokbase + t) * 2 + dir) * 512 + h * 128 + d] = q * e1 * __expf(bsI);
            Qt[i * LS + d] = q * e1; Kt[i * LS + d] = kk * __expf(totI - bl); }
        for (int idx = F.tid; idx < 14 * 128; idx += NTHREADS) { const int v = idx >> 7, dd = idx & 127;
            const float u0 = Bs[15 * LS + dd], u1 = Bs[31 * LS + dd], u2 = Bs[47 * LS + dd], u3 = Bs[63 * LS + dd];
            float x;
            if (v < 6) x = v == 0 ? 0.f : v == 1 ? u1 : v == 2 ? 0.f : v == 3 ? u1 + u2 : v == 4 ? u2 : 0.f;
            else if (v < 10) x = -(v == 6 ? u0 : v == 7 ? u1 : v == 8 ? u2 : u3);
            else x = v == 10 ? u1 + u2 + u3 : v == 11 ? u2 + u3 : v == 12 ? u3 : 0.f;
            SC[idx] = __expf(x);
            if (v == 13) ((float*)(A.ws + WS_HDEC))[(size_t)u * 128 + dd] = __expf(u0 + u1 + u2 + u3); }
    }
    __syncthreads();
    {
        float av[16];
#pragma unroll
        for (int ks = 0; ks < 16; ++ks) { const int j = 4 * ks + g; av[ks] = Kt[j * LS + 16 * w + c15] * SC[(10 + (j >> 4)) * 128 + 16 * w + c15]; }
        float* SL = (float*)(A.ws + WS_HSL) + (size_t)u * 16384;
        for (int et = 0; et < 8; ++et) { f32x4 acc = {0.f, 0.f, 0.f, 0.f};
#pragma unroll
            for (int ks = 0; ks < 16; ++ks) acc = __builtin_amdgcn_mfma_f32_16x16x4f32(av[ks], Vs[(4 * ks + g) * LS + 16 * et + c15], acc, 0, 0, 0);
#pragma unroll
            for (int r = 0; r < 4; ++r) SL[(16 * w + 4 * g + r) * 128 + 16 * et + c15] = acc[r]; }
    }
    for (int tl = w; tl < 10; tl += 8) {
        int I, J, sv;
        if (tl < 4) { I = tl; J = tl; sv = 6 + tl; } else { const int v = tl - 4; I = v < 1 ? 1 : (v < 3 ? 2 : 3); J = v < 1 ? 0 : (v < 3 ? v - 1 : v - 3); sv = v; }
        f32x4 acc = {0.f, 0.f, 0.f, 0.f};
#pragma unroll 8
        for (int ks = 0; ks < 32; ++ks) { const int dd = 4 * ks + g;
            acc = __builtin_amdgcn_mfma_f32_16x16x4f32(Qt[(16 * I + c15) * LS + dd] * SC[sv * 128 + dd], Kt[(16 * J + c15) * LS + dd], acc, 0, 0, 0); }
#pragma unroll
        for (int r = 0; r < 4; ++r) As[(16 * I + 4 * g + r) * AS + 16 * J + c15] = (I == J && c15 > 4 * g + r) ? 0.f : acc[r];
    }
    __syncthreads();
    {   float* OL = (float*)(A.ws + WS_HOL);
#pragma unroll
        for (int I = 0; I < 4; ++I) { f32x4 acc = {0.f, 0.f, 0.f, 0.f};
            for (int ks = 0; ks < 4 * (I + 1); ++ks) acc = __builtin_amdgcn_mfma_f32_16x16x4f32(As[(16 * I + c15) * AS + 4 * ks + g], Vs[(4 * ks + g) * LS + 16 * w + c15], acc, 0, 0, 0);
#pragma unroll
            for (int r = 0; r < 4; ++r) { const int i = 16 * I + 4 * g + r, t = dir ? 64 * c + 63 - i : 64 * c + i; OL[((size_t)(tokbase + t) * 2 + dir) * 512 + h * 128 + 16 * w + c15] = acc[r]; } }
    }
}
__device__ __forceinline__ void hgrn_final_unit(const Frame& F_, const Args& A, int u, int layer) {
    Frame F = F_; F.tid = opq(F_.tid); F.lane = F.tid & 63;
    int s, c, h, nC;
    if (u < 128) { s = 16 + (u >> 6); c = (u >> 2) & 15; h = u & 3; nC = 16; } else { const int v = u - 128; s = v >> 4; c = (v >> 2) & 3; h = v & 3; nC = 4; }
    const int tokbase = s < 16 ? s * SEQ : NCTX + (s - 16) * DSEQ, g = F.lane >> 4, c15 = F.lane & 15, w = F.wave;
    constexpr int LS = 132;
    LAS float* Ss = (LAS float*)F.lds; LAS float* Qd = Ss + 128 * LS; LAS float* Os = Qd + 64 * LS;
    const float* HSL = (const float*)(A.ws + WS_HSL); const float* HDEC = (const float*)(A.ws + WS_HDEC); const float* QD = (const float*)(A.ws + WS_HQD);
    f32x4 acc[4];
#pragma unroll
    for (int tt = 0; tt < 4; ++tt) acc[tt] = (f32x4){0.f, 0.f, 0.f, 0.f};
    for (int dir = 0; dir < 2; ++dir) {
        f32x4 S[8];
        if (s >= 16) { const float* s0 = A.in[I_SHG] + ((size_t)(((s - 16) * 2 + layer) * 2 + dir) * 4 + h) * 16384;
#pragma unroll
            for (int j = 0; j < 8; ++j) S[j] = *(const f32x4*)(s0 + 4 * (F.tid + 512 * j)); }
        else {
#pragma unroll
            for (int j = 0; j < 8; ++j) S[j] = (f32x4){0.f, 0.f, 0.f, 0.f}; }
        const int nprev = dir ? nC - 1 - c : c;
        if (nprev > 0) {
            f32x4 cur[8]; float dcur[8];
            { const int sl = hg_slot(s, h, dir, dir ? nC - 1 : 0);
#pragma unroll
              for (int j = 0; j < 8; ++j) { const int idx4 = F.tid + 512 * j; dcur[j] = HDEC[(size_t)sl * 128 + (idx4 >> 5)]; cur[j] = *(const f32x4*)(HSL + (size_t)sl * 16384 + 4 * idx4); } }
            for (int q = 0; q < nprev; ++q) {
                f32x4 nxt[8]; float dnx[8];
                const int qn = q + 1 < nprev ? q + 1 : q, sl = hg_slot(s, h, dir, dir ? nC - 1 - qn : qn);
#pragma unroll
                for (int j = 0; j < 8; ++j) { const int idx4 = F.tid + 512 * j; dnx[j] = HDEC[(size_t)sl * 128 + (idx4 >> 5)]; nxt[j] = *(const f32x4*)(HSL + (size_t)sl * 16384 + 4 * idx4); }
#pragma unroll
                for (int j = 0; j < 8; ++j) { S[j] = S[j] * dcur[j] + cur[j]; cur[j] = nxt[j]; dcur[j] = dnx[j]; }
            }
        }
        if (s < 16 && (dir ? c == 0 : c == nC - 1)) {
            const int sl = hg_slot(s, h, dir, c); float* so = A.out + OUT_SH + ((size_t)((s * 2 + layer) * 2 + dir) * 4 + h) * 16384;
#pragma unroll
            for (int j = 0; j < 8; ++j) { const int idx4 = F.tid + 512 * j; const float dc = HDEC[(size_t)sl * 128 + (idx4 >> 5)];
                *(f32x4*)(so + 4 * idx4) = S[j] * dc + *(const f32x4*)(HSL + (size_t)sl * 16384 + 4 * idx4); } }
        if (dir) __syncthreads();
#pragma unroll
        for (int j = 0; j < 8; ++j) { const int idx4 = F.tid + 512 * j; *(LAS f32x4*)(Ss + (idx4 >> 5) * LS + 4 * (idx4 & 31)) = S[j]; }
#pragma unroll
        for (int j = 0; j < 4; ++j) { const int idx4 = F.tid + 512 * j, i = idx4 >> 5;
            *(LAS f32x4*)(Qd + i * LS + 4 * (idx4 & 31)) = *(const f32x4*)(QD + ((size_t)(tokbase + 64 * c + i) * 2 + dir) * 512 + h * 128 + 4 * (idx4 & 31)); }
        __syncthreads();
        for (int ks = 0; ks < 32; ++ks) { const float bv = Ss[(4 * ks + g) * LS + 16 * w + c15];
#pragma unroll
            for (int tt = 0; tt < 4; ++tt) acc[tt] = __builtin_amdgcn_mfma_f32_16x16x4f32(Qd[(16 * tt + c15) * LS + 4 * ks + g], bv, acc[tt], 0, 0, 0); }
    }
    const float* OL = (const float*)(A.ws + WS_HOL);
#pragma unroll
    for (int tt = 0; tt < 4; ++tt)
#pragma unroll
        for (int r = 0; r < 4; ++r) { const int t = 16 * tt + 4 * g + r; const float* ol = OL + (size_t)(tokbase + 64 * c + t) * 1024 + h * 128 + 16 * w + c15;
            Os[t * LS + 16 * w + c15] = acc[tt][r] + ol[0] + ol[512]; }
    __syncthreads();
    {
        const int t = F.tid >> 3, seg = F.tid & 7; const size_t row = (size_t)(tokbase + 64 * c + t);
        f32x4 o[4]; float ss = 0.f;
#pragma unroll
        for (int j = 0; j < 4; ++j) { o[j] = *(const LAS f32x4*)(Os + t * LS + 16 * seg + 4 * j); ss += (o[j].x * o[j].x + o[j].y * o[j].y) + (o[j].z * o[j].z + o[j].w * o[j].w); }
        ss += __shfl_xor(ss, 1); ss += __shfl_xor(ss, 2); ss += __shfl_xor(ss, 4);
        const float rstd = 1.0f / sqrtf(ss * (1.0f / 128.f) + 1e-6f);
        const float* gn = A.in[I_HGN] + (size_t)(layer * 4 + h) * 128 + 16 * seg; const float* zo = (const float*)(A.ws + WS_ZF) + row * ZFW + ZO + h * 128 + 16 * seg;
        unsigned pk[8];
#pragma unroll
        for (int j = 0; j < 4; ++j) { const f32x4 gg = *(const f32x4*)(gn + 4 * j), zz = *(const f32x4*)(zo + 4 * j);
            pk[2 * j] = pk2(o[j].x * rstd * gg.x * silu_f(zz.x), o[j].y * rstd * gg.y * silu_f(zz.y)); pk[2 * j + 1] = pk2(o[j].z * rstd * gg.z * silu_f(zz.z), o[j].w * rstd * gg.w * silu_f(zz.w)); }
        bf16* oa = (bf16*)(A.ws + WS_OA) + row * 512 + h * 128 + 16 * seg;
        *(v4u*)oa = (v4u){pk[0], pk[1], pk[2], pk[3]}; *(v4u*)(oa + 8) = (v4u){pk[4], pk[5], pk[6], pk[7]};
    }
}

__device__ __forceinline__ float neg_expm1(float x) {
    return x > -0.03f ? -x * (1.f + x * (0.5f + x * (0.16666667f + x * 0.041666668f))) : 1.f - __expf(x);
}
__device__ __forceinline__ void lru_gate_unit(const Frame& F_, const Args& A, int u, int layer) {
    Frame F = F_; F.tid = opq(F_.tid); F.lane = F.tid & 63;
    const int k = u & 7, tt = (u >> 3) * 8 + F.wave, lane = F.lane, g = lane >> 4, c15 = lane & 15, r0 = 16 * tt;
    const int sstart = r0 < NCTX ? (r0 & ~255) : NCTX + ((r0 - NCTX) & ~1023), send = sstart + (r0 < NCTX ? SEQ : DSEQ);
    const float* Z = (const float*)(A.ws + WS_ZF);
    constexpr int WS_ = 68;
    LAS float* xs = (LAS float*)(F.lds + F.wave * 12544); LAS float* au = xs + 1088;
    LAS float* Wa = (LAS float*)(F.lds + 8 * 12544); LAS float* Wx = Wa + 64 * WS_;
    {   const int ch = 64 * k + lane; const float* cw = A.in[I_CONVW] + (size_t)layer * 4 * 512 + ch; const float w0 = cw[0], w1 = cw[512], w2 = cw[1024], w3 = cw[1536], cb = A.in[I_CONVB][layer * 512 + ch];
        float lx[19];
#pragma unroll
        for (int j = 0; j < 19; ++j) { const int row = r0 - 2 + j; lx[j] = (row >= sstart && row < send) ? Z[(size_t)row * ZFW + ZLX + ch] : 0.f; }
#pragma unroll
        for (int j = 0; j < 16; ++j) xs[j * 65 + lane] = cb + w0 * lx[j] + w1 * lx[j + 1] + w2 * lx[j + 2] + w3 * lx[j + 3]; }
    float* LHL = (float*)(A.ws + WS_LHL); float* LPP = (float*)(A.ws + WS_LPP);
    for (int dir = 0; dir < 2; ++dir) {
        if (dir) __syncthreads();
        {   const float* wsa = A.in[I_LWA] + (size_t)((layer * 2 + dir) * 8 + k) * 4096; const float* wsx = A.in[I_LWX] + (size_t)((layer * 2 + dir) * 8 + k) * 4096;
#pragma unroll
            for (int j = 0; j < 2; ++j) { const int r4 = F.tid + 512 * j;
                *(LAS f32x4*)(Wa + (r4 >> 4) * WS_ + 4 * (r4 & 15)) = *(const f32x4*)(wsa + 4 * r4); *(LAS f32x4*)(Wx + (r4 >> 4) * WS_ + 4 * (r4 & 15)) = *(const f32x4*)(wsx + 4 * r4); } }
        __syncthreads();
        f32x4 aa[4], ax[4];
#pragma unroll
        for (int jt = 0; jt < 4; ++jt) { aa[jt] = (f32x4){0.f, 0.f, 0.f, 0.f}; ax[jt] = aa[jt]; }
#pragma unroll 4
        for (int ks = 0; ks < 16; ++ks) { const float a = xs[c15 * 65 + 4 * ks + g];
#pragma unroll
            for (int jt = 0; jt < 4; ++jt) { const int wi = (4 * ks + g) * WS_ + 16 * jt + c15;
                aa[jt] = __builtin_amdgcn_mfma_f32_16x16x4f32(a, Wa[wi], aa[jt], 0, 0, 0); ax[jt] = __builtin_amdgcn_mfma_f32_16x16x4f32(a, Wx[wi], ax[jt], 0, 0, 0); } }
        const int pb = (layer * 2 + dir) * 512 + 64 * k;
#pragma unroll
        for (int jt = 0; jt < 4; ++jt) { const int chl = 16 * jt + c15; const float ba = A.in[I_LBA][pb + chl], bx = A.in[I_LBX][pb + chl], sp = log1pf(__expf(-A.in[I_LAM][pb + chl]));
#pragma unroll
            for (int r = 0; r < 4; ++r) { const int j = 4 * g + r; const float rg = sigmoid_f(aa[jt][r] + ba), ig = sigmoid_f(ax[jt][r] + bx);
                const float la = -8.0f * rg * sp, av = __expf(la), mult = __builtin_amdgcn_sqrtf(neg_expm1(2.0f * la)), uv = mult * ig * xs[j * 65 + chl];
                au[(j * 64 + chl) * 2] = av; au[(j * 64 + chl) * 2 + 1] = uv; } }
        LDS_WAIT(); asm volatile("" ::: "memory");
        float hh = 0.f, P = 1.f;
#pragma unroll
        for (int jj = 0; jj < 16; ++jj) { const int j = dir ? 15 - jj : jj; const float av = au[(j * 64 + lane) * 2], uv = au[(j * 64 + lane) * 2 + 1];
            hh = av * hh + uv; P *= av; const size_t o = ((size_t)(r0 + j) * 2 + dir) * 512 + 64 * k + lane; LHL[o] = hh; LPP[o] = P; }
        LDS_WAIT(); asm volatile("" ::: "memory");
    }
}
__device__ __forceinline__ float gelu_tanh(float x) { const float t = 0.7978845608028654f * (x + 0.044715f * x * x * x); return 0.5f * x * (1.0f + tanhf(t)); }
__device__ __forceinline__ void lru_final_unit(const Frame& F_, const Args& A, int tt, int layer) {
    Frame F = F_; F.tid = opq(F_.tid); F.lane = F.tid & 63;
    const int ch = F.tid, r0 = 16 * tt;
    const int s = r0 < NCTX ? r0 >> 8 : 16 + ((r0 - NCTX) >> 10), f0 = (r0 < NCTX ? (r0 & ~255) : NCTX + ((r0 - NCTX) & ~1023)) >> 4, nt = r0 < NCTX ? 16 : 64;
    const float* LHL = (const float*)(A.ws + WS_LHL); const float* LPP = (const float*)(A.ws + WS_LPP); const float* Z = (const float*)(A.ws + WS_ZF);
    float cf = 0.f, cb = 0.f;
    if (s >= 16) { const float* h0 = A.in[I_SLRU] + (size_t)((s - 16) * 2 + layer) * 1024; cf = h0[ch]; cb = h0[512 + ch]; }
    {   int j = f0;
        for (; j + 8 <= tt; j += 8) { float hv[8], pv[8];
#pragma unroll
            for (int q = 0; q < 8; ++q) { const size_t o = ((size_t)(16 * (j + q) + 15) * 2 + 0) * 512 + ch; hv[q] = LHL[o]; pv[q] = LPP[o]; }
#pragma unroll
            for (int q = 0; q < 8; ++q) cf = hv[q] + pv[q] * cf; }
        for (; j < tt; ++j) { const size_t o = ((size_t)(16 * j + 15) * 2 + 0) * 512 + ch; cf = LHL[o] + LPP[o] * cf; } }
    {   int j = f0 + nt - 1;
        for (; j - 8 >= tt; j -= 8) { float hv[8], pv[8];
#pragma unroll
            for (int q = 0; q < 8; ++q) { const size_t o = ((size_t)(16 * (j - q)) * 2 + 1) * 512 + ch; hv[q] = LHL[o]; pv[q] = LPP[o]; }
#pragma unroll
            for (int q = 0; q < 8; ++q) cb = hv[q] + pv[q] * cb; }
        for (; j > tt; --j) { const size_t o = ((size_t)(16 * j) * 2 + 1) * 512 + ch; cb = LHL[o] + LPP[o] * cb; } }
    bf16* OC = (bf16*)(A.ws + WS_OC);
#pragma unroll 4
    for (int i = 0; i < 16; ++i) { const size_t row = (size_t)(r0 + i), o0 = (row * 2) * 512 + ch, o1 = o0 + 512;
        const float hf = LHL[o0] + LPP[o0] * cf, hb = LHL[o1] + LPP[o1] * cb, y = (hf + hb) * gelu_tanh(Z[row * ZFW + ZLG + ch]);
        OC[row * 512 + ch] = (bf16)f2bf(y);
        if (s < 16) { if (i == 15 && tt == f0 + nt - 1) A.out[OUT_SL + (size_t)((s * 2 + layer) * 2 + 0) * 512 + ch] = hf;
                      if (i == 0 && tt == f0) A.out[OUT_SL + (size_t)((s * 2 + layer) * 2 + 1) * 512 + ch] = hb; } }
}

#ifndef DUP_P0C
#define DUP_P0C 0
#endif
#ifndef DUP_P0M
#define DUP_P0M 0
#endif
#ifndef DUP_H1
#define DUP_H1 0
#endif
#ifndef DUP_UP1
#define DUP_UP1 0
#endif
#ifndef DUP_NA
#define DUP_NA 0
#endif
#ifndef DUP_CA
#define DUP_CA 0
#endif
#ifndef DUP_L1
#define DUP_L1 0
#endif
#ifndef DUP_H3
#define DUP_H3 0
#endif
#ifndef DUP_L2
#define DUP_L2 0
#endif
#ifndef DUP_NORM
#define DUP_NORM 0
#endif
#ifndef PROBE_NOCACHE
#define PROBE_NOCACHE 0
#endif
#ifndef PROBE_MEMSET
#define PROBE_MEMSET 0
#endif
#ifndef MK_N_LAUNCHES
#define MK_N_LAUNCHES 1
#endif
constexpr int UP_ROWS4 = 2304;
__device__ __forceinline__ void up_gemm(LAS unsigned char* ring, const bf16* Hm, const bf16* Wt, bf16* HIDm, int G) {
    int c = (int)blockIdx.x; asm volatile("" : "+s"(G), "+s"(c));
    { pg8::Gemm g{Hm, Wt, UP_ROWS4, 2 * DFF, DM}; pg8::SplitOrder S; S.init(UP_ROWS4, 2 * DFF, G, c, 256, 0);
      pg8::EpiSwiglu E{HIDm, DFF}; pg8::gemm_phase<pg8::EpiSwiglu, pg8::SplitOrder, true, true, 4>(ring, g, S, E); }
    __syncthreads();
    { pg8::Gemm g{Hm + (size_t)UP_ROWS4 * DM, Wt, MTOK - UP_ROWS4, 2 * DFF, DM}; pg8::SplitOrder S; S.init(MTOK - UP_ROWS4, 2 * DFF, G, c, 192, 144);
      pg8::EpiSwiglu E{HIDm + (size_t)UP_ROWS4 * DFF, DFF}; pg8::gemm_phase<pg8::EpiSwiglu, pg8::SplitOrder, true, true, 3>(ring, g, S, E); }
}
constexpr int N_PHASES = 3 + 12 * DEPTH;
constexpr int MT_N2K = 3;
__global__ void __launch_bounds__(NTHREADS, 2) trunk_fwd(Args A) {
    extern __shared__ __attribute__((aligned(16))) unsigned char lds_raw[];
    Frame F; F.lds = (LAS unsigned char*)lds_raw; F.tid = threadIdx.x; F.lane = F.tid & 63; F.wave = __builtin_amdgcn_readfirstlane(F.tid >> 6);
    F.G = gridDim.x; F.gw = blockIdx.x * NWAVES + F.wave; F.NGW = F.G * NWAVES;
    volatile LAS unsigned* MISC = (volatile LAS unsigned*)(F.lds + LDSCTL_OFF);
    for (int u = F.tid; u < (LDS_BYTES - LDSCTL_OFF) / 4; u += NTHREADS) MISC[u] = 0u;
    __syncthreads();
    gu32* ctl = (gu32*)(A.ws + WS_CTL);
    XcdBarrier bar; bar.bar = (unsigned*)(ctl + CW_BAR); bar.x = 0; bar.st = nullptr;
    if (MK_N_LAUNCHES == 1) bar = xcd_barrier_post((unsigned*)(ctl + CW_BAR), MISC + 8);
    const int lo = A.ph_lo, hi = A.ph_hi;
#define IN(k) (lo <= (k) && (k) < hi)
#define SEAM(k) do { if (IN(k) && IN((k) + 1)) { XcdBarrier b2_ = bar; asm volatile("" : "+s"(b2_.bar)); xcd_barrier(b2_); } } while (0)
    gu32* cvq = ctl + CW_Q + 30 * 64;
#define CV_END(l_, j_, gemm_) do { if (CV_BACKGROUND && IN(3 + 12 * (l_) + (j_))) cv_until(F, A, cvq, cv_need((l_), (j_)), (gemm_) ? ctl + CW_Q + (32 + 12 * (l_) + (j_)) * 64 : (gu32*)nullptr, MISC + 20); } while (0)
    unsigned char* ws = A.ws;
    float* X = (float*)(ws + WS_X); bf16* H = (bf16*)(ws + WS_H); bf16* HID = (bf16*)(ws + WS_HID);
    float* MODS = (float*)(ws + WS_MODS);
    LAS unsigned char* ring = F.lds;

#ifndef NO_P0
    if (IN(0)) { p0_convert(F, A); p0_mods_partial(F, A);
#if !PROBE_NOCACHE
        p0_cache(F, A);
#endif
    }
#if DUP_P0C
    if (IN(0)) { __syncthreads(); p0_convert(F, A); }
#endif
#if DUP_P0M
    if (IN(0)) { __syncthreads(); p0_mods_partial(F, A); }
#endif
    #endif
        SEAM(0);
#ifndef NO_P1
    if (IN(1)) p0_mods_reduce(F, A);
    #endif
        SEAM(1);
#ifndef NO_P2
    if (IN(2)) norm_rows<0>(F, A.in[I_XP], A.in[I_XS], X, A.in[I_NORMG], MODS, 0, H, nullptr);
    #endif
        SEAM(2);

#pragma unroll 1
    for (int l = 0; l < DEPTH; ++l) {
        const int pb = 3 + 12 * l;
        unsigned char* wl = ws + WS_W + (size_t)l * W_LAYER;
        const float* mods_l = MODS + (size_t)l * 3 * 9 * DM;
        const float* ng = A.in[I_NORMG] + (size_t)l * 3 * DM;
#ifndef NO_G0
        if (IN(pb + 0)) up_gemm(ring, H, (const bf16*)(wl + WO_UP1), HID, F.G);
        #endif
        CV_END(l, 0, 1);
        SEAM(pb + 0);
#ifndef NO_G1
        if (IN(pb + 1)) { pg8::Gemm g{HID, (const bf16*)(wl + WO_DN1), MTOK, DM, DFF}; pg8::StaticOrder S; S.init(MTOK, DM, F.G, (int)blockIdx.x, 64 * MT_N2K);
            pg8::EpiResid E{X, DM, mods_l, 0, 0.5f}; pg8::gemm_phase<pg8::EpiResid, pg8::StaticOrder, true, true, MT_N2K>(ring, g, S, E); }
        #endif
        CV_END(l, 1, 1);
        SEAM(pb + 1);
#ifndef NO_N2
        if (IN(pb + 2)) norm_rows<0>(F, X, X + (size_t)NCTX * DM, nullptr, ng + DM, mods_l, 1, H, nullptr);
#if DUP_NORM
        if (IN(pb + 2)) norm_rows<0>(F, X, X + (size_t)NCTX * DM, nullptr, ng + DM, mods_l, 1, H, nullptr);
#endif
        #endif
        CV_END(l, 2, 0);
        SEAM(pb + 2);
#ifndef NO_G3
        if (IN(pb + 3)) { pg8::Gemm g{H, (const bf16*)(wl + WO_IN), MTOK, DIN, DM}; pg8::StaticOrder S; S.init(MTOK, DIN, F.G, (int)blockIdx.x);
            pg8::EpiZ E{(float*)(ws + WS_ZF), (bf16*)(ws + WS_QB), (bf16*)(ws + WS_KB), (bf16*)(ws + WS_VT), (bf16*)(ws + WS_GB), A.out + OUT_K, A.out + OUT_V, l, (float*)(ws + 736 * MiB)}; pg8::gemm_phase<pg8::EpiZ, pg8::StaticOrder, true, true>(ring, g, S, E); }
        #endif
        CV_END(l, 3, 1);
        SEAM(pb + 3);
        if (IN(pb + 4)) {
            gu32* q = ctl + CW_Q + (l * 8) * 64;
            #ifndef NO_H1
            for (int u; (u = next_unit(q + 0 * 64, MISC + 16)) < 768;) hgrn_local_unit(F, A, u, l);
#endif
#if DUP_H1
            for (int u; (u = next_unit(q + 6 * 64, MISC + 16)) < 768;) hgrn_local_unit(F, A, u, l);
#endif
            #ifndef NO_NA
            for (int u; (u = next_unit(q + 1 * 64, MISC + 16)) < 256;) attn_na_unit(F, A, u, l);
#endif
#if DUP_NA
            for (int u; (u = next_unit(q + 6 * 64, MISC + 16)) < 256;) attn_na_unit(F, A, u, l);
#endif
            #ifndef NO_CA
            for (int u; (u = next_unit(q + 2 * 64, MISC + 16)) < 256;) attn_ctx_unit(F, A, u);
#endif
#if DUP_CA
            for (int u; (u = next_unit(q + 6 * 64, MISC + 16)) < 256;) attn_ctx_unit(F, A, u);
#endif
            #ifndef NO_L1
            for (int u; (u = next_unit(q + 3 * 64, MISC + 16)) < 384;) lru_gate_unit(F, A, u, l);
#endif
#if DUP_L1
            for (int u; (u = next_unit(q + 6 * 64, MISC + 16)) < 384;) lru_gate_unit(F, A, u, l);
#endif
        }
        CV_END(l, 4, 0);
        SEAM(pb + 4);
        if (IN(pb + 5)) {
            gu32* q = ctl + CW_Q + (l * 8) * 64;
            #ifndef NO_H3
            for (int u; (u = next_unit(q + 4 * 64, MISC + 16)) < 384;) hgrn_final_unit(F, A, u, l);
#endif
#if DUP_H3
            for (int u; (u = next_unit(q + 7 * 64, MISC + 16)) < 384;) hgrn_final_unit(F, A, u, l);
#endif
            #ifndef NO_L2
            for (int u; (u = next_unit(q + 5 * 64, MISC + 16)) < 384;) lru_final_unit(F, A, u, l);
#endif
#if DUP_L2
            for (int u; (u = next_unit(q + 7 * 64, MISC + 16)) < 384;) lru_final_unit(F, A, u, l);
#endif
        }
        CV_END(l, 5, 0);
        SEAM(pb + 5);
#ifndef NO_G6
        if (IN(pb + 6)) {
            __syncthreads();
            float* MACC = (float*)(ws + WS_MACC); bf16* MB = (bf16*)(ws + WS_MB);
            { pg8::Gemm g{(const bf16*)(ws + WS_OA), (const bf16*)(wl + WO_PA), MTOK, DM, 512}; pg8::StaticOrder S; S.init(MTOK, DM, F.G, (int)blockIdx.x, 64 * MT_N2K);
              pg8::EpiMerge E{(const bf16*)(ws + WS_GB), MACC, MB, 0}; pg8::gemm_phase<pg8::EpiMerge, pg8::StaticOrder, true, true, MT_N2K>(ring, g, S, E); }
            { pg8::Gemm g{(const bf16*)(ws + WS_OB), (const bf16*)(wl + WO_PB), MTOK, DM, 1024}; pg8::StaticOrder S; S.init(MTOK, DM, F.G, (int)blockIdx.x, 64 * MT_N2K);
              pg8::EpiMerge E{(const bf16*)(ws + WS_GB) + DM, MACC, MB, 1}; pg8::gemm_phase<pg8::EpiMerge, pg8::StaticOrder, true, true, MT_N2K>(ring, g, S, E); }
            { pg8::Gemm g{(const bf16*)(ws + WS_OC), (const bf16*)(wl + WO_PC), MTOK, DM, 512}; pg8::StaticOrder S; S.init(MTOK, DM, F.G, (int)blockIdx.x, 64 * MT_N2K);
              pg8::EpiMerge E{(const bf16*)(ws + WS_GB) + 2 * DM, MACC, MB, 2}; pg8::gemm_phase<pg8::EpiMerge, pg8::StaticOrder, true, true, MT_N2K>(ring, g, S, E); }
        }
        #endif
        CV_END(l, 6, 1);
        SEAM(pb + 6);
#ifndef NO_G7
        if (IN(pb + 7)) { pg8::Gemm g{(const bf16*)(ws + WS_MB), (const bf16*)(wl + WO_OUT), MTOK, DM, DM}; pg8::StaticOrder S; S.init(MTOK, DM, F.G, (int)blockIdx.x, 64 * MT_N2K);
            pg8::EpiResid E{X, DM, mods_l, 1, 1.0f}; pg8::gemm_phase<pg8::EpiResid, pg8::StaticOrder, true, true, MT_N2K>(ring, g, S, E); }
        #endif
        CV_END(l, 7, 1);
        SEAM(pb + 7);
#ifndef NO_N8
        if (IN(pb + 8)) norm_rows<0>(F, X, X + (size_t)NCTX * DM, nullptr, ng + 2 * DM, mods_l, 2, H, nullptr);
        #endif
        CV_END(l, 8, 0);
        SEAM(pb + 8);
#ifndef NO_G9
        if (IN(pb + 9)) up_gemm(ring, H, (const bf16*)(wl + WO_UP2), HID, F.G);
        #endif
        CV_END(l, 9, 1);
        SEAM(pb + 9);
#ifndef NO_G10
        if (IN(pb + 10)) { pg8::Gemm g{HID, (const bf16*)(wl + WO_DN2), MTOK, DM, DFF}; pg8::StaticOrder S; S.init(MTOK, DM, F.G, (int)blockIdx.x, 64 * MT_N2K);
            pg8::EpiResid E{X, DM, mods_l, 2, 0.5f}; pg8::gemm_phase<pg8::EpiResid, pg8::StaticOrder, true, true, MT_N2K>(ring, g, S, E); }
        #endif
        CV_END(l, 10, 1);
        SEAM(pb + 10);
#ifndef NO_N11
        if (IN(pb + 11)) {
            if (l + 1 < DEPTH) norm_rows<0>(F, X, X + (size_t)NCTX * DM, nullptr, ng + 3 * DM, mods_l + 3 * 9 * DM, 0, H, nullptr);
            else norm_rows<1>(F, X, X + (size_t)NCTX * DM, nullptr, A.in[I_FNG], nullptr, 0, nullptr, A.out + OUT_Y);
        }
        #endif
        CV_END(l, 11, 0);
        SEAM(pb + 11);
    }
#undef IN
#undef SEAM
}

extern "C" void kernel_launch(void* const* d_in, const int* in_sizes, int n_in, void* d_out, int out_size, void* d_ws, size_t ws_size, hipStream_t stream) {
    static int grid = 0;
    if (grid == 0) {
        if (n_in != 31 || out_size != 33587200 || ws_size < WS_END) { fprintf(stderr, "kernel_launch: unexpected shapes (n_in %d, out %d, ws %zu); nothing launched\n", n_in, out_size, ws_size); grid = -1; return; }
        int dev = 0, cus = 0, per_cu = 0;
        if (hipGetDevice(&dev) != hipSuccess || hipDeviceGetAttribute(&cus, hipDeviceAttributeMultiprocessorCount, dev) != hipSuccess) { grid = -1; return; }
        if (hipFuncSetAttribute((const void*)trunk_fwd, hipFuncAttributeMaxDynamicSharedMemorySize, LDS_BYTES) != hipSuccess) { fprintf(stderr, "kernel_launch: hipFuncSetAttribute failed\n"); grid = -1; return; }
        if (hipOccupancyMaxActiveBlocksPerMultiprocessor(&per_cu, (const void*)trunk_fwd, NTHREADS, LDS_BYTES) != hipSuccess || per_cu < 1) { fprintf(stderr, "kernel_launch: occupancy query says %d blocks per CU\n", per_cu); (void)hipGetLastError(); grid = -1; return; }
        grid = cus;
    }
    if (grid < 0) return;
    if (hipMemsetAsync((char*)d_ws + WS_CTL, 0, CTL_ZERO_BYTES, stream) != hipSuccess) return;
#if PROBE_MEMSET
    (void)hipMemsetAsync((char*)d_ws + PROBE_MS_LO * MiB, 0, (PROBE_MS_HI - PROBE_MS_LO) * MiB, stream);
#endif
    Args a{};
    for (int i = 0; i < 31; ++i) a.in[i] = (const float*)d_in[i];
    a.out = (float*)d_out; a.ws = (unsigned char*)d_ws;
#if MK_N_LAUNCHES == 1
    a.ph_lo = 0; a.ph_hi = N_PHASES;
    hipLaunchKernelGGL(trunk_fwd, dim3(grid), dim3(NTHREADS), LDS_BYTES, stream, a);
#else
    for (int p = 0; p < N_PHASES; ++p) { a.ph_lo = p; a.ph_hi = p + 1; hipLaunchKernelGGL(trunk_fwd, dim3(grid), dim3(NTHREADS), LDS_BYTES, stream, a); }
#endif
}
```
